# Optimizing an MI355X kernel written in HIP

```python
import math
import jax, jax.numpy as jnp
from jax import lax
import numpy as np

D_MODEL = 1024
BATCH = 16
SEQ = 2048
DEPTH = 1

GRID_W = 64
A_HEADS = 8
A_HEAD_DIM = 64
D_A = A_HEADS * A_HEAD_DIM
W_LORA = 64
A_LORA = 64
G_LORA = 128
DECAY_SCALE = math.exp(-0.5)
GN_EPS = 64e-5
B_HEADS = 8
B_HEAD_DIM = 64
D_B = B_HEADS * B_HEAD_DIM
NA_WR_MAX = 8
NA_WC = 16
NA_QB = 16
NA_KB = NA_QB + NA_WC
N_EXPERTS = 32
TOP_K = 4
D_EXPERT = D_MODEL
SWIGLU_LIMIT = 7.0
SWIGLU_ALPHA = 1.702
MOE_BLOCK = 512
RMS_EPS = 1e-5

A_COLS = 3 * D_A + 2 * W_LORA + 2 * A_LORA + G_LORA
B_COLS = 3 * D_B
IN_COLS = A_COLS + B_COLS + 2 * D_MODEL

kernel_name = "hybrid_rwkv7_natten_moe_block"


def rmsnorm(x, g):
    xf = x.astype(jnp.float32)
    y = xf * lax.rsqrt(jnp.mean(xf * xf, axis=-1, keepdims=True) + RMS_EPS) * g.astype(jnp.float32)
    return y.astype(x.dtype)


def head_rmsnorm(t, g):
    tf = t.astype(jnp.float32)
    return tf * lax.rsqrt(jnp.mean(tf * tf, axis=-1, keepdims=True) + RMS_EPS) * g.astype(jnp.float32)


def centred_token_shift(p, mu_prev, mu_next):
    prev = jnp.pad(p[:, :-1], ((0, 0), (1, 0), (0, 0)))
    nxt = jnp.pad(p[:, 1:], ((0, 0), (0, 1), (0, 0)))
    return p + mu_prev * (prev - p) + mu_next * (nxt - p)


def rwkv7_scan(r, w, k, v, kk, a, reverse):
    B, T, H, N = r.shape
    xs = tuple(t.transpose(1, 0, 2, 3) for t in (r, w, k, v, kk, a))

    def step(S, inp):
        r_t, w_t, k_t, v_t, kk_t, a_t = inp
        sa = jnp.einsum('bhvk,bhk->bhv', S, -kk_t)
        S = (S * w_t[:, :, None, :]
             + sa[..., None] * (kk_t * a_t)[:, :, None, :]
             + v_t[..., None] * k_t[:, :, None, :])
        return S, jnp.einsum('bhvk,bhk->bhv', S, r_t)

    S0 = jnp.zeros((B, H, N, N), jnp.float32)
    _, o = lax.scan(step, S0, xs, reverse=reverse)
    return o.transpose(1, 0, 2, 3)


def rwkv7_branch(pa, mu_prev, mu_next, w0_f, w2_f, w0_b, w2_b, a0_f, a2_f, a0_b, a2_b,
                 g2, k_k, k_a, r_k, lnx_g, lnx_b):
    B, T, _ = pa.shape
    xa = centred_token_shift(pa, mu_prev, mu_next)
    split_at = np.cumsum([D_A, D_A, D_A, W_LORA, W_LORA, A_LORA, A_LORA]).tolist()
    r, k, v, lw_f, lw_b, la_f, la_b, lg = jnp.split(xa, split_at, axis=-1)

    def heads(t):
        return t.reshape(B, T, A_HEADS, A_HEAD_DIM).astype(jnp.float32)

    g = jax.nn.sigmoid(lg) @ g2
    kk = heads(k * k_k)
    kk = kk / jnp.maximum(jnp.sqrt(jnp.sum(kk * kk, axis=-1, keepdims=True)), 1e-12)
    r_h, v_h = heads(r), heads(v)

    outs, bonus = [], []
    for w0, w2, a0, a2, lw, la, rev in ((w0_f, w2_f, a0_f, a2_f, lw_f, la_f, False),
                                        (w0_b, w2_b, a0_b, a2_b, lw_b, la_b, True)):
        decay = jnp.exp(-DECAY_SCALE * jax.nn.sigmoid((w0 + jnp.tanh(lw) @ w2).astype(jnp.float32)))
        a = jax.nn.sigmoid(a0 + la @ a2)
        k_dir = heads(k * (1.0 + (a - 1.0) * k_a))
        a_h = heads(a)
        outs.append(rwkv7_scan(r_h, decay.reshape(B, T, A_HEADS, A_HEAD_DIM), k_dir, v_h, kk, a_h, rev))
        bonus.append(jnp.sum(r_h * k_dir * r_k.astype(jnp.float32), axis=-1, keepdims=True) * v_h)

    o = outs[0] + outs[1]
    mu = jnp.mean(o, axis=-1, keepdims=True)
    var = jnp.mean(jnp.square(o - mu), axis=-1, keepdims=True)
    y = ((o - mu) * lax.rsqrt(var + GN_EPS)).reshape(B, T, D_A) * lnx_g + lnx_b
    y = y + (bonus[0] + bonus[1]).reshape(B, T, D_A)
    return (y * g).astype(pa.dtype)


def na_branch(pb, q_gain, k_gain, rpb):
    B, T, _ = pb.shape
    rows = T // GRID_W
    wr = min(NA_WR_MAX, rows)
    n_cb = GRID_W // NA_QB
    q, k, v = jnp.split(pb, 3, axis=-1)

    def to_grid(t):
        return t.reshape(B, rows, GRID_W, B_HEADS, B_HEAD_DIM).transpose(0, 3, 1, 2, 4)

    qg = to_grid(head_rmsnorm(q.reshape(B, T, B_HEADS, B_HEAD_DIM), q_gain))
    kg = to_grid(head_rmsnorm(k.reshape(B, T, B_HEADS, B_HEAD_DIM), k_gain))
    vg = to_grid(v.reshape(B, T, B_HEADS, B_HEAD_DIM))

    qcols = np.arange(GRID_W).reshape(n_cb, NA_QB)
    cs = np.clip(qcols - NA_WC // 2, 0, GRID_W - NA_WC)
    kc0 = np.minimum(cs[:, 0], GRID_W - NA_KB)
    kcols = kc0[:, None] + np.arange(NA_KB)
    col_mask = ((kcols[:, None, :] >= cs[..., None]) &
                (kcols[:, None, :] < cs[..., None] + NA_WC))
    dc_idx = np.clip(kcols[:, None, :] - qcols[..., None] + NA_WC - 1, 0, 2 * NA_WC - 2)
    bias_c = rpb.astype(jnp.float32)[:, :, dc_idx]
    mask = jnp.asarray(col_mask)[:, :, None, :]
    scale = B_HEAD_DIM ** -0.5

    def row_step(r):
        rs = jnp.clip(r - wr // 2, 0, rows - wr)
        k_blk = lax.dynamic_slice_in_dim(kg, rs, wr, axis=2)[:, :, :, kcols]
        v_blk = lax.dynamic_slice_in_dim(vg, rs, wr, axis=2)[:, :, :, kcols]
        q_row = lax.dynamic_index_in_dim(qg, r, axis=2, keepdims=False).reshape(
            B, B_HEADS, n_cb, NA_QB, B_HEAD_DIM)
        s = jnp.einsum('bhcqd,bhrckd->bhcqrk', q_row, k_blk) * scale
        dr_idx = rs + jnp.arange(wr) - r + NA_WR_MAX - 1
        s = s + jnp.take(bias_c, dr_idx, axis=1).transpose(0, 2, 3, 1, 4)
        s = jnp.where(mask, s, -jnp.inf)
        p = jax.nn.softmax(s.reshape(B, B_HEADS, n_cb, NA_QB, wr * NA_KB), axis=-1).reshape(s.shape)
        return jnp.einsum('bhcqrk,bhrckd->bhcqd', p.astype(v_blk.dtype), v_blk)

    o = lax.map(row_step, jnp.arange(rows))
    return o.transpose(1, 0, 3, 4, 2, 5).reshape(B, T, D_B).astype(pb.dtype)


def moe_ffn(h, w_router, b_router, w1, b1, w2, b2):
    B, T, D = h.shape
    M = B * T
    hf = h.reshape(M, D)
    logits = (hf @ w_router).astype(jnp.float32) + b_router.astype(jnp.float32)
    top_vals, top_idx = lax.top_k(logits, TOP_K)
    gate_w = jax.nn.softmax(top_vals, axis=-1)

    A = M * TOP_K
    flat_e = top_idx.reshape(A)
    flat_tok = jnp.arange(A, dtype=jnp.int32) // TOP_K
    flat_w = gate_w.reshape(A)
    order = jnp.argsort(flat_e)
    sorted_e = flat_e[order]
    counts = jnp.bincount(flat_e, length=N_EXPERTS)
    padded = ((counts + MOE_BLOCK - 1) // MOE_BLOCK) * MOE_BLOCK
    start = jnp.cumsum(counts) - counts
    pend = jnp.cumsum(padded)
    pstart = pend - padded
    dest = pstart[sorted_e] + (jnp.arange(A) - start[sorted_e])
    n_blocks = -(-A // MOE_BLOCK) + N_EXPERTS
    n_pad = n_blocks * MOE_BLOCK
    tok_buf = jnp.zeros((n_pad,), jnp.int32).at[dest].set(flat_tok[order])
    w_buf = jnp.zeros((n_pad,), jnp.float32).at[dest].set(flat_w[order])
    block_e = jnp.minimum(jnp.searchsorted(pend, jnp.arange(n_blocks) * MOE_BLOCK, side='right'),
                          N_EXPERTS - 1)

    def expert_block(args):
        e, toks = args
        u = hf[toks] @ w1[e] + b1[e]
        glu = jnp.minimum(u[:, :D_EXPERT], SWIGLU_LIMIT)
        lin = jnp.clip(u[:, D_EXPERT:], -SWIGLU_LIMIT, SWIGLU_LIMIT)
        act = glu * jax.nn.sigmoid(SWIGLU_ALPHA * glu) * (lin + 1.0)
        return act @ w2[e] + b2[e]

    y = lax.map(expert_block, (block_e, tok_buf.reshape(n_blocks, MOE_BLOCK)))
    y = y.reshape(n_pad, D).astype(jnp.float32) * w_buf[:, None]
    out = jnp.zeros((M, D), jnp.float32).at[tok_buf].add(y)
    return out.astype(h.dtype).reshape(B, T, D)


def setup_inputs(seed: int = 0) -> dict:
    key = jax.random.key(seed)
    ks = iter(jax.random.split(key, 40))
    f32 = jnp.float32
    L = DEPTH

    def nrm(shape, scale):
        return jax.random.normal(next(ks), shape, f32) * scale

    def uni(shape, lo, hi):
        return jax.random.uniform(next(ks), shape, f32, lo, hi)

    return {
        "x": nrm((BATCH, SEQ, D_MODEL), 1.0),
        "g_mix": 1.0 + nrm((L, D_MODEL), 0.02),
        "w_in": nrm((L, D_MODEL, IN_COLS), D_MODEL ** -0.5),
        "mu_prev": uni((L, A_COLS), 0.0, 0.5),
        "mu_next": uni((L, A_COLS), 0.0, 0.5),
        "w0_f": nrm((L, D_A), 1.0),
        "w2_f": nrm((L, W_LORA, D_A), 0.1),
        "w0_b": nrm((L, D_A), 1.0),
        "w2_b": nrm((L, W_LORA, D_A), 0.1),
        "a0_f": nrm((L, D_A), 0.5),
        "a2_f": nrm((L, A_LORA, D_A), 0.1),
        "a0_b": nrm((L, D_A), 0.5),
        "a2_b": nrm((L, A_LORA, D_A), 0.1),
        "g2": nrm((L, G_LORA, D_A), G_LORA ** -0.5),
        "k_k": 0.85 + nrm((L, D_A), 0.02),
        "k_a": 1.0 + nrm((L, D_A), 0.02),
        "r_k": nrm((L, A_HEADS, A_HEAD_DIM), 0.1),
        "lnx_g": 1.0 + nrm((L, D_A), 0.02),
        "lnx_b": nrm((L, D_A), 0.01),
        "q_norm_g": 1.0 + nrm((L, B_HEAD_DIM), 0.02),
        "k_norm_g": 1.0 + nrm((L, B_HEAD_DIM), 0.02),
        "rpb": nrm((L, B_HEADS, 2 * NA_WR_MAX - 1, 2 * NA_WC - 1), 0.1),
        "w_a": nrm((L, D_A, D_MODEL), D_A ** -0.5),
        "w_b": nrm((L, D_B, D_MODEL), D_B ** -0.5),
        "w_o": nrm((L, D_MODEL, D_MODEL), D_MODEL ** -0.5),
        "g_ffn": 1.0 + nrm((L, D_MODEL), 0.02),
        "w_router": nrm((L, D_MODEL, N_EXPERTS), D_MODEL ** -0.5),
        "b_router": nrm((L, N_EXPERTS), 0.01),
        "w1": nrm((L, N_EXPERTS, D_MODEL, 2 * D_EXPERT), D_MODEL ** -0.5),
        "b1": nrm((L, N_EXPERTS, 2 * D_EXPERT), 0.01),
        "w2": nrm((L, N_EXPERTS, D_EXPERT, D_MODEL), D_EXPERT ** -0.5),
        "b2": nrm((L, N_EXPERTS, D_MODEL), 0.01),
    }


def reference(x, g_mix, w_in, mu_prev, mu_next, w0_f, w2_f, w0_b, w2_b, a0_f, a2_f, a0_b, a2_b,
              g2, k_k, k_a, r_k, lnx_g, lnx_b, q_norm_g, k_norm_g, rpb, w_a, w_b, w_o,
              g_ffn, w_router, b_router, w1, b1, w2, b2):
    for l in range(DEPTH):
        h = rmsnorm(x, g_mix[l])
        p = h @ w_in[l]
        pa, pb, gates = jnp.split(p, [A_COLS, A_COLS + B_COLS], axis=-1)
        ya = rwkv7_branch(pa, mu_prev[l], mu_next[l], w0_f[l], w2_f[l], w0_b[l], w2_b[l],
                          a0_f[l], a2_f[l], a0_b[l], a2_b[l], g2[l], k_k[l], k_a[l], r_k[l],
                          lnx_g[l], lnx_b[l])
        yb = na_branch(pb, q_norm_g[l], k_norm_g[l], rpb[l])
        gate_a, gate_b = jnp.split(gates, 2, axis=-1)
        merged = jax.nn.sigmoid(gate_a) * (ya @ w_a[l]) + jax.nn.sigmoid(gate_b) * (yb @ w_b[l])
        x = x + merged @ w_o[l]
        x = x + moe_ffn(rmsnorm(x, g_ffn[l]), w_router[l], b_router[l], w1[l], b1[l], w2[l], b2[l])
    return x
```

```cpp
#include <hip/hip_runtime.h>
#include <cstdio>
#include <cstdint>

#ifndef MK_N_LAUNCHES
#define MK_N_LAUNCHES 10
#endif

#define LAS __attribute__((address_space(3)))
#define GAS __attribute__((address_space(1)))
typedef unsigned short bf16;
typedef short bf16x8 __attribute__((ext_vector_type(8)));
typedef float f32x4 __attribute__((ext_vector_type(4)));
typedef float f32x2 __attribute__((ext_vector_type(2)));
typedef unsigned u32x4 __attribute__((ext_vector_type(4)));
typedef unsigned u32x2 __attribute__((ext_vector_type(2)));
typedef GAS unsigned gu32;

constexpr int BATCH = 16, SEQ = 2048, DM = 1024, M = BATCH * SEQ;
constexpr int DA = 512, HD = 64, NH = 8;
constexpr int IN_COLS = 5504, PN = 5632;
constexpr int C_R = 0, C_K = 512, C_V = 1024, C_LWF = 1536, C_LAF = 1664, C_LG = 1792;
constexpr int C_Q = 1920, C_BK = 2432, C_BV = 2944, C_GA = 3456, C_GB = 4480;
constexpr int NE = 32, DE = 1024, LISTCAP = 32768;
constexpr int NT_MAX = 544;
constexpr float RMS_EPS = 1e-5f, GN_EPS = 64e-5f, DECAY_SCALE = 0.6065306597126334f;

constexpr size_t MiB = 1u << 20;
constexpr size_t WS_CTL = 0, CTL_ZERO_BYTES = 1 * MiB;
constexpr size_t WS_WIN = 1 * MiB;
constexpr size_t WS_WA = 12 * MiB, WS_WB = 13 * MiB, WS_WO = 14 * MiB;
constexpr size_t WS_W1 = 16 * MiB;
constexpr size_t WS_W2 = 144 * MiB;
constexpr size_t WS_XN = 208 * MiB;
constexpr size_t WS_P = 272 * MiB;
constexpr size_t WS_OF = 624 * MiB, WS_OB = 688 * MiB;
constexpr size_t WS_YB = 752 * MiB, WS_YA = 784 * MiB;
constexpr size_t WS_MG = 816 * MiB;
constexpr size_t WS_YBUF = 624 * MiB;
constexpr size_t WS_CFB = 880 * MiB;
constexpr size_t WS_GW = 882 * MiB;
constexpr size_t WS_LIST = 883 * MiB;
constexpr size_t WS_END = 888 * MiB;
static_assert(WS_YBUF + 4ull * M * DM * 2 <= WS_CFB, "ybuf overlay");
static_assert((size_t)NT_MAX * 256 * DE * 2 <= 352 * MiB, "act overlay");
constexpr int CW_BAR = 4096;
constexpr int CW_CNT = 16384;

constexpr int LDS_BYTES = 147456;
constexpr int MISC_OFF = LDS_BYTES - 1024;

__device__ __forceinline__ unsigned f2bf(float f) { unsigned u = __builtin_bit_cast(unsigned, f); return (u + 0x7fffu + ((u >> 16) & 1u)) >> 16; }
__device__ __forceinline__ unsigned pk2(float lo, float hi) { return f2bf(lo) | (f2bf(hi) << 16); }
__device__ __forceinline__ float bflo(unsigned u) { return __builtin_bit_cast(float, u << 16); }
__device__ __forceinline__ float bfhi(unsigned u) { return __builtin_bit_cast(float, u & 0xffff0000u); }
__device__ __forceinline__ float sigmoidf_(float x) { return 1.0f / (1.0f + __expf(-x)); }
template <int CTRL> __device__ __forceinline__ float dppf(float x) { return __builtin_bit_cast(float, __builtin_amdgcn_update_dpp(0, __builtin_bit_cast(int, x), CTRL, 0xF, 0xF, true)); }
__device__ __forceinline__ float dpp_sum8(float x) { x += dppf<0xB1>(x); x += dppf<0x4E>(x); x += dppf<0x141>(x); return x; }
__device__ __forceinline__ float dpp_sum16(float x) { x += dppf<0xB1>(x); x += dppf<0x4E>(x); x += dppf<0x141>(x); x += dppf<0x140>(x); return x; }
__device__ __forceinline__ float dpp_max8(float x) { x = fmaxf(x, dppf<0xB1>(x)); x = fmaxf(x, dppf<0x4E>(x)); x = fmaxf(x, dppf<0x141>(x)); return x; }
__device__ __forceinline__ float wave_sum(float v) {
#pragma unroll
    for (int o = 1; o < 64; o <<= 1) v += __shfl_xor(v, o);
    return v;
}
__device__ __forceinline__ float wave_max(float v) {
#pragma unroll
    for (int o = 1; o < 64; o <<= 1) v = fmaxf(v, __shfl_xor(v, o));
    return v;
}
#define LDS_WAIT() asm volatile("s_waitcnt lgkmcnt(0)" ::: "memory")
#define VM_WAIT() asm volatile("s_waitcnt vmcnt(0)" ::: "memory")

namespace pg8 {
constexpr int BM = 256, BK = 64, HALF = 128, HTB = HALF * BK * 2, STAGE_BYTES = 8 * HTB, NXCD = 8, WGM = 8;
__host__ __device__ __forceinline__ int lds_byte(int r, int c) { const int st = (r >> 4) * 2 + (c >> 5), rr = r & 15, cc = c & 31, ob = rr * 64 + cc * 2; return st * 1024 + (ob ^ (((ob >> 9) & 1) << 5)); }
__host__ __device__ __forceinline__ void stage_rc(int b, int& R, int& C) { const int st = b / 1024, sb = b % 1024, swz = sb ^ (((sb >> 9) & 1) << 5); R = (st >> 1) * 16 + swz / 64; C = (st & 1) * 32 + (swz % 64) / 2; }
__host__ __device__ __forceinline__ int perm32(int rho) { const int n = rho >> 4, i = rho & 15; return 8 * (i >> 2) + 4 * n + (i & 3); }

struct Unit { int pm, pn, e, i0; };

struct StaticOrder {
    int nM, nN, nwg, G, c;
    __device__ void init(int M_, int N_, int G_, int c_) { nM = M_ / BM; nN = N_ / BM; nwg = nM * nN; G = G_; c = c_; }
    __device__ bool next(int i, Unit& u) const {
        const long L = (long)i * G + c; if (L >= nwg) return false;
        int wgid = (int)L; { const int q = nwg / NXCD, r = nwg % NXCD, xcd = wgid % NXCD, off = wgid / NXCD; wgid = (xcd < r ? xcd * (q + 1) : r * (q + 1) + (xcd - r) * q) + off; }
        const int nig = WGM * nN, gid = wgid / nig, fm = gid * WGM, gsz = (nM - fm) < WGM ? (nM - fm) : WGM;
        u.pm = fm + ((wgid % nig) % gsz); u.pn = (wgid % nig) / gsz; u.e = 0; u.i0 = 0; return true;
    }
    __device__ __forceinline__ unsigned goff(const Unit&, int) const { return 0u; }
};

__device__ __forceinline__ unsigned cvt_pk_bf16(float lo, float hi) { unsigned r; asm volatile("v_cvt_pk_bf16_f32 %0, %1, %2" : "=v"(r) : "v"(lo), "v"(hi)); return r; }

template <class Epi, class Sched, bool ALIGN_EPI, bool GATHER>
__device__ __forceinline__ void gemm_phase(LAS unsigned char* lds, const bf16* Aall, const bf16* Ball, const int K, const Sched& S, const Epi& E) {
    const int tid = threadIdx.x, wid = __builtin_amdgcn_readfirstlane(tid >> 6), lane = tid & 63, wr = wid >> 2, wc = wid & 3, fr = lane & 15, fq = lane >> 4;
    const int nt = K / BK;
    int Ri[2], Ci[2]; unsigned voffB[2];
#pragma unroll
    for (int i = 0; i < 2; ++i) { stage_rc(tid * 16 + i * 8192, Ri[i], Ci[i]); const int Rb = Epi::PERM ? ((Ri[i] & ~31) + perm32(Ri[i] & 31)) : Ri[i]; voffB[i] = (unsigned)(Rb * K + Ci[i]) * 2u; }
    const size_t kstep = (size_t)(BK * 2);
    const size_t hstep = (size_t)HALF * K * 2;
    const size_t tstep = 2 * hstep;
    const unsigned ldsw = (unsigned)wid * 1024u;
    const int aoff = lds_byte(wr * 64 + fr, fq * 8), boff = lds_byte(wc * 32 + fr, fq * 8);
#define PG8_SA(b, h) (((b) * 2 + (h)) * HTB)
#define PG8_SB(b, h) ((4 + (b) * 2 + (h)) * HTB)
#define PG8_STAGE(bufoff, gbase, v0, v1) do { \
        __builtin_amdgcn_global_load_lds((const unsigned*)((const char*)(gbase) + (v0)), (LAS unsigned*)(lds + (bufoff) + ldsw), 16, 0, 0); \
        __builtin_amdgcn_global_load_lds((const unsigned*)((const char*)(gbase) + (v1)), (LAS unsigned*)(lds + (bufoff) + ldsw + 8192), 16, 0, 0); } while (0)
#define PG8_STAGE_B(bufoff, gbase) PG8_STAGE(bufoff, gbase, voffB[0], voffB[1])
#define PG8_LDA(dst, b, h) do { _Pragma("unroll") for (int m = 0; m < 4; ++m) _Pragma("unroll") for (int k = 0; k < 2; ++k) dst[m][k] = *(const LAS bf16x8*)(lds + PG8_SA(b, h) + aoff + m * 2048 + k * 1024); } while (0)
#define PG8_LDB(dst, b, h) do { _Pragma("unroll") for (int n = 0; n < 2; ++n) _Pragma("unroll") for (int k = 0; k < 2; ++k) dst[n][k] = *(const LAS bf16x8*)(lds + PG8_SB(b, h) + boff + n * 2048 + k * 1024); } while (0)
#define PG8_MMA(ai, bj, At, Bt) do { __builtin_amdgcn_s_setprio(1); _Pragma("unroll") for (int m = 0; m < 4; ++m) _Pragma("unroll") for (int n = 0; n < 2; ++n) _Pragma("unroll") for (int k = 0; k < 2; ++k) \
        acc[ai][bj][m][n] = __builtin_amdgcn_mfma_f32_16x16x32_bf16(Bt[n][k], At[m][k], acc[ai][bj][m][n], 0, 0, 0); __builtin_amdgcn_s_setprio(0); } while (0)
#define PG8_WAIT_V(n) asm volatile("s_waitcnt vmcnt(" #n ")" ::: "memory")
#define PG8_WAIT_L(n) asm volatile("s_waitcnt lgkmcnt(" #n ")" ::: "memory")
#define PG8_BAR __builtin_amdgcn_s_barrier()
#define PG8_SCHED __builtin_amdgcn_sched_barrier(0)
    Unit cur, nxt; int ui = 0;
    if (!S.next(0, cur)) return;
    f32x4 acc[2][2][4][2];
#pragma unroll
    for (int a = 0; a < 2; ++a)
#pragma unroll
        for (int b = 0; b < 2; ++b)
#pragma unroll
            for (int m = 0; m < 4; ++m)
#pragma unroll
                for (int n = 0; n < 2; ++n) acc[a][b][m][n] = (f32x4){0.f, 0.f, 0.f, 0.f};
    bf16x8 At[4][2], B0[2][2], B1[2][2];
    unsigned vc00, vc01, vc10, vc11, vn00, vn01, vn10, vn11;
    if constexpr (GATHER) {
        vc00 = S.goff(cur, Ri[0]) + (unsigned)Ci[0] * 2u; vc01 = S.goff(cur, Ri[1]) + (unsigned)Ci[1] * 2u;
        vc10 = S.goff(cur, 128 + Ri[0]) + (unsigned)Ci[0] * 2u; vc11 = S.goff(cur, 128 + Ri[1]) + (unsigned)Ci[1] * 2u;
    } else {
        vc00 = (unsigned)(Ri[0] * K + Ci[0]) * 2u; vc01 = (unsigned)(Ri[1] * K + Ci[1]) * 2u; vc10 = vc00 + (unsigned)hstep; vc11 = vc01 + (unsigned)hstep;
    }
    vn00 = vc00; vn01 = vc01; vn10 = vc10; vn11 = vc11;
    const char* cA = GATHER ? (const char*)Aall : (const char*)Aall + (size_t)cur.pm * tstep;
    const char* cB = (const char*)Ball + (size_t)cur.pn * tstep;
    PG8_STAGE_B(PG8_SB(0, 0), cB); PG8_STAGE_B(PG8_SB(0, 1), cB + hstep); PG8_STAGE(PG8_SA(0, 0), cA, vc00, vc01); PG8_STAGE(PG8_SA(0, 1), cA, vc10, vc11);
    if (wr == 1) PG8_BAR;
    PG8_WAIT_V(2); PG8_BAR;
    PG8_STAGE_B(PG8_SB(1, 0), cB + kstep); PG8_STAGE(PG8_SA(1, 0), cA + kstep, vc00, vc01); PG8_STAGE_B(PG8_SB(1, 1), cB + hstep + kstep);
    PG8_WAIT_V(6); PG8_BAR;
    for (;;) {
        const bool has_next = S.next(ui + 1, nxt);
        const char* nA = has_next ? (GATHER ? (const char*)Aall : (const char*)Aall + (size_t)nxt.pm * tstep) : cA;
        const char* nB = has_next ? (const char*)Ball + (size_t)nxt.pn * tstep : cB;
        if constexpr (GATHER) {
            if (has_next) {
                vn00 = S.goff(nxt, Ri[0]) + (unsigned)Ci[0] * 2u; vn01 = S.goff(nxt, Ri[1]) + (unsigned)Ci[1] * 2u;
                vn10 = S.goff(nxt, 128 + Ri[0]) + (unsigned)Ci[0] * 2u; vn11 = S.goff(nxt, 128 + Ri[1]) + (unsigned)Ci[1] * 2u;
            }
        }
        for (int t = 0; t < nt; t += 2) {
            const bool last = (t == nt - 2);
            const char* a1 = cA + (size_t)(t + 1) * kstep;
            const char* a2 = last ? nA : cA + (size_t)(t + 2) * kstep; const char* b2 = last ? nB : cB + (size_t)(t + 2) * kstep;
            const char* a3 = a2 + kstep; const char* b3 = b2 + kstep;
            const unsigned s00 = last ? vn00 : vc00, s01 = last ? vn01 : vc01, s10 = last ? vn10 : vc10, s11 = last ? vn11 : vc11;
            PG8_LDB(B0, 0, 0); PG8_LDB(B1, 0, 1); PG8_SCHED; PG8_LDA(At, 0, 0); PG8_STAGE(PG8_SA(1, 1), a1, vc10, vc11);
            PG8_WAIT_V(8); PG8_WAIT_L(0); PG8_BAR; PG8_MMA(0, 0, At, B0); PG8_MMA(0, 1, At, B1); PG8_BAR; PG8_SCHED;
            PG8_LDA(At, 0, 1); PG8_STAGE_B(PG8_SB(0, 0), b2); PG8_STAGE_B(PG8_SB(0, 1), b2 + hstep); PG8_STAGE(PG8_SA(0, 0), a2, s00, s01);
            PG8_WAIT_V(8); PG8_WAIT_L(0); PG8_BAR; PG8_MMA(1, 0, At, B0); PG8_MMA(1, 1, At, B1); PG8_BAR; PG8_SCHED;
            PG8_LDB(B0, 1, 0); PG8_LDB(B1, 1, 1); PG8_SCHED; PG8_LDA(At, 1, 0); PG8_STAGE(PG8_SA(0, 1), a2, s10, s11);
            PG8_WAIT_V(8); PG8_WAIT_L(0); PG8_BAR; PG8_MMA(0, 0, At, B0); PG8_MMA(0, 1, At, B1); PG8_BAR; PG8_SCHED;
            PG8_LDA(At, 1, 1); PG8_STAGE_B(PG8_SB(1, 0), b3); PG8_STAGE_B(PG8_SB(1, 1), b3 + hstep); PG8_STAGE(PG8_SA(1, 0), a3, s00, s01);
            PG8_WAIT_V(8); PG8_WAIT_L(0); PG8_BAR; PG8_MMA(1, 0, At, B0); PG8_MMA(1, 1, At, B1); PG8_BAR; PG8_SCHED;
        }
        if constexpr (ALIGN_EPI) { if (wr == 0) PG8_BAR; }
        E(acc, cur, wr, wc, fr, fq);
        if (!has_next) break;
#pragma unroll
        for (int a = 0; a < 2; ++a)
#pragma unroll
            for (int b = 0; b < 2; ++b)
#pragma unroll
                for (int m = 0; m < 4; ++m)
#pragma unroll
                    for (int n = 0; n < 2; ++n) acc[a][b][m][n] = (f32x4){0.f, 0.f, 0.f, 0.f};
        cur = nxt; cA = nA; cB = nB; ++ui;
        vc00 = vn00; vc01 = vn01; vc10 = vn10; vc11 = vn11;
        if constexpr (ALIGN_EPI) { if (wr == 1) PG8_BAR; }
    }
    PG8_WAIT_V(0);
    if constexpr (!ALIGN_EPI) { if (wr == 0) PG8_BAR; }
    PG8_BAR;
#undef PG8_SA
#undef PG8_SB
#undef PG8_STAGE
#undef PG8_STAGE_B
#undef PG8_LDA
#undef PG8_LDB
#undef PG8_MMA
#undef PG8_WAIT_V
#undef PG8_WAIT_L
#undef PG8_BAR
#undef PG8_SCHED
}
}

struct EpiStoreBf16 {
    static constexpr bool PERM = true;
    bf16* O; int ldc;
    __device__ __forceinline__ void operator()(const f32x4 (&acc)[2][2][4][2], const pg8::Unit& u, int wr, int wc, int fr, int fq) const {
        const int row0 = u.pm * 256 + wr * 64 + fr, col0 = u.pn * 256 + wc * 32 + 8 * fq;
#pragma unroll
        for (int ai = 0; ai < 2; ++ai)
#pragma unroll
            for (int m = 0; m < 4; ++m) { bf16* rowp = O + (size_t)(row0 + ai * 128 + m * 16) * ldc + col0;
#pragma unroll
                for (int bj = 0; bj < 2; ++bj) { const f32x4 v0 = acc[ai][bj][m][0], v1 = acc[ai][bj][m][1]; u32x4 w;
                    w.x = pg8::cvt_pk_bf16(v0[0], v0[1]); w.y = pg8::cvt_pk_bf16(v0[2], v0[3]); w.z = pg8::cvt_pk_bf16(v1[0], v1[1]); w.w = pg8::cvt_pk_bf16(v1[2], v1[3]);
                    *(u32x4*)(rowp + bj * 128) = w; } }
    }
};
template <bool ADD> struct EpiGate {
    static constexpr bool PERM = true;
    bf16* MG; const bf16* P; int gcol0;
    __device__ __forceinline__ void operator()(const f32x4 (&acc)[2][2][4][2], const pg8::Unit& u, int wr, int wc, int fr, int fq) const {
        const int row0 = u.pm * 256 + wr * 64 + fr, col0 = u.pn * 256 + wc * 32 + 8 * fq;
#pragma unroll
        for (int ai = 0; ai < 2; ++ai)
#pragma unroll
            for (int m = 0; m < 4; ++m) { const size_t row = (size_t)(row0 + ai * 128 + m * 16);
#pragma unroll
                for (int bj = 0; bj < 2; ++bj) { const int col = col0 + bj * 128;
                    const u32x4 g = *(const u32x4*)(P + row * PN + gcol0 + col);
                    float o[8]; const f32x4 v0 = acc[ai][bj][m][0], v1 = acc[ai][bj][m][1];
                    o[0] = v0[0] * sigmoidf_(bflo(g.x)); o[1] = v0[1] * sigmoidf_(bfhi(g.x)); o[2] = v0[2] * sigmoidf_(bflo(g.y)); o[3] = v0[3] * sigmoidf_(bfhi(g.y));
                    o[4] = v1[0] * sigmoidf_(bflo(g.z)); o[5] = v1[1] * sigmoidf_(bfhi(g.z)); o[6] = v1[2] * sigmoidf_(bflo(g.w)); o[7] = v1[3] * sigmoidf_(bfhi(g.w));
                    bf16* dst = MG + row * DM + col;
                    if (ADD) { const u32x4 p = *(const u32x4*)dst;
                        o[0] += bflo(p.x); o[1] += bfhi(p.x); o[2] += bflo(p.y); o[3] += bfhi(p.y); o[4] += bflo(p.z); o[5] += bfhi(p.z); o[6] += bflo(p.w); o[7] += bfhi(p.w); }
                    u32x4 w; w.x = pg8::cvt_pk_bf16(o[0], o[1]); w.y = pg8::cvt_pk_bf16(o[2], o[3]); w.z = pg8::cvt_pk_bf16(o[4], o[5]); w.w = pg8::cvt_pk_bf16(o[6], o[7]);
                    *(u32x4*)dst = w; } }
    }
};
struct EpiResid {
    static constexpr bool PERM = false;
    const float* X; float* O;
    __device__ __forceinline__ void operator()(const f32x4 (&acc)[2][2][4][2], const pg8::Unit& u, int wr, int wc, int fr, int fq) const {
        const int row0 = u.pm * 256 + wr * 64 + fr, col0 = u.pn * 256 + wc * 32 + 4 * fq;
#pragma unroll
        for (int ai = 0; ai < 2; ++ai)
#pragma unroll
            for (int m = 0; m < 4; ++m) { const size_t off = (size_t)(row0 + ai * 128 + m * 16) * DM + col0;
#pragma unroll
                for (int bj = 0; bj < 2; ++bj)
#pragma unroll
                    for (int n = 0; n < 2; ++n) { const f32x4 xv = *(const f32x4*)(X + off + bj * 128 + n * 16); *(f32x4*)(O + off + bj * 128 + n * 16) = xv + acc[ai][bj][m][n]; } }
    }
};
struct EpiMoe1 {
    static constexpr bool PERM = true;
    bf16* ACT; const float* b1;
    __device__ __forceinline__ void operator()(const f32x4 (&acc)[2][2][4][2], const pg8::Unit& u, int wr, int wc, int fr, int fq) const {
        const int pnl = u.pn & 7; const int row0 = u.pm * 256 + wr * 64 + fr, j0 = pnl * 128 + wc * 32 + 8 * fq;
        const float* bg = b1 + (size_t)u.e * 2048 + j0; const float* bl = bg + 1024;
        const f32x4 bg0 = *(const f32x4*)bg, bg1 = *(const f32x4*)(bg + 4), bl0 = *(const f32x4*)bl, bl1 = *(const f32x4*)(bl + 4);
#pragma unroll
        for (int ai = 0; ai < 2; ++ai)
#pragma unroll
            for (int m = 0; m < 4; ++m) { bf16* dst = ACT + (size_t)(row0 + ai * 128 + m * 16) * DE + j0; float o[8];
#pragma unroll
                for (int n = 0; n < 2; ++n) { const f32x4 gv = acc[ai][0][m][n] + (n ? bg1 : bg0), lv = acc[ai][1][m][n] + (n ? bl1 : bl0);
#pragma unroll
                    for (int k = 0; k < 4; ++k) { const float g = fminf(gv[k], 7.0f), l = fminf(fmaxf(lv[k], -7.0f), 7.0f); o[n * 4 + k] = g * sigmoidf_(1.702f * g) * (l + 1.0f); } }
                u32x4 w; w.x = pg8::cvt_pk_bf16(o[0], o[1]); w.y = pg8::cvt_pk_bf16(o[2], o[3]); w.z = pg8::cvt_pk_bf16(o[4], o[5]); w.w = pg8::cvt_pk_bf16(o[6], o[7]);
                *(u32x4*)dst = w; }
    }
};
struct EpiMoe2 {
    static constexpr bool PERM = true;
    bf16* YBUF; const float* b2; const int* list; const float* gw; const LAS int* tab;
    __device__ __forceinline__ void operator()(const f32x4 (&acc)[2][2][4][2], const pg8::Unit& u, int wr, int wc, int fr, int fq) const {
        const int pnl = u.pn & 3; const int rl0 = wr * 64 + fr, col0 = pnl * 256 + wc * 32 + 8 * fq; const int cnt = tab[u.e];
        f32x4 bv[2][2];
#pragma unroll
        for (int bj = 0; bj < 2; ++bj)
#pragma unroll
            for (int n = 0; n < 2; ++n) bv[bj][n] = *(const f32x4*)(b2 + (size_t)u.e * 1024 + col0 + bj * 128 + 4 * n);
#pragma unroll
        for (int ai = 0; ai < 2; ++ai)
#pragma unroll
            for (int m = 0; m < 4; ++m) { const int idx = u.i0 + rl0 + ai * 128 + m * 16;
                if (idx < cnt) { const int ent = list[(size_t)u.e * LISTCAP + idx]; const float w8 = gw[ent]; const int tok = ent >> 2, slot = ent & 3;
                    bf16* rowp = YBUF + ((size_t)slot * M + tok) * DM + col0;
#pragma unroll
                    for (int bj = 0; bj < 2; ++bj) { const f32x4 v0 = (acc[ai][bj][m][0] + bv[bj][0]) * w8, v1 = (acc[ai][bj][m][1] + bv[bj][1]) * w8; u32x4 w;
                        w.x = pg8::cvt_pk_bf16(v0[0], v0[1]); w.y = pg8::cvt_pk_bf16(v0[2], v0[3]); w.z = pg8::cvt_pk_bf16(v1[0], v1[1]); w.w = pg8::cvt_pk_bf16(v1[2], v1[3]);
                        *(u32x4*)(rowp + bj * 128) = w; } } }
    }
};
struct MoeOrder {
    int JP, x, j, TPX, NT, NPN; const LAS int* tab; const int* list;
    __device__ bool next(int i, pg8::Unit& u) const {
        const int q = i * JP + j; const int lt = q / NPN, pn = q % NPN; if (lt >= TPX) return false; const int gt = x * TPX + lt; if (gt >= NT) return false;
        int e = 0;
        for (int k = 1; k < NE; ++k) e += (tab[32 + k] <= gt) ? 1 : 0;
        e = __builtin_amdgcn_readfirstlane(e); const int ts = __builtin_amdgcn_readfirstlane(tab[32 + e]);
        u.pm = gt; u.pn = e * NPN + pn; u.e = e; u.i0 = (gt - ts) * 256; return true;
    }
    __device__ __forceinline__ unsigned goff(const pg8::Unit& u, int r) const {
        const int idx = u.i0 + r; int tok = 0; if (idx < tab[u.e]) tok = list[(size_t)u.e * LISTCAP + idx] >> 2; return (unsigned)tok * (unsigned)(DM * 2);
    }
};

#define XB_TMO      128
#define XB_XCNT(j)  (256  + 64 * (j))
#define XB_XSUB(j)  (1280 + 64 * (j))
#define XB_XGEN(j)  (2304 + 64 * (j))
#define XB_TOP      3328
#define XB_TOPGEN   3392
#define XCD_BAR_WORDS 3456
#define XB_SPIN_CAP (1u << 20)
__device__ __forceinline__ unsigned xb_ld(unsigned* p)              { return __hip_atomic_load(p, __ATOMIC_RELAXED, __HIP_MEMORY_SCOPE_AGENT); }
__device__ __forceinline__ unsigned xb_add(unsigned* p, unsigned v) { return __hip_atomic_fetch_add(p, v, __ATOMIC_RELAXED, __HIP_MEMORY_SCOPE_AGENT); }
__device__ __forceinline__ unsigned xb_xcc_id() { return (unsigned)__builtin_amdgcn_s_getreg((3 << 11) | 20) & 0xFu; }
#define XB_SPIN(cond, bar) do { unsigned _sp = 0; while (cond) { __builtin_amdgcn_s_sleep(1); \
    if ((++_sp & 255u) == 0u) { if (xb_ld(&(bar)[XB_TMO])) break; if (_sp > XB_SPIN_CAP) { atomicAdd(&(bar)[XB_TMO], 1u); break; } } } } while (0)
struct XcdBarrier { unsigned* bar; unsigned x; volatile LAS unsigned* st; };
__device__ __forceinline__ XcdBarrier xcd_barrier_post(unsigned* bar, volatile LAS unsigned* st) {
    XcdBarrier b; b.bar = bar; b.x = xb_xcc_id(); b.st = st;
    if (threadIdx.x == 0) (void)xb_add(&bar[XB_XCNT(b.x)], 1u);
    return b;
}
__device__ __forceinline__ void xcd_barrier_complete(unsigned* bar, unsigned x, unsigned& nloc, unsigned& nx) {
    const unsigned G = gridDim.x * gridDim.y * gridDim.z;
    unsigned sum, cnt, mine, sp = 0u;
    for (;;) {
        sum = 0u; cnt = 0u; mine = 0u;
#pragma unroll
        for (unsigned j = 0; j < 16; ++j) { const unsigned c = xb_ld(&bar[XB_XCNT(j)]); sum += c; cnt += (c > 0u) ? 1u : 0u; mine = (j == x) ? c : mine; }
        if (sum == G) break;
        __builtin_amdgcn_s_sleep(1);
        if ((++sp & 255u) == 0u) { if (xb_ld(&bar[XB_TMO])) break; if (sp > XB_SPIN_CAP) { atomicAdd(&bar[XB_TMO], 1u); break; } }
    }
    nloc = mine > 0u ? mine : 1u; nx = cnt > 0u ? cnt : 1u;
}
__device__ __forceinline__ void xcd_barrier(const XcdBarrier& b) {
    asm volatile("s_waitcnt vmcnt(0)" ::: "memory");
    __syncthreads();
    if (threadIdx.x == 0) {
        unsigned* bar = b.bar;
        __builtin_amdgcn_s_waitcnt(0);
        unsigned nloc = b.st[0], nx = b.st[1];
        if (nloc == 0u) { xcd_barrier_complete(bar, b.x, nloc, nx); b.st[0] = nloc; b.st[1] = nx; }
        const unsigned old = xb_add(&bar[XB_XSUB(b.x)], 1u);
        const unsigned gen = old / nloc;
        if (old + 1u == (gen + 1u) * nloc) {
            __builtin_amdgcn_fence(__ATOMIC_RELEASE, "agent");
            asm volatile("s_waitcnt vmcnt(0)" ::: "memory");
            const unsigned og = xb_add(&bar[XB_TOP], 1u);
            const unsigned tg = og / nx;
            if (og + 1u == (tg + 1u) * nx) xb_add(&bar[XB_TOPGEN], 1u);
            else XB_SPIN(xb_ld(&bar[XB_TOPGEN]) == tg, bar);
            __builtin_amdgcn_fence(__ATOMIC_ACQUIRE, "agent");
            xb_add(&bar[XB_XGEN(b.x)], 1u);
            asm volatile("s_waitcnt vmcnt(0)" ::: "memory");
        } else {
            XB_SPIN(xb_ld(&bar[XB_XGEN(b.x)]) == gen, bar);
            __builtin_amdgcn_fence(__ATOMIC_ACQUIRE, "agent");
            asm volatile("s_waitcnt vmcnt(0)" ::: "memory");
        }
    }
    __syncthreads();
}

struct Args { const float* in[32]; float* out; unsigned char* ws; int ph_lo, ph_hi, li, pad; };
enum { I_X = 0, I_GMIX, I_WIN, I_MUP, I_MUN, I_W0F, I_W2F, I_W0B, I_W2B, I_A0F, I_A2F, I_A0B, I_A2B, I_G2, I_KK, I_KA, I_RK, I_LNG, I_LNB, I_QG, I_KG, I_RPB,
       I_WA, I_WB, I_WO, I_GFFN, I_WR, I_BR, I_W1, I_B1, I_W2, I_B2 };

__device__ __forceinline__ void p0_transpose_item(const float* W, int K, int N, bf16* WT, int k0, int n0, int drow0, LAS float* scr, int lane) {
#pragma unroll 8
    for (int i = 0; i < 32; ++i) { const int kk = 2 * i + (lane >> 5); scr[kk * 33 + (lane & 31)] = W[(size_t)(k0 + kk) * N + n0 + (lane & 31)]; }
    LDS_WAIT(); asm volatile("" ::: "memory");
    const int c = lane & 7;
#pragma unroll
    for (int j = 0; j < 4; ++j) { const int n = (lane >> 3) + 8 * j; const LAS float* s = scr + (8 * c) * 33 + n;
        u32x4 o; o.x = pk2(s[0 * 33], s[1 * 33]); o.y = pk2(s[2 * 33], s[3 * 33]); o.z = pk2(s[4 * 33], s[5 * 33]); o.w = pk2(s[6 * 33], s[7 * 33]);
        *(GAS u32x4*)(WT + (size_t)(drow0 + n) * K + k0 + 8 * c) = o; }
    LDS_WAIT(); asm volatile("" ::: "memory");
}
__device__ __forceinline__ void phase_prologue(const Args& a, LAS unsigned char* lds, int G) {
    const int tid = threadIdx.x, lane = tid & 63, wave = tid >> 6;
    unsigned char* ws = a.ws;
    LAS float* scr = (LAS float*)(lds + wave * 16384);
    const int gw = blockIdx.x * 8 + wave, NGW = G * 8;
    constexpr int I_IN = 16 * 172, I_AB = 8 * 32, I_O = 16 * 32, I_1 = 32 * 16 * 64, I_2 = 32 * 16 * 32;
    constexpr int NITEMS = I_IN + 2 * I_AB + I_O + I_1 + I_2;
    const float* x = a.in[I_X]; const float* gmix = a.in[I_GMIX]; bf16* XN = (bf16*)(ws + WS_XN);
    f32x4 gm[4];
#pragma unroll
    for (int j = 0; j < 4; ++j) gm[j] = *(const f32x4*)(gmix + 256 * j + 4 * lane);
    for (int m = gw; m < M; m += NGW) {
        const GAS f32x4* xr = (const GAS f32x4*)(x + (size_t)m * DM) + lane;
        f32x4 v[4]; float s = 0.f;
#pragma unroll
        for (int j = 0; j < 4; ++j) { v[j] = xr[64 * j]; s += (v[j].x * v[j].x + v[j].y * v[j].y) + (v[j].z * v[j].z + v[j].w * v[j].w); }
        const float rstd = 1.0f / sqrtf(wave_sum(s) * (1.f / DM) + RMS_EPS);
        GAS u32x2* o8 = (GAS u32x2*)(XN + (size_t)m * DM) + lane;
#pragma unroll
        for (int j = 0; j < 4; ++j) { u32x2 o; o.x = pk2(v[j].x * rstd * gm[j].x, v[j].y * rstd * gm[j].y); o.y = pk2(v[j].z * rstd * gm[j].z, v[j].w * rstd * gm[j].w); o8[64 * j] = o; }
    }
    for (int it = gw; it < NITEMS; it += NGW) {
        int r = it;
        if (r < I_IN) { const int kb = r / 172, nb = r % 172; p0_transpose_item(a.in[I_WIN], 1024, IN_COLS, (bf16*)(ws + WS_WIN), 64 * kb, 32 * nb, 32 * nb, scr, lane); continue; } r -= I_IN;
        if (r < I_AB) { const int kb = r / 32, nb = r % 32; p0_transpose_item(a.in[I_WA], 512, 1024, (bf16*)(ws + WS_WA), 64 * kb, 32 * nb, 32 * nb, scr, lane); continue; } r -= I_AB;
        if (r < I_AB) { const int kb = r / 32, nb = r % 32; p0_transpose_item(a.in[I_WB], 512, 1024, (bf16*)(ws + WS_WB), 64 * kb, 32 * nb, 32 * nb, scr, lane); continue; } r -= I_AB;
        if (r < I_O) { const int kb = r / 32, nb = r % 32; p0_transpose_item(a.in[I_WO], 1024, 1024, (bf16*)(ws + WS_WO), 64 * kb, 32 * nb, 32 * nb, scr, lane); continue; } r -= I_O;
        if (r < I_1) { const int e = r / 1024, rr = r % 1024, kb = rr / 64, nb = rr % 64; const int c0 = 32 * nb;
            const int drow = 256 * ((c0 & 1023) >> 7) + 128 * (c0 >> 10) + (c0 & 127);
            p0_transpose_item(a.in[I_W1] + (size_t)e * 1024 * 2048, 1024, 2048, (bf16*)(ws + WS_W1) + (size_t)e * 2048 * 1024, 64 * kb, c0, drow, scr, lane); continue; } r -= I_1;
        { const int e = r / 512, rr = r % 512, kb = rr / 32, nb = rr % 32;
            p0_transpose_item(a.in[I_W2] + (size_t)e * 1024 * 1024, 1024, 1024, (bf16*)(ws + WS_W2) + (size_t)e * 1024 * 1024, 64 * kb, 32 * nb, 32 * nb, scr, lane); }
    }
    { GAS u32x4* z = (GAS u32x4*)((bf16*)(ws + WS_WIN) + (size_t)IN_COLS * 1024);
      for (int i = blockIdx.x * 512 + tid; i < 16384; i += G * 512) z[i] = (u32x4){0u, 0u, 0u, 0u}; }
}

__device__ __forceinline__ f32x4 shift4(u32x2 pc, u32x2 pp, u32x2 pn, f32x4 mup, f32x4 mun) {
    f32x4 c = {bflo(pc.x), bfhi(pc.x), bflo(pc.y), bfhi(pc.y)}, p = {bflo(pp.x), bfhi(pp.x), bflo(pp.y), bfhi(pp.y)}, n = {bflo(pn.x), bfhi(pn.x), bflo(pn.y), bfhi(pn.y)};
    return c + mup * (p - c) + mun * (n - c);
}
__device__ __forceinline__ void phase_scan_unit(const Args& a, LAS unsigned char* lds, int unit) {
    const int tid = threadIdx.x;
    const int b = unit >> 4, h = (unit >> 1) & 7, dir = unit & 1;
    unsigned char* ws = a.ws;
    const bf16* P = (const bf16*)(ws + WS_P);
    float* Odir = (float*)(ws + (dir ? WS_OB : WS_OF));
    float* CFB = (float*)(ws + WS_CFB);
    LAS float* W2S = (LAS float*)(lds);
    LAS float* A2S = (LAS float*)(lds + 16384);
    LAS float* XLW = (LAS float*)(lds + 32768);
    LAS float* XLA = (LAS float*)(lds + 40960);
    LAS float* AR = (LAS float*)(lds + 49152);
    LAS float* AKD = AR + 2048; LAS float* AW = AR + 4096; LAS float* ABB = AR + 6144; LAS float* AKK = AR + 8192; LAS float* AV = AR + 10240;
    LAS float* OBUF = AR + 12288;
    const float* w2 = a.in[dir ? I_W2B : I_W2F]; const float* a2 = a.in[dir ? I_A2B : I_A2F];
    __syncthreads();
#pragma unroll
    for (int i = 0; i < 8; ++i) { const int idx = tid + 512 * i, j = idx >> 6, n = idx & 63; W2S[idx] = w2[j * 512 + h * 64 + n]; A2S[idx] = a2[j * 512 + h * 64 + n]; }
    const int tl = tid >> 4, cg = tid & 15, c4 = 4 * cg;
    const float* mup = a.in[I_MUP]; const float* mun = a.in[I_MUN];
    const int segc[5] = {C_R + h * 64 + c4, C_K + h * 64 + c4, C_V + h * 64 + c4, C_LWF + dir * 64 + c4, C_LAF + dir * 64 + c4};
    f32x4 mp[5], mn[5];
#pragma unroll
    for (int s = 0; s < 5; ++s) { mp[s] = *(const f32x4*)(mup + segc[s]); mn[s] = *(const f32x4*)(mun + segc[s]); }
    const int hc = h * 64 + c4;
    const f32x4 w0v = *(const f32x4*)(a.in[dir ? I_W0B : I_W0F] + hc), a0v = *(const f32x4*)(a.in[dir ? I_A0B : I_A0F] + hc);
    const f32x4 kkv = *(const f32x4*)(a.in[I_KK] + hc), kav = *(const f32x4*)(a.in[I_KA] + hc), rkv = *(const f32x4*)(a.in[I_RK] + hc);
    const int rp = tid >> 4, ks = tid & 15;
    float S0[4] = {0.f, 0.f, 0.f, 0.f}, S1[4] = {0.f, 0.f, 0.f, 0.f};
    for (int ci = 0; ci < SEQ / 32; ++ci) {
        const int t0 = dir ? (SEQ - 32 * (ci + 1)) : 32 * ci;
        const int t = t0 + tl;
        const size_t m = (size_t)b * SEQ + t;
        const bf16* prow = P + m * PN;
        const bool hp = t > 0, hn = t < SEQ - 1;
        f32x4 xs[5];
#pragma unroll
        for (int s = 0; s < 5; ++s) {
            const u32x2 pc = *(const u32x2*)(prow + segc[s]);
            u32x2 pp = {0u, 0u}, pn = {0u, 0u};
            if (hp) pp = *(const u32x2*)(prow - PN + segc[s]);
            if (hn) pn = *(const u32x2*)(prow + PN + segc[s]);
            xs[s] = shift4(pc, pp, pn, mp[s], mn[s]);
        }
        f32x4 tlw; tlw.x = tanhf(xs[3].x); tlw.y = tanhf(xs[3].y); tlw.z = tanhf(xs[3].z); tlw.w = tanhf(xs[3].w);
        *(LAS f32x4*)(XLW + tl * 64 + c4) = tlw;
        *(LAS f32x4*)(XLA + tl * 64 + c4) = xs[4];
        __syncthreads();
        f32x4 accw = {0.f, 0.f, 0.f, 0.f}, acca = {0.f, 0.f, 0.f, 0.f};
#pragma unroll 8
        for (int j = 0; j < 64; ++j) { const float lw = XLW[tl * 64 + j], la = XLA[tl * 64 + j];
            accw += lw * *(const LAS f32x4*)(W2S + j * 64 + c4); acca += la * *(const LAS f32x4*)(A2S + j * 64 + c4); }
        f32x4 dec, av, kkn, kd, bb;
        const f32x4 xr = xs[0], xk = xs[1], xv = xs[2];
        float ss = 0.f;
#pragma unroll
        for (int k = 0; k < 4; ++k) { dec[k] = __expf(-DECAY_SCALE * sigmoidf_(w0v[k] + accw[k])); av[k] = sigmoidf_(a0v[k] + acca[k]); kkn[k] = xk[k] * kkv[k]; ss += kkn[k] * kkn[k]; }
        ss = dpp_sum16(ss);
        const float inv = 1.0f / fmaxf(sqrtf(ss), 1e-12f);
        float cb = 0.f;
#pragma unroll
        for (int k = 0; k < 4; ++k) { kkn[k] *= inv; kd[k] = xk[k] * (1.0f + (av[k] - 1.0f) * kav[k]); bb[k] = kkn[k] * av[k]; cb += xr[k] * kd[k] * rkv[k]; }
        cb = dpp_sum16(cb);
        if (cg == 0) CFB[m * 16 + h * 2 + dir] = cb;
        *(LAS f32x4*)(AR + tl * 64 + c4) = xr; *(LAS f32x4*)(AKD + tl * 64 + c4) = kd; *(LAS f32x4*)(AW + tl * 64 + c4) = dec;
        *(LAS f32x4*)(ABB + tl * 64 + c4) = bb; *(LAS f32x4*)(AKK + tl * 64 + c4) = kkn; *(LAS f32x4*)(AV + tl * 64 + c4) = xv;
        __syncthreads();
#pragma unroll 4
        for (int s = 0; s < 32; ++s) {
            const int q = dir ? 31 - s : s;
            const f32x4 kk4 = *(const LAS f32x4*)(AKK + q * 64 + 4 * ks), w4 = *(const LAS f32x4*)(AW + q * 64 + 4 * ks), b4 = *(const LAS f32x4*)(ABB + q * 64 + 4 * ks);
            const f32x4 kd4 = *(const LAS f32x4*)(AKD + q * 64 + 4 * ks), r4 = *(const LAS f32x4*)(AR + q * 64 + 4 * ks);
            const f32x2 v2 = *(const LAS f32x2*)(AV + q * 64 + 2 * rp);
            float sa0 = (S0[0] * kk4[0] + S0[1] * kk4[1]) + (S0[2] * kk4[2] + S0[3] * kk4[3]);
            float sa1 = (S1[0] * kk4[0] + S1[1] * kk4[1]) + (S1[2] * kk4[2] + S1[3] * kk4[3]);
            sa0 = -dpp_sum16(sa0); sa1 = -dpp_sum16(sa1);
            float o0 = 0.f, o1 = 0.f;
#pragma unroll
            for (int k = 0; k < 4; ++k) {
                S0[k] = S0[k] * w4[k] + sa0 * b4[k] + v2.x * kd4[k]; S1[k] = S1[k] * w4[k] + sa1 * b4[k] + v2.y * kd4[k];
                o0 += S0[k] * r4[k]; o1 += S1[k] * r4[k]; }
            o0 = dpp_sum16(o0); o1 = dpp_sum16(o1);
            if (ks == 0) *(LAS f32x2*)(OBUF + q * 64 + 2 * rp) = (f32x2){o0, o1};
        }
        __syncthreads();
        *(f32x4*)(Odir + ((size_t)b * SEQ + t0 + tl) * DA + h * 64 + c4) = *(const LAS f32x4*)(OBUF + tl * 64 + c4);
    }
    __syncthreads();
}

__device__ __forceinline__ void phase_na_unit(const Args& a, LAS unsigned char* lds, int unit) {
    const int tid = threadIdx.x;
    const int b = unit >> 8, h = (unit >> 5) & 7, r = unit & 31;
    const int rs = min(max(r - 4, 0), 24);
    unsigned char* ws = a.ws;
    const bf16* P = (const bf16*)(ws + WS_P);
    bf16* YB = (bf16*)(ws + WS_YB);
    LAS unsigned char* Ks = lds; LAS unsigned char* Vs = lds + 65536;
    const int q = tid >> 3, dp = tid & 7;
    __syncthreads();
    {
        const f32x4 g0 = *(const f32x4*)(a.in[I_KG] + 8 * dp), g1 = *(const f32x4*)(a.in[I_KG] + 8 * dp + 4);
#pragma unroll 2
        for (int ps = 0; ps < 8; ++ps) {
            const int key = ps * 64 + q;
            const size_t tok = (size_t)b * SEQ + (rs + ps) * 64 + q;
            const u32x4 kc = *(const u32x4*)(P + tok * PN + C_BK + h * 64 + 8 * dp);
            const u32x4 vc = *(const u32x4*)(P + tok * PN + C_BV + h * 64 + 8 * dp);
            const float e0 = bflo(kc.x), e1 = bfhi(kc.x), e2 = bflo(kc.y), e3 = bfhi(kc.y), e4 = bflo(kc.z), e5 = bfhi(kc.z), e6 = bflo(kc.w), e7 = bfhi(kc.w);
            float ss = (e0 * e0 + e1 * e1) + (e2 * e2 + e3 * e3) + (e4 * e4 + e5 * e5) + (e6 * e6 + e7 * e7);
            ss = dpp_sum8(ss);
            const float rk = 1.0f / sqrtf(ss * (1.f / 64.f) + RMS_EPS);
            u32x4 o; o.x = pk2(e0 * rk * g0.x, e1 * rk * g0.y); o.y = pk2(e2 * rk * g0.z, e3 * rk * g0.w); o.z = pk2(e4 * rk * g1.x, e5 * rk * g1.y); o.w = pk2(e6 * rk * g1.z, e7 * rk * g1.w);
            *(LAS u32x4*)(Ks + key * 128 + dp * 16) = o;
            *(LAS u32x4*)(Vs + key * 128 + dp * 16) = vc;
        }
    }
    __syncthreads();
    const size_t qtok = (size_t)b * SEQ + r * 64 + q;
    float qh[8];
    {
        const u32x4 v = *(const u32x4*)(P + qtok * PN + C_Q + h * 64 + 8 * dp);
        qh[0] = bflo(v.x); qh[1] = bfhi(v.x); qh[2] = bflo(v.y); qh[3] = bfhi(v.y); qh[4] = bflo(v.z); qh[5] = bfhi(v.z); qh[6] = bflo(v.w); qh[7] = bfhi(v.w);
        float ss = 0.f;
#pragma unroll
        for (int d = 0; d < 8; ++d) ss += qh[d] * qh[d];
        ss = dpp_sum8(ss);
        const float rq = 0.125f / sqrtf(ss * (1.f / 64.f) + RMS_EPS);
        const float* qg = a.in[I_QG] + 8 * dp;
#pragma unroll
        for (int d = 0; d < 8; ++d) qh[d] *= rq * qg[d];
    }
    const int cs = min(max(q - 8, 0), 48);
    const float* rpb = a.in[I_RPB] + ((size_t)h * 15 + (rs - r + 7)) * 31 + (cs - q + 15);
    const LAS unsigned char* kb = Ks + cs * 128 + dp * 16;
    const LAS unsigned char* vb = Vs + cs * 128 + dp * 16;
    float mx = -1e30f, sum = 0.f;
    float acc[8];
#pragma unroll
    for (int d = 0; d < 8; ++d) acc[d] = 0.f;
#pragma unroll 1
    for (int ri = 0; ri < 8; ++ri) {
        float sc[16]; float rmx = -1e30f;
#pragma unroll
        for (int j = 0; j < 16; ++j) {
            const u32x4 kv = *(const LAS u32x4*)(kb + (ri * 64 + j) * 128);
            float dot = (qh[0] * bflo(kv.x) + qh[1] * bfhi(kv.x)) + (qh[2] * bflo(kv.y) + qh[3] * bfhi(kv.y)) + (qh[4] * bflo(kv.z) + qh[5] * bfhi(kv.z)) + (qh[6] * bflo(kv.w) + qh[7] * bfhi(kv.w));
            dot = dpp_sum8(dot) + rpb[ri * 31 + j];
            sc[j] = dot; rmx = fmaxf(rmx, dot);
        }
        const float mnew = fmaxf(mx, rmx); const float scale = __expf(mx - mnew); mx = mnew;
        sum *= scale;
#pragma unroll
        for (int d = 0; d < 8; ++d) acc[d] *= scale;
#pragma unroll
        for (int j = 0; j < 16; ++j) {
            const u32x4 vv = *(const LAS u32x4*)(vb + (ri * 64 + j) * 128); const float p = __expf(sc[j] - mnew); sum += p;
            acc[0] += p * bflo(vv.x); acc[1] += p * bfhi(vv.x); acc[2] += p * bflo(vv.y); acc[3] += p * bfhi(vv.y);
            acc[4] += p * bflo(vv.z); acc[5] += p * bfhi(vv.z); acc[6] += p * bflo(vv.w); acc[7] += p * bfhi(vv.w);
        }
    }
    const float rinv = 1.0f / sum;
    u32x4 o; o.x = pk2(acc[0] * rinv, acc[1] * rinv); o.y = pk2(acc[2] * rinv, acc[3] * rinv); o.z = pk2(acc[4] * rinv, acc[5] * rinv); o.w = pk2(acc[6] * rinv, acc[7] * rinv);
    *(u32x4*)(YB + qtok * DA + h * 64 + 8 * dp) = o;
}

__device__ __forceinline__ void phase_combine(const Args& a, LAS unsigned char* lds, int G) {
    const int tid = threadIdx.x;
    unsigned char* ws = a.ws;
    const bf16* P = (const bf16*)(ws + WS_P);
    const float* OF = (const float*)(ws + WS_OF); const float* OB = (const float*)(ws + WS_OB); const float* CFB = (const float*)(ws + WS_CFB);
    bf16* YA = (bf16*)(ws + WS_YA);
    LAS unsigned char* G2B = lds;
    LAS float* SIG = (LAS float*)(lds + 131072);
    const float* g2 = a.in[I_G2];
    __syncthreads();
#pragma unroll 4
    for (int i = 0; i < 32; ++i) { const int idx = tid * 4 + 2048 * i; const f32x4 v = *(const f32x4*)(g2 + idx); u32x2 o; o.x = pk2(v.x, v.y); o.y = pk2(v.z, v.w); *(LAS u32x2*)(G2B + idx * 2) = o; }
    const float* mup = a.in[I_MUP]; const float* mun = a.in[I_MUN];
    const int ng = tid & 63, ts = tid >> 6, c0 = 8 * ng, hh = ng >> 3;
    f32x4 lg0 = *(const f32x4*)(a.in[I_LNG] + c0), lg1 = *(const f32x4*)(a.in[I_LNG] + c0 + 4), lb0 = *(const f32x4*)(a.in[I_LNB] + c0), lb1 = *(const f32x4*)(a.in[I_LNB] + c0 + 4);
    f32x4 mpv0 = *(const f32x4*)(mup + C_V + c0), mpv1 = *(const f32x4*)(mup + C_V + c0 + 4), mnv0 = *(const f32x4*)(mun + C_V + c0), mnv1 = *(const f32x4*)(mun + C_V + c0 + 4);
    const int st = tid >> 5, sj = (tid & 31) * 4;
    const f32x4 mpg = *(const f32x4*)(mup + C_LG + sj), mng = *(const f32x4*)(mun + C_LG + sj);
    for (int grp = blockIdx.x; grp < M / 16; grp += G) {
        const int m0 = grp * 16;
        __syncthreads();
        {   const int m = m0 + st, t = m & (SEQ - 1); const bf16* prow = P + (size_t)m * PN + C_LG + sj;
            const u32x2 pc = *(const u32x2*)prow; u32x2 pp = {0u, 0u}, pn = {0u, 0u};
            if (t > 0) pp = *(const u32x2*)(prow - PN); if (t < SEQ - 1) pn = *(const u32x2*)(prow + PN);
            f32x4 xa = shift4(pc, pp, pn, mpg, mng); xa.x = sigmoidf_(xa.x); xa.y = sigmoidf_(xa.y); xa.z = sigmoidf_(xa.z); xa.w = sigmoidf_(xa.w);
            *(LAS f32x4*)(SIG + st * 128 + sj) = xa; }
        __syncthreads();
        float g0[8], g1[8];
#pragma unroll
        for (int k = 0; k < 8; ++k) { g0[k] = 0.f; g1[k] = 0.f; }
#pragma unroll 4
        for (int j = 0; j < 128; ++j) { const u32x4 gv = *(const LAS u32x4*)(G2B + (j * 512 + c0) * 2); const float s0 = SIG[(2 * ts) * 128 + j], s1 = SIG[(2 * ts + 1) * 128 + j];
            const float e[8] = {bflo(gv.x), bfhi(gv.x), bflo(gv.y), bfhi(gv.y), bflo(gv.z), bfhi(gv.z), bflo(gv.w), bfhi(gv.w)};
#pragma unroll
            for (int k = 0; k < 8; ++k) { g0[k] += s0 * e[k]; g1[k] += s1 * e[k]; } }
#pragma unroll
        for (int tk = 0; tk < 2; ++tk) {
            const int m = m0 + 2 * ts + tk, t = m & (SEQ - 1);
            const f32x4 f0 = *(const f32x4*)(OF + (size_t)m * DA + c0), f1 = *(const f32x4*)(OF + (size_t)m * DA + c0 + 4);
            const f32x4 b0 = *(const f32x4*)(OB + (size_t)m * DA + c0), b1 = *(const f32x4*)(OB + (size_t)m * DA + c0 + 4);
            float o[8] = {f0.x + b0.x, f0.y + b0.y, f0.z + b0.z, f0.w + b0.w, f1.x + b1.x, f1.y + b1.y, f1.z + b1.z, f1.w + b1.w};
            float s = 0.f;
#pragma unroll
            for (int k = 0; k < 8; ++k) s += o[k];
            const float mu = dpp_sum8(s) * (1.f / 64.f);
            float vq = 0.f;
#pragma unroll
            for (int k = 0; k < 8; ++k) { o[k] -= mu; vq += o[k] * o[k]; }
            const float rstd = 1.0f / sqrtf(dpp_sum8(vq) * (1.f / 64.f) + GN_EPS);
            const float cfb = CFB[(size_t)m * 16 + hh * 2] + CFB[(size_t)m * 16 + hh * 2 + 1];
            const bf16* prow = P + (size_t)m * PN + C_V + c0;
            const u32x4 pc = *(const u32x4*)prow; u32x4 pp = {0u, 0u, 0u, 0u}, pn = {0u, 0u, 0u, 0u};
            if (t > 0) pp = *(const u32x4*)(prow - PN); if (t < SEQ - 1) pn = *(const u32x4*)(prow + PN);
            const f32x4 xv0 = shift4((u32x2){pc.x, pc.y}, (u32x2){pp.x, pp.y}, (u32x2){pn.x, pn.y}, mpv0, mnv0), xv1 = shift4((u32x2){pc.z, pc.w}, (u32x2){pp.z, pp.w}, (u32x2){pn.z, pn.w}, mpv1, mnv1);
            const float xv[8] = {xv0.x, xv0.y, xv0.z, xv0.w, xv1.x, xv1.y, xv1.z, xv1.w};
            const float lgv[8] = {lg0.x, lg0.y, lg0.z, lg0.w, lg1.x, lg1.y, lg1.z, lg1.w}, lbv[8] = {lb0.x, lb0.y, lb0.z, lb0.w, lb1.x, lb1.y, lb1.z, lb1.w};
            float y[8];
#pragma unroll
            for (int k = 0; k < 8; ++k) y[k] = (o[k] * rstd * lgv[k] + lbv[k] + cfb * xv[k]) * (tk ? g1[k] : g0[k]);
            u32x4 w; w.x = pk2(y[0], y[1]); w.y = pk2(y[2], y[3]); w.z = pk2(y[4], y[5]); w.w = pk2(y[6], y[7]);
            *(u32x4*)(YA + (size_t)m * DA + c0) = w;
        }
    }
    __syncthreads();
}

__device__ __forceinline__ void phase_router(const Args& a, LAS unsigned char* lds, int G) {
    const int tid = threadIdx.x, lane = tid & 63, wave = tid >> 6;
    unsigned char* ws = a.ws;
    const float* X1 = a.out; bf16* H2 = (bf16*)(ws + WS_XN);
    int* list = (int*)(ws + WS_LIST); float* gwt = (float*)(ws + WS_GW);
    unsigned* cnt = (unsigned*)(ws + WS_CTL) + CW_CNT;
    LAS float* WRT = (LAS float*)lds;
    LAS int* rowE = (LAS int*)(lds + 131584); LAS float* rowW = (LAS float*)(lds + 133632); LAS int* rowPos = (LAS int*)(lds + 135680);
    LAS int* bcnt = (LAS int*)(lds + 137728); LAS int* bbase = (LAS int*)(lds + 137856);
    const float* wr = a.in[I_WR];
    __syncthreads();
    for (int i = 0; i < 64; ++i) { const int idx = tid + 512 * i; WRT[(idx & 31) * 1028 + (idx >> 5)] = wr[idx]; }
    f32x4 gf[4];
#pragma unroll
    for (int j = 0; j < 4; ++j) gf[j] = *(const f32x4*)(a.in[I_GFFN] + 256 * j + 4 * lane);
    const float brl = a.in[I_BR][(lane >> 1) & 31];
    for (int grp = blockIdx.x; grp < M / 128; grp += G) {
        __syncthreads();
        if (tid < 32) bcnt[tid] = 0;
        __syncthreads();
        for (int rr = 0; rr < 16; ++rr) {
            const int rl = wave * 16 + rr, m = grp * 128 + rl;
            const f32x4* xr = (const f32x4*)(X1 + (size_t)m * DM) + lane;
            f32x4 v[4]; float s = 0.f;
#pragma unroll
            for (int j = 0; j < 4; ++j) { v[j] = xr[64 * j]; s += (v[j].x * v[j].x + v[j].y * v[j].y) + (v[j].z * v[j].z + v[j].w * v[j].w); }
            const float rstd = 1.0f / sqrtf(wave_sum(s) * (1.f / DM) + RMS_EPS);
            u32x2* o8 = (u32x2*)(H2 + (size_t)m * DM) + lane;
#pragma unroll
            for (int j = 0; j < 4; ++j) { v[j] = v[j] * rstd * gf[j]; u32x2 o; o.x = pk2(v[j].x, v[j].y); o.y = pk2(v[j].z, v[j].w); o8[64 * j] = o; }
            float p[32];
#pragma unroll
            for (int e = 0; e < 32; ++e) { float acc = 0.f;
#pragma unroll
                for (int j = 0; j < 4; ++j) { const f32x4 w = *(const LAS f32x4*)(WRT + e * 1028 + 256 * j + 4 * lane); acc += (v[j].x * w.x + v[j].y * w.y) + (v[j].z * w.z + v[j].w * w.w); }
                p[e] = acc; }
            {   const bool h5 = (lane & 32) != 0;
#pragma unroll
                for (int i = 0; i < 16; ++i) { const float send = h5 ? p[i] : p[i + 16], keep = h5 ? p[i + 16] : p[i]; p[i] = keep + __shfl_xor(send, 32); }
                const bool h4 = (lane & 16) != 0;
#pragma unroll
                for (int i = 0; i < 8; ++i) { const float send = h4 ? p[i] : p[i + 8], keep = h4 ? p[i + 8] : p[i]; p[i] = keep + __shfl_xor(send, 16); }
                const bool h3 = (lane & 8) != 0;
#pragma unroll
                for (int i = 0; i < 4; ++i) { const float send = h3 ? p[i] : p[i + 4], keep = h3 ? p[i + 4] : p[i]; p[i] = keep + __shfl_xor(send, 8); }
                const bool h2 = (lane & 4) != 0;
#pragma unroll
                for (int i = 0; i < 2; ++i) { const float send = h2 ? p[i] : p[i + 2], keep = h2 ? p[i + 2] : p[i]; p[i] = keep + __shfl_xor(send, 4); }
                const bool h1 = (lane & 2) != 0;
                { const float send = h1 ? p[0] : p[1], keep = h1 ? p[1] : p[0]; p[0] = keep + __shfl_xor(send, 2); }
                p[0] += __shfl_xor(p[0], 1);
            }
            float val = p[0] + brl;
            int te[4]; float tv[4];
#pragma unroll
            for (int i = 0; i < 4; ++i) { const float mxv = wave_max(val); const unsigned long long mk = __ballot(val == mxv); const int src = __ffsll((long long)mk) - 1; te[i] = src >> 1; tv[i] = mxv; if ((lane >> 1) == te[i]) val = -3.0e38f; }
            const float e1 = __expf(tv[1] - tv[0]), e2 = __expf(tv[2] - tv[0]), e3 = __expf(tv[3] - tv[0]); const float den = 1.0f / (1.0f + e1 + e2 + e3);
            if (lane < 4) { const int ee = lane == 0 ? te[0] : lane == 1 ? te[1] : lane == 2 ? te[2] : te[3]; const float wv = (lane == 0 ? 1.0f : lane == 1 ? e1 : lane == 2 ? e2 : e3) * den;
                const int pos = __hip_atomic_fetch_add(bcnt + ee, 1, __ATOMIC_RELAXED, __HIP_MEMORY_SCOPE_WORKGROUP);
                rowE[rl * 4 + lane] = ee; rowW[rl * 4 + lane] = wv; rowPos[rl * 4 + lane] = pos; }
        }
        __syncthreads();
        if (tid < 32) bbase[tid] = (int)__hip_atomic_fetch_add(cnt + 64 * tid, (unsigned)bcnt[tid], __ATOMIC_RELAXED, __HIP_MEMORY_SCOPE_AGENT);
        __syncthreads();
        { const int rl = tid >> 2, i = tid & 3, m = grp * 128 + rl; const int e = rowE[tid], pos = bbase[e] + rowPos[tid];
          list[(size_t)e * LISTCAP + pos] = m * 4 + i; gwt[(size_t)m * 4 + i] = rowW[tid]; }
    }
    __syncthreads();
}

__device__ __forceinline__ int moe_table(const Args& a, LAS unsigned char* lds) {
    LAS int* tab = (LAS int*)(lds + MISC_OFF) + 16;
    unsigned* cnt = (unsigned*)(a.ws + WS_CTL) + CW_CNT;
    __syncthreads();
    if (threadIdx.x < 32) tab[threadIdx.x] = (int)__hip_atomic_load(cnt + 64 * threadIdx.x, __ATOMIC_RELAXED, __HIP_MEMORY_SCOPE_AGENT);
    __syncthreads();
    if (threadIdx.x == 0) { int s = 0; for (int e = 0; e < NE; ++e) { tab[32 + e] = s; s += (tab[e] + 255) >> 8; } tab[32 + NE] = s; }
    __syncthreads();
    return tab[32 + NE];
}

__device__ __forceinline__ void phase_final(const Args& a, int G) {
    const int tid = threadIdx.x, lane = tid & 63, wave = tid >> 6;
    const bf16* YBUF = (const bf16*)(a.ws + WS_YBUF); float* out = a.out;
    const int gw = blockIdx.x * 8 + wave, NGW = G * 8;
    for (int m = gw; m < M; m += NGW) {
        f32x4* xr = (f32x4*)(out + (size_t)m * DM) + lane;
#pragma unroll
        for (int j = 0; j < 4; ++j) { f32x4 v = xr[64 * j];
#pragma unroll
            for (int s = 0; s < 4; ++s) { const u32x2 y = *((const u32x2*)(YBUF + ((size_t)s * M + m) * DM) + lane + 64 * j); v.x += bflo(y.x); v.y += bfhi(y.x); v.z += bflo(y.y); v.w += bfhi(y.y); }
            xr[64 * j] = v; }
    }
}

constexpr int N_PHASES = 10;
__global__ void __launch_bounds__(512, 2) mk_fwd(Args args) {
    extern __shared__ __attribute__((aligned(16))) unsigned char lds_raw[];
    LAS unsigned char* lds = (LAS unsigned char*)lds_raw;
    const int tid = threadIdx.x; const int G = gridDim.x;
    unsigned char* ws = args.ws;
    volatile LAS unsigned* MISC = (volatile LAS unsigned*)(lds + MISC_OFF);
    for (int u = tid; u < 256; u += 512) MISC[u] = 0u;
    __syncthreads();
    const int lo = args.ph_lo, hi = args.ph_hi;
    XcdBarrier bar; bar.bar = (unsigned*)(ws + WS_CTL) + CW_BAR; bar.x = 0; bar.st = nullptr;
    if (hi - lo > 1) bar = xcd_barrier_post((unsigned*)(ws + WS_CTL) + CW_BAR, MISC + 8);
#ifndef ONLY_PHASE
#define ONLY_PHASE -1
#endif
#define IN(k) ((ONLY_PHASE < 0 || ONLY_PHASE == (k)) && lo <= (k) && (k) < hi)
#define SEAM(k) do { if (IN(k) && IN((k) + 1)) xcd_barrier(bar); } while (0)

    if (IN(0)) { phase_prologue(args, lds, G); } SEAM(0);
    if (IN(1)) {
        pg8::StaticOrder S; S.init(M, PN, G, (int)blockIdx.x);
        EpiStoreBf16 E{(bf16*)(ws + WS_P), PN};
        pg8::gemm_phase<EpiStoreBf16, pg8::StaticOrder, true, false>(lds, (const bf16*)(ws + WS_XN), (const bf16*)(ws + WS_WIN), 1024, S, E);
    } SEAM(1);
    if (IN(2)) {
#ifndef SKIP_SCAN
        for (int u = blockIdx.x; u < 256; u += G) phase_scan_unit(args, lds, u);
#endif
#ifndef SKIP_NA
        for (int u = blockIdx.x; u < BATCH * NH * 32; u += G) phase_na_unit(args, lds, u);
#endif
    } SEAM(2);
    if (IN(3)) { phase_combine(args, lds, G); } SEAM(3);
    if (IN(4)) {
        pg8::StaticOrder S; S.init(M, DM, G, (int)blockIdx.x);
        { EpiGate<false> E{(bf16*)(ws + WS_MG), (const bf16*)(ws + WS_P), C_GA};
          pg8::gemm_phase<EpiGate<false>, pg8::StaticOrder, true, false>(lds, (const bf16*)(ws + WS_YA), (const bf16*)(ws + WS_WA), 512, S, E); }
        { EpiGate<true> E{(bf16*)(ws + WS_MG), (const bf16*)(ws + WS_P), C_GB};
          pg8::gemm_phase<EpiGate<true>, pg8::StaticOrder, true, false>(lds, (const bf16*)(ws + WS_YB), (const bf16*)(ws + WS_WB), 512, S, E); }
    } SEAM(4);
    if (IN(5)) {
        pg8::StaticOrder S; S.init(M, DM, G, (int)blockIdx.x);
        EpiResid E{args.in[I_X], args.out};
        pg8::gemm_phase<EpiResid, pg8::StaticOrder, true, false>(lds, (const bf16*)(ws + WS_MG), (const bf16*)(ws + WS_WO), 1024, S, E);
    } SEAM(5);
    if (IN(6)) { phase_router(args, lds, G); } SEAM(6);
    if (IN(7)) {
        const int NT = moe_table(args, lds);
        MoeOrder S; S.JP = G / 8; S.x = blockIdx.x % 8; S.j = blockIdx.x / 8; S.NT = NT; S.TPX = (NT + 7) / 8; S.NPN = 8; S.tab = (const LAS int*)(lds + MISC_OFF) + 16; S.list = (const int*)(ws + WS_LIST);
        EpiMoe1 E{(bf16*)(ws + WS_P), args.in[I_B1]};
        pg8::gemm_phase<EpiMoe1, MoeOrder, true, true>(lds, (const bf16*)(ws + WS_XN), (const bf16*)(ws + WS_W1), 1024, S, E);
    } SEAM(7);
    if (IN(8)) {
        const int NT = moe_table(args, lds);
        MoeOrder S; S.JP = G / 8; S.x = blockIdx.x % 8; S.j = blockIdx.x / 8; S.NT = NT; S.TPX = (NT + 7) / 8; S.NPN = 4; S.tab = (const LAS int*)(lds + MISC_OFF) + 16; S.list = (const int*)(ws + WS_LIST);
        EpiMoe2 E{(bf16*)(ws + WS_YBUF), args.in[I_B2], (const int*)(ws + WS_LIST), (const float*)(ws + WS_GW), (const LAS int*)(lds + MISC_OFF) + 16};
        pg8::gemm_phase<EpiMoe2, MoeOrder, true, false>(lds, (const bf16*)(ws + WS_P), (const bf16*)(ws + WS_W2), 1024, S, E);
    } SEAM(8);
    if (IN(9)) { phase_final(args, G); }
#undef IN
#undef SEAM
}

extern "C" void kernel_launch(void* const* d_in, const int* in_sizes, int n_in, void* d_out, int out_size, void* d_ws, size_t ws_size, hipStream_t stream) {
    static int grid = 0;
    if (grid == 0) {
        if (n_in != 32 || in_sizes[0] != M * DM || out_size != M * DM || ws_size < WS_END) {
            fprintf(stderr, "kernel_launch: unexpected problem: n_in %d in0 %d out %d ws %zu (need %zu)\n", n_in, n_in > 0 ? in_sizes[0] : -1, out_size, ws_size, (size_t)WS_END); grid = -1; return; }
        int dev = 0, cus = 0;
        if (hipGetDevice(&dev) != hipSuccess || hipDeviceGetAttribute(&cus, hipDeviceAttributeMultiprocessorCount, dev) != hipSuccess) { grid = -1; return; }
        if (hipFuncSetAttribute((const void*)mk_fwd, hipFuncAttributeMaxDynamicSharedMemorySize, LDS_BYTES) != hipSuccess) { fprintf(stderr, "kernel_launch: hipFuncSetAttribute failed\n"); grid = -1; return; }
        (void)hipGetLastError();
        grid = cus;
        if (grid != 256) fprintf(stderr, "kernel_launch: note: %d CUs\n", grid);
        if (grid % 8 != 0) grid -= grid % 8;
    }
    if (grid < 0) return;
    (void)hipMemsetAsync((char*)d_ws + WS_CTL, 0, CTL_ZERO_BYTES, stream);
    Args a{};
    for (int i = 0; i < 32; ++i) a.in[i] = (const float*)d_in[i];
    a.out = (float*)d_out; a.ws = (unsigned char*)d_ws;
#if MK_N_LAUNCHES == 1
    a.ph_lo = 0; a.ph_hi = N_PHASES; a.li = 0;
    hipLaunchKernelGGL(mk_fwd, dim3(grid), dim3(512), LDS_BYTES, stream, a);
#else
    for (int p = 0; p < N_PHASES; ++p) { a.ph_lo = p; a.ph_hi = p + 1; a.li = p; hipLaunchKernelGGL(mk_fwd, dim3(grid), dim3(512), LDS_BYTES, stream, a); }
#endif
}
```

```cpp
#include <hip/hip_runtime.h>
#include <cstdio>
#include <cstdint>

#ifndef MK_N_LAUNCHES
#define MK_N_LAUNCHES 1
#endif

#define LAS __attribute__((address_space(3)))
#define GAS __attribute__((address_space(1)))
typedef unsigned short bf16;
typedef short bf16x8 __attribute__((ext_vector_type(8)));
typedef float f32x4 __attribute__((ext_vector_type(4)));
typedef float f32x2 __attribute__((ext_vector_type(2)));
typedef unsigned u32x4 __attribute__((ext_vector_type(4)));
typedef unsigned u32x2 __attribute__((ext_vector_type(2)));
typedef GAS unsigned gu32;

constexpr int BATCH = 16, SEQ = 2048, DM = 1024, M = BATCH * SEQ;
constexpr int DA = 512, HD = 64, NH = 8;
constexpr int IN_COLS = 5504, PN = 5632;
constexpr int C_R = 0, C_K = 512, C_V = 1024, C_LWF = 1536, C_LAF = 1664, C_LG = 1792;
constexpr int C_Q = 1920, C_BK = 2432, C_BV = 2944, C_GA = 3456, C_GB = 4480;
constexpr int NE = 32, DE = 1024, LISTCAP = 32768;
constexpr int NT_MAX = 544;
constexpr float RMS_EPS = 1e-5f, GN_EPS = 64e-5f, DECAY_SCALE = 0.6065306597126334f;

constexpr size_t MiB = 1u << 20;
constexpr size_t WS_CTL = 0, CTL_ZERO_BYTES = 1 * MiB;
constexpr size_t WS_WIN = 1 * MiB;
constexpr size_t WS_WA = 12 * MiB, WS_WB = 13 * MiB, WS_WO = 14 * MiB;
constexpr size_t WS_W1 = 16 * MiB;
constexpr size_t WS_W2 = 144 * MiB;
constexpr size_t WS_XN = 208 * MiB;
constexpr size_t WS_P = 272 * MiB;
constexpr size_t WS_OF = 624 * MiB, WS_OB = 688 * MiB;
constexpr size_t WS_YB = 752 * MiB, WS_YA = 784 * MiB;
constexpr size_t WS_MG = 816 * MiB;
constexpr size_t WS_YBUF = 624 * MiB;
constexpr size_t WS_CFB = 880 * MiB;
constexpr size_t WS_GW = 882 * MiB;
constexpr size_t WS_LIST = 883 * MiB;
constexpr size_t WS_END = 888 * MiB;
static_assert(WS_YBUF + 4ull * M * DM * 2 <= WS_CFB, "ybuf overlay");
static_assert((size_t)NT_MAX * 256 * DE * 2 <= 352 * MiB, "act overlay");
constexpr int CW_BAR = 4096;
constexpr int CW_CNT = 16384;

constexpr int LDS_BYTES = 147456;
constexpr int MISC_OFF = LDS_BYTES - 1024;

__device__ __forceinline__ unsigned f2bf(float f) { unsigned u = __builtin_bit_cast(unsigned, f); return (u + 0x7fffu + ((u >> 16) & 1u)) >> 16; }
__device__ __forceinline__ unsigned pk2(float lo, float hi) { return f2bf(lo) | (f2bf(hi) << 16); }
__device__ __forceinline__ float bflo(unsigned u) { return __builtin_bit_cast(float, u << 16); }
__device__ __forceinline__ float bfhi(unsigned u) { return __builtin_bit_cast(float, u & 0xffff0000u); }
__device__ __forceinline__ float sigmoidf_(float x) { return 1.0f / (1.0f + __expf(-x)); }
template <int CTRL> __device__ __forceinline__ float dppf(float x) { return __builtin_bit_cast(float, __builtin_amdgcn_update_dpp(0, __builtin_bit_cast(int, x), CTRL, 0xF, 0xF, true)); }
__device__ __forceinline__ float dpp_sum8(float x) { x += dppf<0xB1>(x); x += dppf<0x4E>(x); x += dppf<0x141>(x); return x; }
__device__ __forceinline__ float dpp_sum16(float x) { x += dppf<0xB1>(x); x += dppf<0x4E>(x); x += dppf<0x141>(x); x += dppf<0x140>(x); return x; }
__device__ __forceinline__ float dpp_max8(float x) { x = fmaxf(x, dppf<0xB1>(x)); x = fmaxf(x, dppf<0x4E>(x)); x = fmaxf(x, dppf<0x141>(x)); return x; }
__device__ __forceinline__ float wave_sum(float v) {
#pragma unroll
    for (int o = 1; o < 64; o <<= 1) v += __shfl_xor(v, o);
    return v;
}
__device__ __forceinline__ float wave_max(float v) {
#pragma unroll
    for (int o = 1; o < 64; o <<= 1) v = fmaxf(v, __shfl_xor(v, o));
    return v;
}
#define LDS_WAIT() asm volatile("s_waitcnt lgkmcnt(0)" ::: "memory")
#define VM_WAIT() asm volatile("s_waitcnt vmcnt(0)" ::: "memory")

namespace pg8 {
constexpr int BM = 256, BK = 64, HALF = 128, HTB = HALF * BK * 2, STAGE_BYTES = 8 * HTB, NXCD = 8, WGM = 8;
__host__ __device__ __forceinline__ int lds_byte(int r, int c) { const int st = (r >> 4) * 2 + (c >> 5), rr = r & 15, cc = c & 31, ob = rr * 64 + cc * 2; return st * 1024 + (ob ^ (((ob >> 9) & 1) << 5)); }
__host__ __device__ __forceinline__ void stage_rc(int b, int& R, int& C) { const int st = b / 1024, sb = b % 1024, swz = sb ^ (((sb >> 9) & 1) << 5); R = (st >> 1) * 16 + swz / 64; C = (st & 1) * 32 + (swz % 64) / 2; }
__host__ __device__ __forceinline__ int perm32(int rho) { const int n = rho >> 4, i = rho & 15; return 8 * (i >> 2) + 4 * n + (i & 3); }

struct Unit { int pm, pn, e, i0; };

struct StaticOrder {
    int nM, nN, nwg, G, c;
    __device__ void init(int M_, int N_, int G_, int c_) { nM = M_ / BM; nN = N_ / BM; nwg = nM * nN; G = G_; c = c_; }
    __device__ bool next(int i, Unit& u) const {
        const long L = (long)i * G + c; if (L >= nwg) return false;
        int wgid = (int)L; { const int q = nwg / NXCD, r = nwg % NXCD, xcd = wgid % NXCD, off = wgid / NXCD; wgid = (xcd < r ? xcd * (q + 1) : r * (q + 1) + (xcd - r) * q) + off; }
        const int nig = WGM * nN, gid = wgid / nig, fm = gid * WGM, gsz = (nM - fm) < WGM ? (nM - fm) : WGM;
        u.pm = fm + ((wgid % nig) % gsz); u.pn = (wgid % nig) / gsz; u.e = 0; u.i0 = 0; return true;
    }
    __device__ __forceinline__ unsigned goff(const Unit&, int) const { return 0u; }
};

__device__ __forceinline__ unsigned cvt_pk_bf16(float lo, float hi) { unsigned r; asm volatile("v_cvt_pk_bf16_f32 %0, %1, %2" : "=v"(r) : "v"(lo), "v"(hi)); return r; }

template <class Epi, class Sched, bool ALIGN_EPI, bool GATHER>
__device__ __forceinline__ void gemm_phase(LAS unsigned char* lds, const bf16* Aall, const bf16* Ball, const int K, const Sched& S, const Epi& E) {
    const int tid = threadIdx.x, wid = __builtin_amdgcn_readfirstlane(tid >> 6), lane = tid & 63, wr = wid >> 2, wc = wid & 3, fr = lane & 15, fq = lane >> 4;
    const int nt = K / BK;
    int Ri[2], Ci[2]; unsigned voffB[2];
#pragma unroll
    for (int i = 0; i < 2; ++i) { stage_rc(tid * 16 + i * 8192, Ri[i], Ci[i]); const int Rb = Epi::PERM ? ((Ri[i] & ~31) + perm32(Ri[i] & 31)) : Ri[i]; voffB[i] = (unsigned)(Rb * K + Ci[i]) * 2u; }
    const size_t kstep = (size_t)(BK * 2);
    const size_t hstep = (size_t)HALF * K * 2;
    const size_t tstep = 2 * hstep;
    const unsigned ldsw = (unsigned)wid * 1024u;
    const int aoff = lds_byte(wr * 64 + fr, fq * 8), boff = lds_byte(wc * 32 + fr, fq * 8);
#define PG8_SA(b, h) (((b) * 2 + (h)) * HTB)
#define PG8_SB(b, h) ((4 + (b) * 2 + (h)) * HTB)
#define PG8_STAGE(bufoff, gbase, v0, v1) do { \
        __builtin_amdgcn_global_load_lds((const unsigned*)((const char*)(gbase) + (v0)), (LAS unsigned*)(lds + (bufoff) + ldsw), 16, 0, 0); \
        __builtin_amdgcn_global_load_lds((const unsigned*)((const char*)(gbase) + (v1)), (LAS unsigned*)(lds + (bufoff) + ldsw + 8192), 16, 0, 0); } while (0)
#define PG8_STAGE_B(bufoff, gbase) PG8_STAGE(bufoff, gbase, voffB[0], voffB[1])
#define PG8_LDA(dst, b, h) do { _Pragma("unroll") for (int m = 0; m < 4; ++m) _Pragma("unroll") for (int k = 0; k < 2; ++k) dst[m][k] = *(const LAS bf16x8*)(lds + PG8_SA(b, h) + aoff + m * 2048 + k * 1024); } while (0)
#define PG8_LDB(dst, b, h) do { _Pragma("unroll") for (int n = 0; n < 2; ++n) _Pragma("unroll") for (int k = 0; k < 2; ++k) dst[n][k] = *(const LAS bf16x8*)(lds + PG8_SB(b, h) + boff + n * 2048 + k * 1024); } while (0)
#define PG8_MMA(ai, bj, At, Bt) do { __builtin_amdgcn_s_setprio(1); _Pragma("unroll") for (int m = 0; m < 4; ++m) _Pragma("unroll") for (int n = 0; n < 2; ++n) _Pragma("unroll") for (int k = 0; k < 2; ++k) \
        acc[ai][bj][m][n] = __builtin_amdgcn_mfma_f32_16x16x32_bf16(Bt[n][k], At[m][k], acc[ai][bj][m][n], 0, 0, 0); __builtin_amdgcn_s_setprio(0); } while (0)
#define PG8_WAIT_V(n) asm volatile("s_waitcnt vmcnt(" #n ")" ::: "memory")
#define PG8_WAIT_L(n) asm volatile("s_waitcnt lgkmcnt(" #n ")" ::: "memory")
#define PG8_BAR __builtin_amdgcn_s_barrier()
#define PG8_SCHED __builtin_amdgcn_sched_barrier(0)
    Unit cur, nxt; int ui = 0;
    if (!S.next(0, cur)) return;
    f32x4 acc[2][2][4][2];
#pragma unroll
    for (int a = 0; a < 2; ++a)
#pragma unroll
        for (int b = 0; b < 2; ++b)
#pragma unroll
            for (int m = 0; m < 4; ++m)
#pragma unroll
                for (int n = 0; n < 2; ++n) acc[a][b][m][n] = (f32x4){0.f, 0.f, 0.f, 0.f};
    bf16x8 At[4][2], B0[2][2], B1[2][2];
    unsigned vc00, vc01, vc10, vc11, vn00, vn01, vn10, vn11;
    if constexpr (GATHER) {
        vc00 = S.goff(cur, Ri[0]) + (unsigned)Ci[0] * 2u; vc01 = S.goff(cur, Ri[1]) + (unsigned)Ci[1] * 2u;
        vc10 = S.goff(cur, 128 + Ri[0]) + (unsigned)Ci[0] * 2u; vc11 = S.goff(cur, 128 + Ri[1]) + (unsigned)Ci[1] * 2u;
    } else {
        vc00 = (unsigned)(Ri[0] * K + Ci[0]) * 2u; vc01 = (unsigned)(Ri[1] * K + Ci[1]) * 2u; vc10 = vc00 + (unsigned)hstep; vc11 = vc01 + (unsigned)hstep;
    }
    vn00 = vc00; vn01 = vc01; vn10 = vc10; vn11 = vc11;
    const char* cA = GATHER ? (const char*)Aall : (const char*)Aall + (size_t)cur.pm * tstep;
    const char* cB = (const char*)Ball + (size_t)cur.pn * tstep;
    PG8_STAGE_B(PG8_SB(0, 0), cB); PG8_STAGE_B(PG8_SB(0, 1), cB + hstep); PG8_STAGE(PG8_SA(0, 0), cA, vc00, vc01); PG8_STAGE(PG8_SA(0, 1), cA, vc10, vc11);
    if (wr == 1) PG8_BAR;
    PG8_WAIT_V(2); PG8_BAR;
    PG8_STAGE_B(PG8_SB(1, 0), cB + kstep); PG8_STAGE(PG8_SA(1, 0), cA + kstep, vc00, vc01); PG8_STAGE_B(PG8_SB(1, 1), cB + hstep + kstep);
    PG8_WAIT_V(6); PG8_BAR;
    for (;;) {
        const bool has_next = S.next(ui + 1, nxt);
        const char* nA = has_next ? (GATHER ? (const char*)Aall : (const char*)Aall + (size_t)nxt.pm * tstep) : cA;
        const char* nB = has_next ? (const char*)Ball + (size_t)nxt.pn * tstep : cB;
        if constexpr (GATHER) {
            if (has_next) {
                vn00 = S.goff(nxt, Ri[0]) + (unsigned)Ci[0] * 2u; vn01 = S.goff(nxt, Ri[1]) + (unsigned)Ci[1] * 2u;
                vn10 = S.goff(nxt, 128 + Ri[0]) + (unsigned)Ci[0] * 2u; vn11 = S.goff(nxt, 128 + Ri[1]) + (unsigned)Ci[1] * 2u;
            }
        }
        for (int t = 0; t < nt; t += 2) {
            const bool last = (t == nt - 2);
            const char* a1 = cA + (size_t)(t + 1) * kstep;
            const char* a2 = last ? nA : cA + (size_t)(t + 2) * kstep; const char* b2 = last ? nB : cB + (size_t)(t + 2) * kstep;
            const char* a3 = a2 + kstep; const char* b3 = b2 + kstep;
            const unsigned s00 = last ? vn00 : vc00, s01 = last ? vn01 : vc01, s10 = last ? vn10 : vc10, s11 = last ? vn11 : vc11;
            PG8_LDB(B0, 0, 0); PG8_LDB(B1, 0, 1); PG8_SCHED; PG8_LDA(At, 0, 0); PG8_STAGE(PG8_SA(1, 1), a1, vc10, vc11);
            PG8_WAIT_V(8); PG8_WAIT_L(0); PG8_BAR; PG8_MMA(0, 0, At, B0); PG8_MMA(0, 1, At, B1); PG8_BAR; PG8_SCHED;
            PG8_LDA(At, 0, 1); PG8_STAGE_B(PG8_SB(0, 0), b2); PG8_STAGE_B(PG8_SB(0, 1), b2 + hstep); PG8_STAGE(PG8_SA(0, 0), a2, s00, s01);
            PG8_WAIT_V(8); PG8_WAIT_L(0); PG8_BAR; PG8_MMA(1, 0, At, B0); PG8_MMA(1, 1, At, B1); PG8_BAR; PG8_SCHED;
            PG8_LDB(B0, 1, 0); PG8_LDB(B1, 1, 1); PG8_SCHED; PG8_LDA(At, 1, 0); PG8_STAGE(PG8_SA(0, 1), a2, s10, s11);
            PG8_WAIT_V(8); PG8_WAIT_L(0); PG8_BAR; PG8_MMA(0, 0, At, B0); PG8_MMA(0, 1, At, B1); PG8_BAR; PG8_SCHED;
            PG8_LDA(At, 1, 1); PG8_STAGE_B(PG8_SB(1, 0), b3); PG8_STAGE_B(PG8_SB(1, 1), b3 + hstep); PG8_STAGE(PG8_SA(1, 0), a3, s00, s01);
            PG8_WAIT_V(8); PG8_WAIT_L(0); PG8_BAR; PG8_MMA(1, 0, At, B0); PG8_MMA(1, 1, At, B1); PG8_BAR; PG8_SCHED;
        }
        if constexpr (ALIGN_EPI) { if (wr == 0) PG8_BAR; }
        E(acc, cur, wr, wc, fr, fq);
        if (!has_next) break;
#pragma unroll
        for (int a = 0; a < 2; ++a)
#pragma unroll
            for (int b = 0; b < 2; ++b)
#pragma unroll
                for (int m = 0; m < 4; ++m)
#pragma unroll
                    for (int n = 0; n < 2; ++n) acc[a][b][m][n] = (f32x4){0.f, 0.f, 0.f, 0.f};
        cur = nxt; cA = nA; cB = nB; ++ui;
        vc00 = vn00; vc01 = vn01; vc10 = vn10; vc11 = vn11;
        if constexpr (ALIGN_EPI) { if (wr == 1) PG8_BAR; }
    }
    PG8_WAIT_V(0);
    if constexpr (!ALIGN_EPI) { if (wr == 0) PG8_BAR; }
    PG8_BAR;
#undef PG8_SA
#undef PG8_SB
#undef PG8_STAGE
#undef PG8_STAGE_B
#undef PG8_LDA
#undef PG8_LDB
#undef PG8_MMA
#undef PG8_WAIT_V
#undef PG8_WAIT_L
#undef PG8_BAR
#undef PG8_SCHED
}
}

struct EpiStoreBf16 {
    static constexpr bool PERM = true;
    bf16* O; int ldc;
    __device__ __forceinline__ void operator()(const f32x4 (&acc)[2][2][4][2], const pg8::Unit& u, int wr, int wc, int fr, int fq) const {
        const int row0 = u.pm * 256 + wr * 64 + fr, col0 = u.pn * 256 + wc * 32 + 8 * fq;
#pragma unroll
        for (int ai = 0; ai < 2; ++ai)
#pragma unroll
            for (int m = 0; m < 4; ++m) { bf16* rowp = O + (size_t)(row0 + ai * 128 + m * 16) * ldc + col0;
#pragma unroll
                for (int bj = 0; bj < 2; ++bj) { const f32x4 v0 = acc[ai][bj][m][0], v1 = acc[ai][bj][m][1]; u32x4 w;
                    w.x = pg8::cvt_pk_bf16(v0[0], v0[1]); w.y = pg8::cvt_pk_bf16(v0[2], v0[3]); w.z = pg8::cvt_pk_bf16(v1[0], v1[1]); w.w = pg8::cvt_pk_bf16(v1[2], v1[3]);
                    *(u32x4*)(rowp + bj * 128) = w; } }
    }
};
template <bool ADD> struct EpiGate {
    static constexpr bool PERM = true;
    bf16* MG; const bf16* P; int gcol0;
    __device__ __forceinline__ void operator()(const f32x4 (&acc)[2][2][4][2], const pg8::Unit& u, int wr, int wc, int fr, int fq) const {
        const int row0 = u.pm * 256 + wr * 64 + fr, col0 = u.pn * 256 + wc * 32 + 8 * fq;
#pragma unroll
        for (int ai = 0; ai < 2; ++ai)
#pragma unroll
            for (int m = 0; m < 4; ++m) { const size_t row = (size_t)(row0 + ai * 128 + m * 16);
#pragma unroll
                for (int bj = 0; bj < 2; ++bj) { const int col = col0 + bj * 128;
                    const u32x4 g = *(const u32x4*)(P + row * PN + gcol0 + col);
                    float o[8]; const f32x4 v0 = acc[ai][bj][m][0], v1 = acc[ai][bj][m][1];
                    o[0] = v0[0] * sigmoidf_(bflo(g.x)); o[1] = v0[1] * sigmoidf_(bfhi(g.x)); o[2] = v0[2] * sigmoidf_(bflo(g.y)); o[3] = v0[3] * sigmoidf_(bfhi(g.y));
                    o[4] = v1[0] * sigmoidf_(bflo(g.z)); o[5] = v1[1] * sigmoidf_(bfhi(g.z)); o[6] = v1[2] * sigmoidf_(bflo(g.w)); o[7] = v1[3] * sigmoidf_(bfhi(g.w));
                    bf16* dst = MG + row * DM + col;
                    if (ADD) { const u32x4 p = *(const u32x4*)dst;
                        o[0] += bflo(p.x); o[1] += bfhi(p.x); o[2] += bflo(p.y); o[3] += bfhi(p.y); o[4] += bflo(p.z); o[5] += bfhi(p.z); o[6] += bflo(p.w); o[7] += bfhi(p.w); }
                    u32x4 w; w.x = pg8::cvt_pk_bf16(o[0], o[1]); w.y = pg8::cvt_pk_bf16(o[2], o[3]); w.z = pg8::cvt_pk_bf16(o[4], o[5]); w.w = pg8::cvt_pk_bf16(o[6], o[7]);
                    *(u32x4*)dst = w; } }
    }
};
struct EpiResid {
    static constexpr bool PERM = false;
    const float* X; float* O;
    __device__ __forceinline__ void operator()(const f32x4 (&acc)[2][2][4][2], const pg8::Unit& u, int wr, int wc, int fr, int fq) const {
        const int row0 = u.pm * 256 + wr * 64 + fr, col0 = u.pn * 256 + wc * 32 + 4 * fq;
#pragma unroll
        for (int ai = 0; ai < 2; ++ai)
#pragma unroll
            for (int m = 0; m < 4; ++m) { const size_t off = (size_t)(row0 + ai * 128 + m * 16) * DM + col0;
#pragma unroll
                for (int bj = 0; bj < 2; ++bj)
#pragma unroll
                    for (int n = 0; n < 2; ++n) { const f32x4 xv = *(const f32x4*)(X + off + bj * 128 + n * 16); *(f32x4*)(O + off + bj * 128 + n * 16) = xv + acc[ai][bj][m][n]; } }
    }
};
struct EpiMoe1 {
    static constexpr bool PERM = true;
    bf16* ACT; const float* b1;
    __device__ __forceinline__ void operator()(const f32x4 (&acc)[2][2][4][2], const pg8::Unit& u, int wr, int wc, int fr, int fq) const {
        const int pnl = u.pn & 7; const int row0 = u.pm * 256 + wr * 64 + fr, j0 = pnl * 128 + wc * 32 + 8 * fq;
        const float* bg = b1 + (size_t)u.e * 2048 + j0; const float* bl = bg + 1024;
        const f32x4 bg0 = *(const f32x4*)bg, bg1 = *(const f32x4*)(bg + 4), bl0 = *(const f32x4*)bl, bl1 = *(const f32x4*)(bl + 4);
#pragma unroll
        for (int ai = 0; ai < 2; ++ai)
#pragma unroll
            for (int m = 0; m < 4; ++m) { bf16* dst = ACT + (size_t)(row0 + ai * 128 + m * 16) * DE + j0; float o[8];
#pragma unroll
                for (int n = 0; n < 2; ++n) { const f32x4 gv = acc[ai][0][m][n] + (n ? bg1 : bg0), lv = acc[ai][1][m][n] + (n ? bl1 : bl0);
#pragma unroll
                    for (int k = 0; k < 4; ++k) { const float g = fminf(gv[k], 7.0f), l = fminf(fmaxf(lv[k], -7.0f), 7.0f); o[n * 4 + k] = g * sigmoidf_(1.702f * g) * (l + 1.0f); } }
                u32x4 w; w.x = pg8::cvt_pk_bf16(o[0], o[1]); w.y = pg8::cvt_pk_bf16(o[2], o[3]); w.z = pg8::cvt_pk_bf16(o[4], o[5]); w.w = pg8::cvt_pk_bf16(o[6], o[7]);
                *(u32x4*)dst = w; }
    }
};
struct EpiMoe2 {
    static constexpr bool PERM = true;
    bf16* YBUF; const float* b2; const int* list; const float* gw; const LAS int* tab;
    __device__ __forceinline__ void operator()(const f32x4 (&acc)[2][2][4][2], const pg8::Unit& u, int wr, int wc, int fr, int fq) const {
        const int pnl = u.pn & 3; const int rl0 = wr * 64 + fr, col0 = pnl * 256 + wc * 32 + 8 * fq; const int cnt = tab[u.e];
        f32x4 bv[2][2];
#pragma unroll
        for (int bj = 0; bj < 2; ++bj)
#pragma unroll
            for (int n = 0; n < 2; ++n) bv[bj][n] = *(const f32x4*)(b2 + (size_t)u.e * 1024 + col0 + bj * 128 + 4 * n);
#pragma unroll
        for (int ai = 0; ai < 2; ++ai)
#pragma unroll
            for (int m = 0; m < 4; ++m) { const int idx = u.i0 + rl0 + ai * 128 + m * 16;
                if (idx < cnt) { const int ent = list[(size_t)u.e * LISTCAP + idx]; const float w8 = gw[ent]; const int tok = ent >> 2, slot = ent & 3;
                    bf16* rowp = YBUF + ((size_t)slot * M + tok) * DM + col0;
#pragma unroll
                    for (int bj = 0; bj < 2; ++bj) { const f32x4 v0 = (acc[ai][bj][m][0] + bv[bj][0]) * w8, v1 = (acc[ai][bj][m][1] + bv[bj][1]) * w8; u32x4 w;
                        w.x = pg8::cvt_pk_bf16(v0[0], v0[1]); w.y = pg8::cvt_pk_bf16(v0[2], v0[3]); w.z = pg8::cvt_pk_bf16(v1[0], v1[1]); w.w = pg8::cvt_pk_bf16(v1[2], v1[3]);
                        *(u32x4*)(rowp + bj * 128) = w; } } }
    }
};
struct MoeOrder {
    int JP, x, j, TPX, NT, NPN; const LAS int* tab; const int* list;
    __device__ bool next(int i, pg8::Unit& u) const {
        const int q = i * JP + j; const int lt = q / NPN, pn = q % NPN; if (lt >= TPX) return false; const int gt = x * TPX + lt; if (gt >= NT) return false;
        int e = 0;
        for (int k = 1; k < NE; ++k) e += (tab[32 + k] <= gt) ? 1 : 0;
        e = __builtin_amdgcn_readfirstlane(e); const int ts = __builtin_amdgcn_readfirstlane(tab[32 + e]);
        u.pm = gt; u.pn = e * NPN + pn; u.e = e; u.i0 = (gt - ts) * 256; return true;
    }
    __device__ __forceinline__ unsigned goff(const pg8::Unit& u, int r) const {
        const int idx = u.i0 + r; int tok = 0; if (idx < tab[u.e]) tok = list[(size_t)u.e * LISTCAP + idx] >> 2; return (unsigned)tok * (unsigned)(DM * 2);
    }
};

#define XB_TMO      128
#define XB_XCNT(j)  (256  + 64 * (j))
#define XB_XSUB(j)  (1280 + 64 * (j))
#define XB_XGEN(j)  (2304 + 64 * (j))
#define XB_TOP      3328
#define XB_TOPGEN   3392
#define XCD_BAR_WORDS 3456
#define XB_SPIN_CAP (1u << 20)
__device__ __forceinline__ unsigned xb_ld(unsigned* p)              { return __hip_atomic_load(p, __ATOMIC_RELAXED, __HIP_MEMORY_SCOPE_AGENT); }
__device__ __forceinline__ unsigned xb_add(unsigned* p, unsigned v) { return __hip_atomic_fetch_add(p, v, __ATOMIC_RELAXED, __HIP_MEMORY_SCOPE_AGENT); }
__device__ __forceinline__ unsigned xb_xcc_id() { return (unsigned)__builtin_amdgcn_s_getreg((3 << 11) | 20) & 0xFu; }
#define XB_SPIN(cond, bar) do { unsigned _sp = 0; while (cond) { __builtin_amdgcn_s_sleep(1); \
    if ((++_sp & 255u) == 0u) { if (xb_ld(&(bar)[XB_TMO])) break; if (_sp > XB_SPIN_CAP) { atomicAdd(&(bar)[XB_TMO], 1u); break; } } } } while (0)
struct XcdBarrier { unsigned* bar; unsigned x; volatile LAS unsigned* st; };
__device__ __forceinline__ XcdBarrier xcd_barrier_post(unsigned* bar, volatile LAS unsigned* st) {
    XcdBarrier b; b.bar = bar; b.x = xb_xcc_id(); b.st = st;
    if (threadIdx.x == 0) (void)xb_add(&bar[XB_XCNT(b.x)], 1u);
    return b;
}
__device__ __forceinline__ void xcd_barrier_complete(unsigned* bar, unsigned x, unsigned& nloc, unsigned& nx) {
    const unsigned G = gridDim.x * gridDim.y * gridDim.z;
    unsigned sum, cnt, mine, sp = 0u;
    for (;;) {
        sum = 0u; cnt = 0u; mine = 0u;
#pragma unroll
        for (unsigned j = 0; j < 16; ++j) { const unsigned c = xb_ld(&bar[XB_XCNT(j)]); sum += c; cnt += (c > 0u) ? 1u : 0u; mine = (j == x) ? c : mine; }
        if (sum == G) break;
        __builtin_amdgcn_s_sleep(1);
        if ((++sp & 255u) == 0u) { if (xb_ld(&bar[XB_TMO])) break; if (sp > XB_SPIN_CAP) { atomicAdd(&bar[XB_TMO], 1u); break; } }
    }
    nloc = mine > 0u ? mine : 1u; nx = cnt > 0u ? cnt : 1u;
}
__device__ __forceinline__ void xcd_barrier(const XcdBarrier& b) {
    asm volatile("s_waitcnt vmcnt(0)" ::: "memory");
    __syncthreads();
    if (threadIdx.x == 0) {
        unsigned* bar = b.bar;
        __builtin_amdgcn_s_waitcnt(0);
        unsigned nloc = b.st[0], nx = b.st[1];
        if (nloc == 0u) { xcd_barrier_complete(bar, b.x, nloc, nx); b.st[0] = nloc; b.st[1] = nx; }
        const unsigned old = xb_add(&bar[XB_XSUB(b.x)], 1u);
        const unsigned gen = old / nloc;
        if (old + 1u == (gen + 1u) * nloc) {
            __builtin_amdgcn_fence(__ATOMIC_RELEASE, "agent");
            asm volatile("s_waitcnt vmcnt(0)" ::: "memory");
            const unsigned og = xb_add(&bar[XB_TOP], 1u);
            const unsigned tg = og / nx;
            if (og + 1u == (tg + 1u) * nx) xb_add(&bar[XB_TOPGEN], 1u);
            else XB_SPIN(xb_ld(&bar[XB_TOPGEN]) == tg, bar);
            __builtin_amdgcn_fence(__ATOMIC_ACQUIRE, "agent");
            xb_add(&bar[XB_XGEN(b.x)], 1u);
            asm volatile("s_waitcnt vmcnt(0)" ::: "memory");
        } else {
            XB_SPIN(xb_ld(&bar[XB_XGEN(b.x)]) == gen, bar);
            __builtin_amdgcn_fence(__ATOMIC_ACQUIRE, "agent");
            asm volatile("s_waitcnt vmcnt(0)" ::: "memory");
        }
    }
    __syncthreads();
}

struct Args { const float* in[32]; float* out; unsigned char* ws; int ph_lo, ph_hi, li, pad; };
enum { I_X = 0, I_GMIX, I_WIN, I_MUP, I_MUN, I_W0F, I_W2F, I_W0B, I_W2B, I_A0F, I_A2F, I_A0B, I_A2B, I_G2, I_KK, I_KA, I_RK, I_LNG, I_LNB, I_QG, I_KG, I_RPB,
       I_WA, I_WB, I_WO, I_GFFN, I_WR, I_BR, I_W1, I_B1, I_W2, I_B2 };

__device__ __forceinline__ void p0_transpose_item(const float* W, int K, int N, bf16* WT, int k0, int n0, int drow0, LAS float* scr, int lane) {
#pragma unroll 8
    for (int i = 0; i < 32; ++i) { const int kk = 2 * i + (lane >> 5); scr[kk * 33 + (lane & 31)] = W[(size_t)(k0 + kk) * N + n0 + (lane & 31)]; }
    LDS_WAIT(); asm volatile("" ::: "memory");
    const int c = lane & 7;
#pragma unroll
    for (int j = 0; j < 4; ++j) { const int n = (lane >> 3) + 8 * j; const LAS float* s = scr + (8 * c) * 33 + n;
        u32x4 o; o.x = pk2(s[0 * 33], s[1 * 33]); o.y = pk2(s[2 * 33], s[3 * 33]); o.z = pk2(s[4 * 33], s[5 * 33]); o.w = pk2(s[6 * 33], s[7 * 33]);
        *(GAS u32x4*)(WT + (size_t)(drow0 + n) * K + k0 + 8 * c) = o; }
    LDS_WAIT(); asm volatile("" ::: "memory");
}
__device__ __forceinline__ void phase_prologue(const Args& a, LAS unsigned char* lds, int G) {
    const int tid = threadIdx.x, lane = tid & 63, wave = tid >> 6;
    unsigned char* ws = a.ws;
    LAS float* scr = (LAS float*)(lds + wave * 16384);
    const int gw = blockIdx.x * 8 + wave, NGW = G * 8;
    constexpr int I_IN = 16 * 172, I_AB = 8 * 32, I_O = 16 * 32, I_1 = 32 * 16 * 64, I_2 = 32 * 16 * 32;
    constexpr int NITEMS = I_IN + 2 * I_AB + I_O + I_1 + I_2;
    const float* x = a.in[I_X]; const float* gmix = a.in[I_GMIX]; bf16* XN = (bf16*)(ws + WS_XN);
    f32x4 gm[4];
#pragma unroll
    for (int j = 0; j < 4; ++j) gm[j] = *(const f32x4*)(gmix + 256 * j + 4 * lane);
    for (int m = gw; m < M; m += NGW) {
        const GAS f32x4* xr = (const GAS f32x4*)(x + (size_t)m * DM) + lane;
        f32x4 v[4]; float s = 0.f;
#pragma unroll
        for (int j = 0; j < 4; ++j) { v[j] = xr[64 * j]; s += (v[j].x * v[j].x + v[j].y * v[j].y) + (v[j].z * v[j].z + v[j].w * v[j].w); }
        const float rstd = 1.0f / sqrtf(wave_sum(s) * (1.f / DM) + RMS_EPS);
        GAS u32x2* o8 = (GAS u32x2*)(XN + (size_t)m * DM) + lane;
#pragma unroll
        for (int j = 0; j < 4; ++j) { u32x2 o; o.x = pk2(v[j].x * rstd * gm[j].x, v[j].y * rstd * gm[j].y); o.y = pk2(v[j].z * rstd * gm[j].z, v[j].w * rstd * gm[j].w); o8[64 * j] = o; }
    }
    for (int it = gw; it < NITEMS; it += NGW) {
        int r = it;
        if (r < I_IN) { const int kb = r / 172, nb = r % 172; p0_transpose_item(a.in[I_WIN], 1024, IN_COLS, (bf16*)(ws + WS_WIN), 64 * kb, 32 * nb, 32 * nb, scr, lane); continue; } r -= I_IN;
        if (r < I_AB) { const int kb = r / 32, nb = r % 32; p0_transpose_item(a.in[I_WA], 512, 1024, (bf16*)(ws + WS_WA), 64 * kb, 32 * nb, 32 * nb, scr, lane); continue; } r -= I_AB;
        if (r < I_AB) { const int kb = r / 32, nb = r % 32; p0_transpose_item(a.in[I_WB], 512, 1024, (bf16*)(ws + WS_WB), 64 * kb, 32 * nb, 32 * nb, scr, lane); continue; } r -= I_AB;
        if (r < I_O) { const int kb = r / 32, nb = r % 32; p0_transpose_item(a.in[I_WO], 1024, 1024, (bf16*)(ws + WS_WO), 64 * kb, 32 * nb, 32 * nb, scr, lane); continue; } r -= I_O;
        if (r < I_1) { const int e = r / 1024, rr = r % 1024, kb = rr / 64, nb = rr % 64; const int c0 = 32 * nb;
            const int drow = 256 * ((c0 & 1023) >> 7) + 128 * (c0 >> 10) + (c0 & 127);
            p0_transpose_item(a.in[I_W1] + (size_t)e * 1024 * 2048, 1024, 2048, (bf16*)(ws + WS_W1) + (size_t)e * 2048 * 1024, 64 * kb, c0, drow, scr, lane); continue; } r -= I_1;
        { const int e = r / 512, rr = r % 512, kb = rr / 32, nb = rr % 32;
            p0_transpose_item(a.in[I_W2] + (size_t)e * 1024 * 1024, 1024, 1024, (bf16*)(ws + WS_W2) + (size_t)e * 1024 * 1024, 64 * kb, 32 * nb, 32 * nb, scr, lane); }
    }
    { GAS u32x4* z = (GAS u32x4*)((bf16*)(ws + WS_WIN) + (size_t)IN_COLS * 1024);
      for (int i = blockIdx.x * 512 + tid; i < 16384; i += G * 512) z[i] = (u32x4){0u, 0u, 0u, 0u}; }
}

__device__ __forceinline__ f32x4 shift4(u32x2 pc, u32x2 pp, u32x2 pn, f32x4 mup, f32x4 mun) {
    f32x4 c = {bflo(pc.x), bfhi(pc.x), bflo(pc.y), bfhi(pc.y)}, p = {bflo(pp.x), bfhi(pp.x), bflo(pp.y), bfhi(pp.y)}, n = {bflo(pn.x), bfhi(pn.x), bflo(pn.y), bfhi(pn.y)};
    return c + mup * (p - c) + mun * (n - c);
}
__device__ __forceinline__ void phase_scan_unit(const Args& a, LAS unsigned char* lds, int unit) {
    const int tid = threadIdx.x;
    const int b = unit >> 4, h = (unit >> 1) & 7, dir = unit & 1;
    unsigned char* ws = a.ws;
    const bf16* P = (const bf16*)(ws + WS_P);
    float* Odir = (float*)(ws + (dir ? WS_OB : WS_OF));
    float* CFB = (float*)(ws + WS_CFB);
    LAS float* W2S = (LAS float*)(lds);
    LAS float* A2S = (LAS float*)(lds + 16384);
    LAS float* XLW = (LAS float*)(lds + 32768);
    LAS float* XLA = (LAS float*)(lds + 40960);
    LAS float* AR = (LAS float*)(lds + 49152);
    LAS float* AKD = AR + 2048; LAS float* AW = AR + 4096; LAS float* ABB = AR + 6144; LAS float* AKK = AR + 8192; LAS float* AV = AR + 10240;
    LAS float* OBUF = AR + 12288;
    const float* w2 = a.in[dir ? I_W2B : I_W2F]; const float* a2 = a.in[dir ? I_A2B : I_A2F];
    __syncthreads();
#pragma unroll
    for (int i = 0; i < 8; ++i) { const int idx = tid + 512 * i, j = idx >> 6, n = idx & 63; W2S[idx] = w2[j * 512 + h * 64 + n]; A2S[idx] = a2[j * 512 + h * 64 + n]; }
    const int tl = tid >> 4, cg = tid & 15, c4 = 4 * cg;
    const float* mup = a.in[I_MUP]; const float* mun = a.in[I_MUN];
    const int segc[5] = {C_R + h * 64 + c4, C_K + h * 64 + c4, C_V + h * 64 + c4, C_LWF + dir * 64 + c4, C_LAF + dir * 64 + c4};
    f32x4 mp[5], mn[5];
#pragma unroll
    for (int s = 0; s < 5; ++s) { mp[s] = *(const f32x4*)(mup + segc[s]); mn[s] = *(const f32x4*)(mun + segc[s]); }
    const int hc = h * 64 + c4;
    const f32x4 w0v = *(const f32x4*)(a.in[dir ? I_W0B : I_W0F] + hc), a0v = *(const f32x4*)(a.in[dir ? I_A0B : I_A0F] + hc);
    const f32x4 kkv = *(const f32x4*)(a.in[I_KK] + hc), kav = *(const f32x4*)(a.in[I_KA] + hc), rkv = *(const f32x4*)(a.in[I_RK] + hc);
    const int rp = tid >> 4, ks = tid & 15;
    float S0[4] = {0.f, 0.f, 0.f, 0.f}, S1[4] = {0.f, 0.f, 0.f, 0.f};
    for (int ci = 0; ci < SEQ / 32; ++ci) {
        const int t0 = dir ? (SEQ - 32 * (ci + 1)) : 32 * ci;
        const int t = t0 + tl;
        const size_t m = (size_t)b * SEQ + t;
        const bf16* prow = P + m * PN;
        const bool hp = t > 0, hn = t < SEQ - 1;
        f32x4 xs[5];
#pragma unroll
        for (int s = 0; s < 5; ++s) {
            const u32x2 pc = *(const u32x2*)(prow + segc[s]);
            u32x2 pp = {0u, 0u}, pn = {0u, 0u};
            if (hp) pp = *(const u32x2*)(prow - PN + segc[s]);
            if (hn) pn = *(const u32x2*)(prow + PN + segc[s]);
            xs[s] = shift4(pc, pp, pn, mp[s], mn[s]);
        }
        f32x4 tlw; tlw.x = tanhf(xs[3].x); tlw.y = tanhf(xs[3].y); tlw.z = tanhf(xs[3].z); tlw.w = tanhf(xs[3].w);
        *(LAS f32x4*)(XLW + tl * 64 + c4) = tlw;
        *(LAS f32x4*)(XLA + tl * 64 + c4) = xs[4];
        __syncthreads();
        f32x4 accw = {0.f, 0.f, 0.f, 0.f}, acca = {0.f, 0.f, 0.f, 0.f};
#pragma unroll 8
        for (int j = 0; j < 64; ++j) { const float lw = XLW[tl * 64 + j], la = XLA[tl * 64 + j];
            accw += lw * *(const LAS f32x4*)(W2S + j * 64 + c4); acca += la * *(const LAS f32x4*)(A2S + j * 64 + c4); }
        f32x4 dec, av, kkn, kd, bb;
        const f32x4 xr = xs[0], xk = xs[1], xv = xs[2];
        float ss = 0.f;
#pragma unroll
        for (int k = 0; k < 4; ++k) { dec[k] = __expf(-DECAY_SCALE * sigmoidf_(w0v[k] + accw[k])); av[k] = sigmoidf_(a0v[k] + acca[k]); kkn[k] = xk[k] * kkv[k]; ss += kkn[k] * kkn[k]; }
        ss = dpp_sum16(ss);
        const float inv = 1.0f / fmaxf(sqrtf(ss), 1e-12f);
        float cb = 0.f;
#pragma unroll
        for (int k = 0; k < 4; ++k) { kkn[k] *= inv; kd[k] = xk[k] * (1.0f + (av[k] - 1.0f) * kav[k]); bb[k] = kkn[k] * av[k]; cb += xr[k] * kd[k] * rkv[k]; }
        cb = dpp_sum16(cb);
        if (cg == 0) CFB[m * 16 + h * 2 + dir] = cb;
        *(LAS f32x4*)(AR + tl * 64 + c4) = xr; *(LAS f32x4*)(AKD + tl * 64 + c4) = kd; *(LAS f32x4*)(AW + tl * 64 + c4) = dec;
        *(LAS f32x4*)(ABB + tl * 64 + c4) = bb; *(LAS f32x4*)(AKK + tl * 64 + c4) = kkn; *(LAS f32x4*)(AV + tl * 64 + c4) = xv;
        __syncthreads();
#pragma unroll 4
        for (int s = 0; s < 32; ++s) {
            const int q = dir ? 31 - s : s;
            const f32x4 kk4 = *(const LAS f32x4*)(AKK + q * 64 + 4 * ks), w4 = *(const LAS f32x4*)(AW + q * 64 + 4 * ks), b4 = *(const LAS f32x4*)(ABB + q * 64 + 4 * ks);
            const f32x4 kd4 = *(const LAS f32x4*)(AKD + q * 64 + 4 * ks), r4 = *(const LAS f32x4*)(AR + q * 64 + 4 * ks);
            const f32x2 v2 = *(const LAS f32x2*)(AV + q * 64 + 2 * rp);
            float sa0 = (S0[0] * kk4[0] + S0[1] * kk4[1]) + (S0[2] * kk4[2] + S0[3] * kk4[3]);
            float sa1 = (S1[0] * kk4[0] + S1[1] * kk4[1]) + (S1[2] * kk4[2] + S1[3] * kk4[3]);
            sa0 = -dpp_sum16(sa0); sa1 = -dpp_sum16(sa1);
            float o0 = 0.f, o1 = 0.f;
#pragma unroll
            for (int k = 0; k < 4; ++k) {
                S0[k] = S0[k] * w4[k] + sa0 * b4[k] + v2.x * kd4[k]; S1[k] = S1[k] * w4[k] + sa1 * b4[k] + v2.y * kd4[k];
                o0 += S0[k] * r4[k]; o1 += S1[k] * r4[k]; }
            o0 = dpp_sum16(o0); o1 = dpp_sum16(o1);
            if (ks == 0) *(LAS f32x2*)(OBUF + q * 64 + 2 * rp) = (f32x2){o0, o1};
        }
        __syncthreads();
        *(f32x4*)(Odir + ((size_t)b * SEQ + t0 + tl) * DA + h * 64 + c4) = *(const LAS f32x4*)(OBUF + tl * 64 + c4);
    }
    __syncthreads();
}

__device__ __forceinline__ void phase_na_unit(const Args& a, LAS unsigned char* lds, int unit) {
    const int tid = threadIdx.x;
    const int b = unit >> 8, h = (unit >> 5) & 7, r = unit & 31;
    const int rs = min(max(r - 4, 0), 24);
    unsigned char* ws = a.ws;
    const bf16* P = (const bf16*)(ws + WS_P);
    bf16* YB = (bf16*)(ws + WS_YB);
    LAS unsigned char* Ks = lds; LAS unsigned char* Vs = lds + 65536;
    const int q = tid >> 3, dp = tid & 7;
    __syncthreads();
    {
        const f32x4 g0 = *(const f32x4*)(a.in[I_KG] + 8 * dp), g1 = *(const f32x4*)(a.in[I_KG] + 8 * dp + 4);
#pragma unroll 2
        for (int ps = 0; ps < 8; ++ps) {
            const int key = ps * 64 + q;
            const size_t tok = (size_t)b * SEQ + (rs + ps) * 64 + q;
            const u32x4 kc = *(const u32x4*)(P + tok * PN + C_BK + h * 64 + 8 * dp);
            const u32x4 vc = *(const u32x4*)(P + tok * PN + C_BV + h * 64 + 8 * dp);
            const float e0 = bflo(kc.x), e1 = bfhi(kc.x), e2 = bflo(kc.y), e3 = bfhi(kc.y), e4 = bflo(kc.z), e5 = bfhi(kc.z), e6 = bflo(kc.w), e7 = bfhi(kc.w);
            float ss = (e0 * e0 + e1 * e1) + (e2 * e2 + e3 * e3) + (e4 * e4 + e5 * e5) + (e6 * e6 + e7 * e7);
            ss = dpp_sum8(ss);
            const float rk = 1.0f / sqrtf(ss * (1.f / 64.f) + RMS_EPS);
            u32x4 o; o.x = pk2(e0 * rk * g0.x, e1 * rk * g0.y); o.y = pk2(e2 * rk * g0.z, e3 * rk * g0.w); o.z = pk2(e4 * rk * g1.x, e5 * rk * g1.y); o.w = pk2(e6 * rk * g1.z, e7 * rk * g1.w);
            *(LAS u32x4*)(Ks + key * 128 + dp * 16) = o;
            *(LAS u32x4*)(Vs + key * 128 + dp * 16) = vc;
        }
    }
    __syncthreads();
    const size_t qtok = (size_t)b * SEQ + r * 64 + q;
    float qh[8];
    {
        const u32x4 v = *(const u32x4*)(P + qtok * PN + C_Q + h * 64 + 8 * dp);
        qh[0] = bflo(v.x); qh[1] = bfhi(v.x); qh[2] = bflo(v.y); qh[3] = bfhi(v.y); qh[4] = bflo(v.z); qh[5] = bfhi(v.z); qh[6] = bflo(v.w); qh[7] = bfhi(v.w);
        float ss = 0.f;
#pragma unroll
        for (int d = 0; d < 8; ++d) ss += qh[d] * qh[d];
        ss = dpp_sum8(ss);
        const float rq = 0.125f / sqrtf(ss * (1.f / 64.f) + RMS_EPS);
        const float* qg = a.in[I_QG] + 8 * dp;
#pragma unroll
        for (int d = 0; d < 8; ++d) qh[d] *= rq * qg[d];
    }
    const int cs = min(max(q - 8, 0), 48);
    const float* rpb = a.in[I_RPB] + ((size_t)h * 15 + (rs - r + 7)) * 31 + (cs - q + 15);
    const LAS unsigned char* kb = Ks + cs * 128 + dp * 16;
    const LAS unsigned char* vb = Vs + cs * 128 + dp * 16;
    float mx = -1e30f, sum = 0.f;
    float acc[8];
#pragma unroll
    for (int d = 0; d < 8; ++d) acc[d] = 0.f;
#pragma unroll 1
    for (int ri = 0; ri < 8; ++ri) {
        float sc[16]; float rmx = -1e30f;
#pragma unroll
        for (int j = 0; j < 16; ++j) {
            const u32x4 kv = *(const LAS u32x4*)(kb + (ri * 64 + j) * 128);
            float dot = (qh[0] * bflo(kv.x) + qh[1] * bfhi(kv.x)) + (qh[2] * bflo(kv.y) + qh[3] * bfhi(kv.y)) + (qh[4] * bflo(kv.z) + qh[5] * bfhi(kv.z)) + (qh[6] * bflo(kv.w) + qh[7] * bfhi(kv.w));
            dot = dpp_sum8(dot) + rpb[ri * 31 + j];
            sc[j] = dot; rmx = fmaxf(rmx, dot);
        }
        const float mnew = fmaxf(mx, rmx); const float scale = __expf(mx - mnew); mx = mnew;
        sum *= scale;
#pragma unroll
        for (int d = 0; d < 8; ++d) acc[d] *= scale;
#pragma unroll
        for (int j = 0; j < 16; ++j) {
            const u32x4 vv = *(const LAS u32x4*)(vb + (ri * 64 + j) * 128); const float p = __expf(sc[j] - mnew); sum += p;
            acc[0] += p * bflo(vv.x); acc[1] += p * bfhi(vv.x); acc[2] += p * bflo(vv.y); acc[3] += p * bfhi(vv.y);
            acc[4] += p * bflo(vv.z); acc[5] += p * bfhi(vv.z); acc[6] += p * bflo(vv.w); acc[7] += p * bfhi(vv.w);
        }
    }
    const float rinv = 1.0f / sum;
    u32x4 o; o.x = pk2(acc[0] * rinv, acc[1] * rinv); o.y = pk2(acc[2] * rinv, acc[3] * rinv); o.z = pk2(acc[4] * rinv, acc[5] * rinv); o.w = pk2(acc[6] * rinv, acc[7] * rinv);
    *(u32x4*)(YB + qtok * DA + h * 64 + 8 * dp) = o;
}

__device__ __forceinline__ void phase_combine(const Args& a, LAS unsigned char* lds, int G) {
    const int tid = threadIdx.x;
    unsigned char* ws = a.ws;
    const bf16* P = (const bf16*)(ws + WS_P);
    const float* OF = (const float*)(ws + WS_OF); const float* OB = (const float*)(ws + WS_OB); const float* CFB = (const float*)(ws + WS_CFB);
    bf16* YA = (bf16*)(ws + WS_YA);
    LAS unsigned char* G2B = lds;
    LAS float* SIG = (LAS float*)(lds + 131072);
    const float* g2 = a.in[I_G2];
    __syncthreads();
#pragma unroll 4
    for (int i = 0; i < 32; ++i) { const int idx = tid * 4 + 2048 * i; const f32x4 v = *(const f32x4*)(g2 + idx); u32x2 o; o.x = pk2(v.x, v.y); o.y = pk2(v.z, v.w); *(LAS u32x2*)(G2B + idx * 2) = o; }
    const float* mup = a.in[I_MUP]; const float* mun = a.in[I_MUN];
    const int ng = tid & 63, ts = tid >> 6, c0 = 8 * ng, hh = ng >> 3;
    f32x4 lg0 = *(const f32x4*)(a.in[I_LNG] + c0), lg1 = *(const f32x4*)(a.in[I_LNG] + c0 + 4), lb0 = *(const f32x4*)(a.in[I_LNB] + c0), lb1 = *(const f32x4*)(a.in[I_LNB] + c0 + 4);
    f32x4 mpv0 = *(const f32x4*)(mup + C_V + c0), mpv1 = *(const f32x4*)(mup + C_V + c0 + 4), mnv0 = *(const f32x4*)(mun + C_V + c0), mnv1 = *(const f32x4*)(mun + C_V + c0 + 4);
    const int st = tid >> 5, sj = (tid & 31) * 4;
    const f32x4 mpg = *(const f32x4*)(mup + C_LG + sj), mng = *(const f32x4*)(mun + C_LG + sj);
    for (int grp = blockIdx.x; grp < M / 16; grp += G) {
        const int m0 = grp * 16;
        __syncthreads();
        {   const int m = m0 + st, t = m & (SEQ - 1); const bf16* prow = P + (size_t)m * PN + C_LG + sj;
            const u32x2 pc = *(const u32x2*)prow; u32x2 pp = {0u, 0u}, pn = {0u, 0u};
            if (t > 0) pp = *(const u32x2*)(prow - PN); if (t < SEQ - 1) pn = *(const u32x2*)(prow + PN);
            f32x4 xa = shift4(pc, pp, pn, mpg, mng); xa.x = sigmoidf_(xa.x); xa.y = sigmoidf_(xa.y); xa.z = sigmoidf_(xa.z); xa.w = sigmoidf_(xa.w);
            *(LAS f32x4*)(SIG + st * 128 + sj) = xa; }
        __syncthreads();
        float g0[8], g1[8];
#pragma unroll
        for (int k = 0; k < 8; ++k) { g0[k] = 0.f; g1[k] = 0.f; }
#pragma unroll 4
        for (int j = 0; j < 128; ++j) { const u32x4 gv = *(const LAS u32x4*)(G2B + (j * 512 + c0) * 2); const float s0 = SIG[(2 * ts) * 128 + j], s1 = SIG[(2 * ts + 1) * 128 + j];
            const float e[8] = {bflo(gv.x), bfhi(gv.x), bflo(gv.y), bfhi(gv.y), bflo(gv.z), bfhi(gv.z), bflo(gv.w), bfhi(gv.w)};
#pragma unroll
            for (int k = 0; k < 8; ++k) { g0[k] += s0 * e[k]; g1[k] += s1 * e[k]; } }
#pragma unroll
        for (int tk = 0; tk < 2; ++tk) {
            const int m = m0 + 2 * ts + tk, t = m & (SEQ - 1);
            const f32x4 f0 = *(const f32x4*)(OF + (size_t)m * DA + c0), f1 = *(const f32x4*)(OF + (size_t)m * DA + c0 + 4);
            const f32x4 b0 = *(const f32x4*)(OB + (size_t)m * DA + c0), b1 = *(const f32x4*)(OB + (size_t)m * DA + c0 + 4);
            float o[8] = {f0.x + b0.x, f0.y + b0.y, f0.z + b0.z, f0.w + b0.w, f1.x + b1.x, f1.y + b1.y, f1.z + b1.z, f1.w + b1.w};
            float s = 0.f;
#pragma unroll
            for (int k = 0; k < 8; ++k) s += o[k];
            const float mu = dpp_sum8(s) * (1.f / 64.f);
            float vq = 0.f;
#pragma unroll
            for (int k = 0; k < 8; ++k) { o[k] -= mu; vq += o[k] * o[k]; }
            const float rstd = 1.0f / sqrtf(dpp_sum8(vq) * (1.f / 64.f) + GN_EPS);
            const float cfb = CFB[(size_t)m * 16 + hh * 2] + CFB[(size_t)m * 16 + hh * 2 + 1];
            const bf16* prow = P + (size_t)m * PN + C_V + c0;
            const u32x4 pc = *(const u32x4*)prow; u32x4 pp = {0u, 0u, 0u, 0u}, pn = {0u, 0u, 0u, 0u};
            if (t > 0) pp = *(const u32x4*)(prow - PN); if (t < SEQ - 1) pn = *(const u32x4*)(prow + PN);
            const f32x4 xv0 = shift4((u32x2){pc.x, pc.y}, (u32x2){pp.x, pp.y}, (u32x2){pn.x, pn.y}, mpv0, mnv0), xv1 = shift4((u32x2){pc.z, pc.w}, (u32x2){pp.z, pp.w}, (u32x2){pn.z, pn.w}, mpv1, mnv1);
            const float xv[8] = {xv0.x, xv0.y, xv0.z, xv0.w, xv1.x, xv1.y, xv1.z, xv1.w};
            const float lgv[8] = {lg0.x, lg0.y, lg0.z, lg0.w, lg1.x, lg1.y, lg1.z, lg1.w}, lbv[8] = {lb0.x, lb0.y, lb0.z, lb0.w, lb1.x, lb1.y, lb1.z, lb1.w};
            float y[8];
#pragma unroll
            for (int k = 0; k < 8; ++k) y[k] = (o[k] * rstd * lgv[k] + lbv[k] + cfb * xv[k]) * (tk ? g1[k] : g0[k]);
            u32x4 w; w.x = pk2(y[0], y[1]); w.y = pk2(y[2], y[3]); w.z = pk2(y[4], y[5]); w.w = pk2(y[6], y[7]);
            *(u32x4*)(YA + (size_t)m * DA + c0) = w;
        }
    }
    __syncthreads();
}

__device__ __forceinline__ void phase_router(const Args& a, LAS unsigned char* lds, int G) {
    const int tid = threadIdx.x, lane = tid & 63, wave = tid >> 6;
    unsigned char* ws = a.ws;
    const float* X1 = a.out; bf16* H2 = (bf16*)(ws + WS_XN);
    int* list = (int*)(ws + WS_LIST); float* gwt = (float*)(ws + WS_GW);
    unsigned* cnt = (unsigned*)(ws + WS_CTL) + CW_CNT;
    LAS float* WRT = (LAS float*)lds;
    LAS int* rowE = (LAS int*)(lds + 131584); LAS float* rowW = (LAS float*)(lds + 133632); LAS int* rowPos = (LAS int*)(lds + 135680);
    LAS int* bcnt = (LAS int*)(lds + 137728); LAS int* bbase = (LAS int*)(lds + 137856);
    const float* wr = a.in[I_WR];
    __syncthreads();
    for (int i = 0; i < 64; ++i) { const int idx = tid + 512 * i; WRT[(idx & 31) * 1028 + (idx >> 5)] = wr[idx]; }
    f32x4 gf[4];
#pragma unroll
    for (int j = 0; j < 4; ++j) gf[j] = *(const f32x4*)(a.in[I_GFFN] + 256 * j + 4 * lane);
    const float brl = a.in[I_BR][(lane >> 1) & 31];
    for (int grp = blockIdx.x; grp < M / 128; grp += G) {
        __syncthreads();
        if (tid < 32) bcnt[tid] = 0;
        __syncthreads();
        for (int rr = 0; rr < 16; ++rr) {
            const int rl = wave * 16 + rr, m = grp * 128 + rl;
            const f32x4* xr = (const f32x4*)(X1 + (size_t)m * DM) + lane;
            f32x4 v[4]; float s = 0.f;
#pragma unroll
            for (int j = 0; j < 4; ++j) { v[j] = xr[64 * j]; s += (v[j].x * v[j].x + v[j].y * v[j].y) + (v[j].z * v[j].z + v[j].w * v[j].w); }
            const float rstd = 1.0f / sqrtf(wave_sum(s) * (1.f / DM) + RMS_EPS);
            u32x2* o8 = (u32x2*)(H2 + (size_t)m * DM) + lane;
#pragma unroll
            for (int j = 0; j < 4; ++j) { v[j] = v[j] * rstd * gf[j]; u32x2 o; o.x = pk2(v[j].x, v[j].y); o.y = pk2(v[j].z, v[j].w); o8[64 * j] = o; }
            float p[32];
#pragma unroll
            for (int e = 0; e < 32; ++e) { float acc = 0.f;
#pragma unroll
                for (int j = 0; j < 4; ++j) { const f32x4 w = *(const LAS f32x4*)(WRT + e * 1028 + 256 * j + 4 * lane); acc += (v[j].x * w.x + v[j].y * w.y) + (v[j].z * w.z + v[j].w * w.w); }
                p[e] = acc; }
            {   const bool h5 = (lane & 32) != 0;
#pragma unroll
                for (int i = 0; i < 16; ++i) { const float send = h5 ? p[i] : p[i + 16], keep = h5 ? p[i + 16] : p[i]; p[i] = keep + __shfl_xor(send, 32); }
                const bool h4 = (lane & 16) != 0;
#pragma unroll
                for (int i = 0; i < 8; ++i) { const float send = h4 ? p[i] : p[i + 8], keep = h4 ? p[i + 8] : p[i]; p[i] = keep + __shfl_xor(send, 16); }
                const bool h3 = (lane & 8) != 0;
#pragma unroll
                for (int i = 0; i < 4; ++i) { const float send = h3 ? p[i] : p[i + 4], keep = h3 ? p[i + 4] : p[i]; p[i] = keep + __shfl_xor(send, 8); }
                const bool h2 = (lane & 4) != 0;
#pragma unroll
                for (int i = 0; i < 2; ++i) { const float send = h2 ? p[i] : p[i + 2], keep = h2 ? p[i + 2] : p[i]; p[i] = keep + __shfl_xor(send, 4); }
                const bool h1 = (lane & 2) != 0;
                { const float send = h1 ? p[0] : p[1], keep = h1 ? p[1] : p[0]; p[0] = keep + __shfl_xor(send, 2); }
                p[0] += __shfl_xor(p[0], 1);
            }
            float val = p[0] + brl;
            int te[4]; float tv[4];
#pragma unroll
            for (int i = 0; i < 4; ++i) { const float mxv = wave_max(val); const unsigned long long mk = __ballot(val == mxv); const int src = __ffsll((long long)mk) - 1; te[i] = src >> 1; tv[i] = mxv; if ((lane >> 1) == te[i]) val = -3.0e38f; }
            const float e1 = __expf(tv[1] - tv[0]), e2 = __expf(tv[2] - tv[0]), e3 = __expf(tv[3] - tv[0]); const float den = 1.0f / (1.0f + e1 + e2 + e3);
            if (lane < 4) { const int ee = lane == 0 ? te[0] : lane == 1 ? te[1] : lane == 2 ? te[2] : te[3]; const float wv = (lane == 0 ? 1.0f : lane == 1 ? e1 : lane == 2 ? e2 : e3) * den;
                const int pos = __hip_atomic_fetch_add(bcnt + ee, 1, __ATOMIC_RELAXED, __HIP_MEMORY_SCOPE_WORKGROUP);
                rowE[rl * 4 + lane] = ee; rowW[rl * 4 + lane] = wv; rowPos[rl * 4 + lane] = pos; }
        }
        __syncthreads();
        if (tid < 32) bbase[tid] = (int)__hip_atomic_fetch_add(cnt + 64 * tid, (unsigned)bcnt[tid], __ATOMIC_RELAXED, __HIP_MEMORY_SCOPE_AGENT);
        __syncthreads();
        { const int rl = tid >> 2, i = tid & 3, m = grp * 128 + rl; const int e = rowE[tid], pos = bbase[e] + rowPos[tid];
          list[(size_t)e * LISTCAP + pos] = m * 4 + i; gwt[(size_t)m * 4 + i] = rowW[tid]; }
    }
    __syncthreads();
}

__device__ __forceinline__ int moe_table(const Args& a, LAS unsigned char* lds) {
    LAS int* tab = (LAS int*)(lds + MISC_OFF) + 16;
    unsigned* cnt = (unsigned*)(a.ws + WS_CTL) + CW_CNT;
    __syncthreads();
    if (threadIdx.x < 32) tab[threadIdx.x] = (int)__hip_atomic_load(cnt + 64 * threadIdx.x, __ATOMIC_RELAXED, __HIP_MEMORY_SCOPE_AGENT);
    __syncthreads();
    if (threadIdx.x == 0) { int s = 0; for (int e = 0; e < NE; ++e) { tab[32 + e] = s; s += (tab[e] + 255) >> 8; } tab[32 + NE] = s; }
    __syncthreads();
    return tab[32 + NE];
}

__device__ __forceinline__ void phase_final(const Args& a, int G) {
    const int tid = threadIdx.x, lane = tid & 63, wave = tid >> 6;
    const bf16* YBUF = (const bf16*)(a.ws + WS_YBUF); float* out = a.out;
    const int gw = blockIdx.x * 8 + wave, NGW = G * 8;
    for (int m = gw; m < M; m += NGW) {
        f32x4* xr = (f32x4*)(out + (size_t)m * DM) + lane;
#pragma unroll
        for (int j = 0; j < 4; ++j) { f32x4 v = xr[64 * j];
#pragma unroll
            for (int s = 0; s < 4; ++s) { const u32x2 y = *((const u32x2*)(YBUF + ((size_t)s * M + m) * DM) + lane + 64 * j); v.x += bflo(y.x); v.y += bfhi(y.x); v.z += bflo(y.y); v.w += bfhi(y.y); }
            xr[64 * j] = v; }
    }
}

constexpr int N_PHASES = 10;
__global__ void __launch_bounds__(512, 2) mk_fwd(Args args) {
    extern __shared__ __attribute__((aligned(16))) unsigned char lds_raw[];
    LAS unsigned char* lds = (LAS unsigned char*)lds_raw;
    const int tid = threadIdx.x; const int G = gridDim.x;
    unsigned char* ws = args.ws;
    volatile LAS unsigned* MISC = (volatile LAS unsigned*)(lds + MISC_OFF);
    for (int u = tid; u < 256; u += 512) MISC[u] = 0u;
    __syncthreads();
    const int lo = args.ph_lo, hi = args.ph_hi;
    XcdBarrier bar; bar.bar = (unsigned*)(ws + WS_CTL) + CW_BAR; bar.x = 0; bar.st = nullptr;
    if (hi - lo > 1) bar = xcd_barrier_post((unsigned*)(ws + WS_CTL) + CW_BAR, MISC + 8);
#ifndef ONLY_PHASE
#define ONLY_PHASE -1
#endif
#define IN(k) ((ONLY_PHASE < 0 || ONLY_PHASE == (k)) && lo <= (k) && (k) < hi)
#define SEAM(k) do { if (IN(k) && IN((k) + 1)) xcd_barrier(bar); } while (0)

    if (IN(0)) { phase_prologue(args, lds, G); } SEAM(0);
    if (IN(1)) {
        pg8::StaticOrder S; S.init(M, PN, G, (int)blockIdx.x);
        EpiStoreBf16 E{(bf16*)(ws + WS_P), PN};
        pg8::gemm_phase<EpiStoreBf16, pg8::StaticOrder, true, false>(lds, (const bf16*)(ws + WS_XN), (const bf16*)(ws + WS_WIN), 1024, S, E);
    } SEAM(1);
    if (IN(2)) {
#ifndef SKIP_SCAN
        for (int u = blockIdx.x; u < 256; u += G) phase_scan_unit(args, lds, u);
#endif
#ifndef SKIP_NA
        for (int u = blockIdx.x; u < BATCH * NH * 32; u += G) phase_na_unit(args, lds, u);
#endif
    } SEAM(2);
    if (IN(3)) { phase_combine(args, lds, G); } SEAM(3);
    if (IN(4)) {
        pg8::StaticOrder S; S.init(M, DM, G, (int)blockIdx.x);
        { EpiGate<false> E{(bf16*)(ws + WS_MG), (const bf16*)(ws + WS_P), C_GA};
          pg8::gemm_phase<EpiGate<false>, pg8::StaticOrder, true, false>(lds, (const bf16*)(ws + WS_YA), (const bf16*)(ws + WS_WA), 512, S, E); }
        { EpiGate<true> E{(bf16*)(ws + WS_MG), (const bf16*)(ws + WS_P), C_GB};
          pg8::gemm_phase<EpiGate<true>, pg8::StaticOrder, true, false>(lds, (const bf16*)(ws + WS_YB), (const bf16*)(ws + WS_WB), 512, S, E); }
    } SEAM(4);
    if (IN(5)) {
        pg8::StaticOrder S; S.init(M, DM, G, (int)blockIdx.x);
        EpiResid E{args.in[I_X], args.out};
        pg8::gemm_phase<EpiResid, pg8::StaticOrder, true, false>(lds, (const bf16*)(ws + WS_MG), (const bf16*)(ws + WS_WO), 1024, S, E);
    } SEAM(5);
    if (IN(6)) { phase_router(args, lds, G); } SEAM(6);
    if (IN(7)) {
        const int NT = moe_table(args, lds);
        MoeOrder S; S.JP = G / 8; S.x = blockIdx.x % 8; S.j = blockIdx.x / 8; S.NT = NT; S.TPX = (NT + 7) / 8; S.NPN = 8; S.tab = (const LAS int*)(lds + MISC_OFF) + 16; S.list = (const int*)(ws + WS_LIST);
        EpiMoe1 E{(bf16*)(ws + WS_P), args.in[I_B1]};
        pg8::gemm_phase<EpiMoe1, MoeOrder, true, true>(lds, (const bf16*)(ws + WS_XN), (const bf16*)(ws + WS_W1), 1024, S, E);
    } SEAM(7);
    if (IN(8)) {
        const int NT = moe_table(args, lds);
        MoeOrder S; S.JP = G / 8; S.x = blockIdx.x % 8; S.j = blockIdx.x / 8; S.NT = NT; S.TPX = (NT + 7) / 8; S.NPN = 4; S.tab = (const LAS int*)(lds + MISC_OFF) + 16; S.list = (const int*)(ws + WS_LIST);
        EpiMoe2 E{(bf16*)(ws + WS_YBUF), args.in[I_B2], (const int*)(ws + WS_LIST), (const float*)(ws + WS_GW), (const LAS int*)(lds + MISC_OFF) + 16};
        pg8::gemm_phase<EpiMoe2, MoeOrder, true, false>(lds, (const bf16*)(ws + WS_P), (const bf16*)(ws + WS_W2), 1024, S, E);
    } SEAM(8);
    if (IN(9)) { phase_final(args, G); }
#undef IN
#undef SEAM
}

extern "C" void kernel_launch(void* const* d_in, const int* in_sizes, int n_in, void* d_out, int out_size, void* d_ws, size_t ws_size, hipStream_t stream) {
    static int grid = 0;
    if (grid == 0) {
        if (n_in != 32 || in_sizes[0] != M * DM || out_size != M * DM || ws_size < WS_END) {
            fprintf(stderr, "kernel_launch: unexpected problem: n_in %d in0 %d out %d ws %zu (need %zu)\n", n_in, n_in > 0 ? in_sizes[0] : -1, out_size, ws_size, (size_t)WS_END); grid = -1; return; }
        int dev = 0, cus = 0;
        if (hipGetDevice(&dev) != hipSuccess || hipDeviceGetAttribute(&cus, hipDeviceAttributeMultiprocessorCount, dev) != hipSuccess) { grid = -1; return; }
        if (hipFuncSetAttribute((const void*)mk_fwd, hipFuncAttributeMaxDynamicSharedMemorySize, LDS_BYTES) != hipSuccess) { fprintf(stderr, "kernel_launch: hipFuncSetAttribute failed\n"); grid = -1; return; }
        (void)hipGetLastError();
        grid = cus;
        if (grid != 256) fprintf(stderr, "kernel_launch: note: %d CUs\n", grid);
        if (grid % 8 != 0) grid -= grid % 8;
    }
    if (grid < 0) return;
    (void)hipMemsetAsync((char*)d_ws + WS_CTL, 0, CTL_ZERO_BYTES, stream);
    Args a{};
    for (int i = 0; i < 32; ++i) a.in[i] = (const float*)d_in[i];
    a.out = (float*)d_out; a.ws = (unsigned char*)d_ws;
#if MK_N_LAUNCHES == 1
    a.ph_lo = 0; a.ph_hi = N_PHASES; a.li = 0;
    hipLaunchKernelGGL(mk_fwd, dim3(grid), dim3(512), LDS_BYTES, stream, a);
#else
    for (int p = 0; p < N_PHASES; ++p) { a.ph_lo = p; a.ph_hi = p + 1; a.li = p; hipLaunchKernelGGL(mk_fwd, dim3(grid), dim3(512), LDS_BYTES, stream, a); }
#endif
}
```

```cpp
#include <hip/hip_runtime.h>
#include <cstdio>
#include <cstdint>

#ifndef MK_N_LAUNCHES
#define MK_N_LAUNCHES 1
#endif

#ifndef DUP_MASK
#define DUP_MASK 0
#endif
#ifndef SCAN_DUP
#define SCAN_DUP 0
#endif
#ifndef SCAN_DBG
#define SCAN_DBG 0
#endif
#define NREP(k) (((DUP_MASK >> (k)) & 1) + 1)
#define LAS __attribute__((address_space(3)))
#define GAS __attribute__((address_space(1)))
typedef unsigned short bf16;
typedef short bf16x8 __attribute__((ext_vector_type(8)));
typedef float f32x4 __attribute__((ext_vector_type(4)));
typedef float f32x2 __attribute__((ext_vector_type(2)));
typedef unsigned u32x4 __attribute__((ext_vector_type(4)));
typedef unsigned u32x2 __attribute__((ext_vector_type(2)));
typedef GAS unsigned gu32;

constexpr int BATCH = 16, SEQ = 2048, DM = 1024, M = BATCH * SEQ;
constexpr int DA = 512, HD = 64, NH = 8;
constexpr int IN_COLS = 5504, PN = 5632;
constexpr int C_R = 0, C_K = 512, C_V = 1024, C_LWF = 1536, C_LAF = 1664, C_LG = 1792;
constexpr int C_Q = 1920, C_BK = 2432, C_BV = 2944, C_GA = 3456, C_GB = 4480;
constexpr int NE = 32, DE = 1024, LISTCAP = 32768;
constexpr int NT_MAX = 544;
constexpr float RMS_EPS = 1e-5f, GN_EPS = 64e-5f, DECAY_SCALE = 0.6065306597126334f;

constexpr size_t MiB = 1u << 20;
constexpr size_t WS_CTL = 0, CTL_ZERO_BYTES = 1 * MiB;
constexpr size_t WS_WIN = 1 * MiB;
constexpr size_t WS_WA = 12 * MiB, WS_WB = 13 * MiB, WS_WO = 14 * MiB;
constexpr size_t WS_W1 = 16 * MiB;
constexpr size_t WS_W2 = 144 * MiB;
constexpr size_t WS_XN = 208 * MiB;
constexpr size_t WS_P = 272 * MiB;
constexpr size_t WS_OF = 624 * MiB, WS_OB = 688 * MiB;
constexpr size_t WS_YB = 752 * MiB, WS_YA = 784 * MiB;
constexpr size_t WS_MG = 816 * MiB;
constexpr size_t WS_YBUF = 624 * MiB;
constexpr size_t WS_CFB = 880 * MiB;
constexpr size_t WS_GW = 882 * MiB;
constexpr size_t WS_LIST = 883 * MiB;
constexpr size_t WS_END = 888 * MiB;
static_assert(WS_YBUF + 4ull * M * DM * 2 <= WS_CFB, "ybuf overlay");
static_assert((size_t)NT_MAX * 256 * DE * 2 <= 352 * MiB, "act overlay");
constexpr int CW_BAR = 4096;
constexpr int CW_CNT = 16384;

constexpr int LDS_BYTES = 147456;
constexpr int MISC_OFF = LDS_BYTES - 1024;

__device__ __forceinline__ unsigned f2bf(float f) { unsigned u = __builtin_bit_cast(unsigned, f); return (u + 0x7fffu + ((u >> 16) & 1u)) >> 16; }
__device__ __forceinline__ unsigned pk2(float lo, float hi) { return f2bf(lo) | (f2bf(hi) << 16); }
__device__ __forceinline__ float bflo(unsigned u) { return __builtin_bit_cast(float, u << 16); }
__device__ __forceinline__ float bfhi(unsigned u) { return __builtin_bit_cast(float, u & 0xffff0000u); }
__device__ __forceinline__ float sigmoidf_(float x) { return 1.0f / (1.0f + __expf(-x)); }
template <int CTRL> __device__ __forceinline__ float dppf(float x) { return __builtin_bit_cast(float, __builtin_amdgcn_update_dpp(0, __builtin_bit_cast(int, x), CTRL, 0xF, 0xF, true)); }
__device__ __forceinline__ float dpp_sum8(float x) { x += dppf<0xB1>(x); x += dppf<0x4E>(x); x += dppf<0x141>(x); return x; }
__device__ __forceinline__ float dpp_sum16(float x) { x += dppf<0xB1>(x); x += dppf<0x4E>(x); x += dppf<0x141>(x); x += dppf<0x140>(x); return x; }
__device__ __forceinline__ float dpp_max8(float x) { x = fmaxf(x, dppf<0xB1>(x)); x = fmaxf(x, dppf<0x4E>(x)); x = fmaxf(x, dppf<0x141>(x)); return x; }
__device__ __forceinline__ float wave_sum(float v) {
#pragma unroll
    for (int o = 1; o < 64; o <<= 1) v += __shfl_xor(v, o);
    return v;
}
__device__ __forceinline__ float wave_max(float v) {
#pragma unroll
    for (int o = 1; o < 64; o <<= 1) v = fmaxf(v, __shfl_xor(v, o));
    return v;
}
#define LDS_WAIT() asm volatile("s_waitcnt lgkmcnt(0)" ::: "memory")
#define VM_WAIT() asm volatile("s_waitcnt vmcnt(0)" ::: "memory")

namespace pg8 {
constexpr int BM = 256, BK = 64, HALF = 128, HTB = HALF * BK * 2, STAGE_BYTES = 8 * HTB, NXCD = 8, WGM = 8;
__host__ __device__ __forceinline__ int lds_byte(int r, int c) { const int st = (r >> 4) * 2 + (c >> 5), rr = r & 15, cc = c & 31, ob = rr * 64 + cc * 2; return st * 1024 + (ob ^ (((ob >> 9) & 1) << 5)); }
__host__ __device__ __forceinline__ void stage_rc(int b, int& R, int& C) { const int st = b / 1024, sb = b % 1024, swz = sb ^ (((sb >> 9) & 1) << 5); R = (st >> 1) * 16 + swz / 64; C = (st & 1) * 32 + (swz % 64) / 2; }
__host__ __device__ __forceinline__ int perm32(int rho) { const int n = rho >> 4, i = rho & 15; return 8 * (i >> 2) + 4 * n + (i & 3); }

struct Unit { int pm, pn, e, i0; };

struct StaticOrder {
    int nM, nN, nwg, G, c;
    __device__ void init(int M_, int N_, int G_, int c_) { nM = M_ / BM; nN = N_ / BM; nwg = nM * nN; G = G_; c = c_; }
    __device__ bool next(int i, Unit& u) const {
        const long L = (long)i * G + c; if (L >= nwg) return false;
        int wgid = (int)L; { const int q = nwg / NXCD, r = nwg % NXCD, xcd = wgid % NXCD, off = wgid / NXCD; wgid = (xcd < r ? xcd * (q + 1) : r * (q + 1) + (xcd - r) * q) + off; }
        const int nig = WGM * nN, gid = wgid / nig, fm = gid * WGM, gsz = (nM - fm) < WGM ? (nM - fm) : WGM;
        u.pm = fm + ((wgid % nig) % gsz); u.pn = (wgid % nig) / gsz; u.e = 0; u.i0 = 0; return true;
    }
    __device__ __forceinline__ unsigned goff(const Unit&, int) const { return 0u; }
};

__device__ __forceinline__ unsigned cvt_pk_bf16(float lo, float hi) { unsigned r; asm volatile("v_cvt_pk_bf16_f32 %0, %1, %2" : "=v"(r) : "v"(lo), "v"(hi)); return r; }

template <class Epi, class Sched, bool ALIGN_EPI, bool GATHER>
__device__ __forceinline__ void gemm_phase(LAS unsigned char* lds, const bf16* Aall, const bf16* Ball, const int K, const Sched& S, const Epi& E) {
    const int tid = threadIdx.x, wid = __builtin_amdgcn_readfirstlane(tid >> 6), lane = tid & 63, wr = wid >> 2, wc = wid & 3, fr = lane & 15, fq = lane >> 4;
    const int nt = K / BK;
    int Ri[2], Ci[2]; unsigned voffB[2];
#pragma unroll
    for (int i = 0; i < 2; ++i) { stage_rc(tid * 16 + i * 8192, Ri[i], Ci[i]); const int Rb = Epi::PERM ? ((Ri[i] & ~31) + perm32(Ri[i] & 31)) : Ri[i]; voffB[i] = (unsigned)(Rb * K + Ci[i]) * 2u; }
    const size_t kstep = (size_t)(BK * 2);
    const size_t hstep = (size_t)HALF * K * 2;
    const size_t tstep = 2 * hstep;
    const unsigned ldsw = (unsigned)wid * 1024u;
    const int aoff = lds_byte(wr * 64 + fr, fq * 8), boff = lds_byte(wc * 32 + fr, fq * 8);
#define PG8_SA(b, h) (((b) * 2 + (h)) * HTB)
#define PG8_SB(b, h) ((4 + (b) * 2 + (h)) * HTB)
#define PG8_STAGE(bufoff, gbase, v0, v1) do { \
        __builtin_amdgcn_global_load_lds((const unsigned*)((const char*)(gbase) + (v0)), (LAS unsigned*)(lds + (bufoff) + ldsw), 16, 0, 0); \
        __builtin_amdgcn_global_load_lds((const unsigned*)((const char*)(gbase) + (v1)), (LAS unsigned*)(lds + (bufoff) + ldsw + 8192), 16, 0, 0); } while (0)
#define PG8_STAGE_B(bufoff, gbase) PG8_STAGE(bufoff, gbase, voffB[0], voffB[1])
#define PG8_LDA(dst, b, h) do { _Pragma("unroll") for (int m = 0; m < 4; ++m) _Pragma("unroll") for (int k = 0; k < 2; ++k) dst[m][k] = *(const LAS bf16x8*)(lds + PG8_SA(b, h) + aoff + m * 2048 + k * 1024); } while (0)
#define PG8_LDB(dst, b, h) do { _Pragma("unroll") for (int n = 0; n < 2; ++n) _Pragma("unroll") for (int k = 0; k < 2; ++k) dst[n][k] = *(const LAS bf16x8*)(lds + PG8_SB(b, h) + boff + n * 2048 + k * 1024); } while (0)
#define PG8_MMA(ai, bj, At, Bt) do { __builtin_amdgcn_s_setprio(1); _Pragma("unroll") for (int m = 0; m < 4; ++m) _Pragma("unroll") for (int n = 0; n < 2; ++n) _Pragma("unroll") for (int k = 0; k < 2; ++k) \
        acc[ai][bj][m][n] = __builtin_amdgcn_mfma_f32_16x16x32_bf16(Bt[n][k], At[m][k], acc[ai][bj][m][n], 0, 0, 0); __builtin_amdgcn_s_setprio(0); } while (0)
#define PG8_WAIT_V(n) asm volatile("s_waitcnt vmcnt(" #n ")" ::: "memory")
#define PG8_WAIT_L(n) asm volatile("s_waitcnt lgkmcnt(" #n ")" ::: "memory")
#define PG8_BAR __builtin_amdgcn_s_barrier()
#define PG8_SCHED __builtin_amdgcn_sched_barrier(0)
    Unit cur, nxt; int ui = 0;
    if (!S.next(0, cur)) return;
    f32x4 acc[2][2][4][2];
#pragma unroll
    for (int a = 0; a < 2; ++a)
#pragma unroll
        for (int b = 0; b < 2; ++b)
#pragma unroll
            for (int m = 0; m < 4; ++m)
#pragma unroll
                for (int n = 0; n < 2; ++n) acc[a][b][m][n] = (f32x4){0.f, 0.f, 0.f, 0.f};
    bf16x8 At[4][2], B0[2][2], B1[2][2];
    unsigned vc00, vc01, vc10, vc11, vn00, vn01, vn10, vn11;
    if constexpr (GATHER) {
        vc00 = S.goff(cur, Ri[0]) + (unsigned)Ci[0] * 2u; vc01 = S.goff(cur, Ri[1]) + (unsigned)Ci[1] * 2u;
        vc10 = S.goff(cur, 128 + Ri[0]) + (unsigned)Ci[0] * 2u; vc11 = S.goff(cur, 128 + Ri[1]) + (unsigned)Ci[1] * 2u;
    } else {
        vc00 = (unsigned)(Ri[0] * K + Ci[0]) * 2u; vc01 = (unsigned)(Ri[1] * K + Ci[1]) * 2u; vc10 = vc00 + (unsigned)hstep; vc11 = vc01 + (unsigned)hstep;
    }
    vn00 = vc00; vn01 = vc01; vn10 = vc10; vn11 = vc11;
    const char* cA = GATHER ? (const char*)Aall : (const char*)Aall + (size_t)cur.pm * tstep;
    const char* cB = (const char*)Ball + (size_t)cur.pn * tstep;
    PG8_STAGE_B(PG8_SB(0, 0), cB); PG8_STAGE_B(PG8_SB(0, 1), cB + hstep); PG8_STAGE(PG8_SA(0, 0), cA, vc00, vc01); PG8_STAGE(PG8_SA(0, 1), cA, vc10, vc11);
    if (wr == 1) PG8_BAR;
    PG8_WAIT_V(2); PG8_BAR;
    PG8_STAGE_B(PG8_SB(1, 0), cB + kstep); PG8_STAGE(PG8_SA(1, 0), cA + kstep, vc00, vc01); PG8_STAGE_B(PG8_SB(1, 1), cB + hstep + kstep);
    PG8_WAIT_V(6); PG8_BAR;
    for (;;) {
        const bool has_next = S.next(ui + 1, nxt);
        const char* nA = has_next ? (GATHER ? (const char*)Aall : (const char*)Aall + (size_t)nxt.pm * tstep) : cA;
        const char* nB = has_next ? (const char*)Ball + (size_t)nxt.pn * tstep : cB;
        if constexpr (GATHER) {
            if (has_next) {
                vn00 = S.goff(nxt, Ri[0]) + (unsigned)Ci[0] * 2u; vn01 = S.goff(nxt, Ri[1]) + (unsigned)Ci[1] * 2u;
                vn10 = S.goff(nxt, 128 + Ri[0]) + (unsigned)Ci[0] * 2u; vn11 = S.goff(nxt, 128 + Ri[1]) + (unsigned)Ci[1] * 2u;
            }
        }
        for (int t = 0; t < nt; t += 2) {
            const bool last = (t == nt - 2);
            const char* a1 = cA + (size_t)(t + 1) * kstep;
            const char* a2 = last ? nA : cA + (size_t)(t + 2) * kstep; const char* b2 = last ? nB : cB + (size_t)(t + 2) * kstep;
            const char* a3 = a2 + kstep; const char* b3 = b2 + kstep;
            const unsigned s00 = last ? vn00 : vc00, s01 = last ? vn01 : vc01, s10 = last ? vn10 : vc10, s11 = last ? vn11 : vc11;
            PG8_LDB(B0, 0, 0); PG8_LDB(B1, 0, 1); PG8_SCHED; PG8_LDA(At, 0, 0); PG8_STAGE(PG8_SA(1, 1), a1, vc10, vc11);
            PG8_WAIT_V(8); PG8_WAIT_L(0); PG8_BAR; PG8_MMA(0, 0, At, B0); PG8_MMA(0, 1, At, B1); PG8_BAR; PG8_SCHED;
            PG8_LDA(At, 0, 1); PG8_STAGE_B(PG8_SB(0, 0), b2); PG8_STAGE_B(PG8_SB(0, 1), b2 + hstep); PG8_STAGE(PG8_SA(0, 0), a2, s00, s01);
            PG8_WAIT_V(8); PG8_WAIT_L(0); PG8_BAR; PG8_MMA(1, 0, At, B0); PG8_MMA(1, 1, At, B1); PG8_BAR; PG8_SCHED;
            PG8_LDB(B0, 1, 0); PG8_LDB(B1, 1, 1); PG8_SCHED; PG8_LDA(At, 1, 0); PG8_STAGE(PG8_SA(0, 1), a2, s10, s11);
            PG8_WAIT_V(8); PG8_WAIT_L(0); PG8_BAR; PG8_MMA(0, 0, At, B0); PG8_MMA(0, 1, At, B1); PG8_BAR; PG8_SCHED;
            PG8_LDA(At, 1, 1); PG8_STAGE_B(PG8_SB(1, 0), b3); PG8_STAGE_B(PG8_SB(1, 1), b3 + hstep); PG8_STAGE(PG8_SA(1, 0), a3, s00, s01);
            PG8_WAIT_V(8); PG8_WAIT_L(0); PG8_BAR; PG8_MMA(1, 0, At, B0); PG8_MMA(1, 1, At, B1); PG8_BAR; PG8_SCHED;
        }
        if constexpr (ALIGN_EPI) { if (wr == 0) PG8_BAR; }
        E(acc, cur, wr, wc, fr, fq);
        if (!has_next) break;
#pragma unroll
        for (int a = 0; a < 2; ++a)
#pragma unroll
            for (int b = 0; b < 2; ++b)
#pragma unroll
                for (int m = 0; m < 4; ++m)
#pragma unroll
                    for (int n = 0; n < 2; ++n) acc[a][b][m][n] = (f32x4){0.f, 0.f, 0.f, 0.f};
        cur = nxt; cA = nA; cB = nB; ++ui;
        vc00 = vn00; vc01 = vn01; vc10 = vn10; vc11 = vn11;
        if constexpr (ALIGN_EPI) { if (wr == 1) PG8_BAR; }
    }
    PG8_WAIT_V(0);
    if constexpr (!ALIGN_EPI) { if (wr == 0) PG8_BAR; }
    PG8_BAR;
#undef PG8_SA
#undef PG8_SB
#undef PG8_STAGE
#undef PG8_STAGE_B
#undef PG8_LDA
#undef PG8_LDB
#undef PG8_MMA
#undef PG8_WAIT_V
#undef PG8_WAIT_L
#undef PG8_BAR
#undef PG8_SCHED
}
}

struct EpiStoreBf16 {
    static constexpr bool PERM = true;
    bf16* O; int ldc;
    __device__ __forceinline__ void operator()(const f32x4 (&acc)[2][2][4][2], const pg8::Unit& u, int wr, int wc, int fr, int fq) const {
        const int row0 = u.pm * 256 + wr * 64 + fr, col0 = u.pn * 256 + wc * 32 + 8 * fq;
#pragma unroll
        for (int ai = 0; ai < 2; ++ai)
#pragma unroll
            for (int m = 0; m < 4; ++m) { bf16* rowp = O + (size_t)(row0 + ai * 128 + m * 16) * ldc + col0;
#pragma unroll
                for (int bj = 0; bj < 2; ++bj) { const f32x4 v0 = acc[ai][bj][m][0], v1 = acc[ai][bj][m][1]; u32x4 w;
                    w.x = pg8::cvt_pk_bf16(v0[0], v0[1]); w.y = pg8::cvt_pk_bf16(v0[2], v0[3]); w.z = pg8::cvt_pk_bf16(v1[0], v1[1]); w.w = pg8::cvt_pk_bf16(v1[2], v1[3]);
                    *(u32x4*)(rowp + bj * 128) = w; } }
    }
};
template <bool ADD> struct EpiGate {
    static constexpr bool PERM = true;
    bf16* MG; const bf16* P; int gcol0;
    __device__ __forceinline__ void operator()(const f32x4 (&acc)[2][2][4][2], const pg8::Unit& u, int wr, int wc, int fr, int fq) const {
        const int row0 = u.pm * 256 + wr * 64 + fr, col0 = u.pn * 256 + wc * 32 + 8 * fq;
#pragma unroll
        for (int ai = 0; ai < 2; ++ai)
#pragma unroll
            for (int m = 0; m < 4; ++m) { const size_t row = (size_t)(row0 + ai * 128 + m * 16);
#pragma unroll
                for (int bj = 0; bj < 2; ++bj) { const int col = col0 + bj * 128;
                    const u32x4 g = *(const u32x4*)(P + row * PN + gcol0 + col);
                    float o[8]; const f32x4 v0 = acc[ai][bj][m][0], v1 = acc[ai][bj][m][1];
                    o[0] = v0[0] * sigmoidf_(bflo(g.x)); o[1] = v0[1] * sigmoidf_(bfhi(g.x)); o[2] = v0[2] * sigmoidf_(bflo(g.y)); o[3] = v0[3] * sigmoidf_(bfhi(g.y));
                    o[4] = v1[0] * sigmoidf_(bflo(g.z)); o[5] = v1[1] * sigmoidf_(bfhi(g.z)); o[6] = v1[2] * sigmoidf_(bflo(g.w)); o[7] = v1[3] * sigmoidf_(bfhi(g.w));
                    bf16* dst = MG + row * DM + col;
                    if (ADD) { const u32x4 p = *(const u32x4*)dst;
                        o[0] += bflo(p.x); o[1] += bfhi(p.x); o[2] += bflo(p.y); o[3] += bfhi(p.y); o[4] += bflo(p.z); o[5] += bfhi(p.z); o[6] += bflo(p.w); o[7] += bfhi(p.w); }
                    u32x4 w; w.x = pg8::cvt_pk_bf16(o[0], o[1]); w.y = pg8::cvt_pk_bf16(o[2], o[3]); w.z = pg8::cvt_pk_bf16(o[4], o[5]); w.w = pg8::cvt_pk_bf16(o[6], o[7]);
                    *(u32x4*)dst = w; } }
    }
};
struct EpiResid {
    static constexpr bool PERM = false;
    const float* X; float* O;
    __device__ __forceinline__ void operator()(const f32x4 (&acc)[2][2][4][2], const pg8::Unit& u, int wr, int wc, int fr, int fq) const {
        const int row0 = u.pm * 256 + wr * 64 + fr, col0 = u.pn * 256 + wc * 32 + 4 * fq;
#pragma unroll
        for (int ai = 0; ai < 2; ++ai)
#pragma unroll
            for (int m = 0; m < 4; ++m) { const size_t off = (size_t)(row0 + ai * 128 + m * 16) * DM + col0;
#pragma unroll
                for (int bj = 0; bj < 2; ++bj)
#pragma unroll
                    for (int n = 0; n < 2; ++n) { const f32x4 xv = *(const f32x4*)(X + off + bj * 128 + n * 16); *(f32x4*)(O + off + bj * 128 + n * 16) = xv + acc[ai][bj][m][n]; } }
    }
};
struct EpiMoe1 {
    static constexpr bool PERM = true;
    bf16* ACT; const float* b1;
    __device__ __forceinline__ void operator()(const f32x4 (&acc)[2][2][4][2], const pg8::Unit& u, int wr, int wc, int fr, int fq) const {
        const int pnl = u.pn & 7; const int row0 = u.pm * 256 + wr * 64 + fr, j0 = pnl * 128 + wc * 32 + 8 * fq;
        const float* bg = b1 + (size_t)u.e * 2048 + j0; const float* bl = bg + 1024;
        const f32x4 bg0 = *(const f32x4*)bg, bg1 = *(const f32x4*)(bg + 4), bl0 = *(const f32x4*)bl, bl1 = *(const f32x4*)(bl + 4);
#pragma unroll
        for (int ai = 0; ai < 2; ++ai)
#pragma unroll
            for (int m = 0; m < 4; ++m) { bf16* dst = ACT + (size_t)(row0 + ai * 128 + m * 16) * DE + j0; float o[8];
#pragma unroll
                for (int n = 0; n < 2; ++n) { const f32x4 gv = acc[ai][0][m][n] + (n ? bg1 : bg0), lv = acc[ai][1][m][n] + (n ? bl1 : bl0);
#pragma unroll
                    for (int k = 0; k < 4; ++k) { const float g = fminf(gv[k], 7.0f), l = fminf(fmaxf(lv[k], -7.0f), 7.0f); o[n * 4 + k] = g * sigmoidf_(1.702f * g) * (l + 1.0f); } }
                u32x4 w; w.x = pg8::cvt_pk_bf16(o[0], o[1]); w.y = pg8::cvt_pk_bf16(o[2], o[3]); w.z = pg8::cvt_pk_bf16(o[4], o[5]); w.w = pg8::cvt_pk_bf16(o[6], o[7]);
                *(u32x4*)dst = w; }
    }
};
struct EpiMoe2 {
    static constexpr bool PERM = true;
    bf16* YBUF; const float* b2; const int* list; const float* gw; const LAS int* tab;
    __device__ __forceinline__ void operator()(const f32x4 (&acc)[2][2][4][2], const pg8::Unit& u, int wr, int wc, int fr, int fq) const {
        const int pnl = u.pn & 3; const int rl0 = wr * 64 + fr, col0 = pnl * 256 + wc * 32 + 8 * fq; const int cnt = tab[u.e];
        f32x4 bv[2][2];
#pragma unroll
        for (int bj = 0; bj < 2; ++bj)
#pragma unroll
            for (int n = 0; n < 2; ++n) bv[bj][n] = *(const f32x4*)(b2 + (size_t)u.e * 1024 + col0 + bj * 128 + 4 * n);
#pragma unroll
        for (int ai = 0; ai < 2; ++ai)
#pragma unroll
            for (int m = 0; m < 4; ++m) { const int idx = u.i0 + rl0 + ai * 128 + m * 16;
                if (idx < cnt) { const int ent = list[(size_t)u.e * LISTCAP + idx]; const float w8 = gw[ent]; const int tok = ent >> 2, slot = ent & 3;
                    bf16* rowp = YBUF + ((size_t)slot * M + tok) * DM + col0;
#pragma unroll
                    for (int bj = 0; bj < 2; ++bj) { const f32x4 v0 = (acc[ai][bj][m][0] + bv[bj][0]) * w8, v1 = (acc[ai][bj][m][1] + bv[bj][1]) * w8; u32x4 w;
                        w.x = pg8::cvt_pk_bf16(v0[0], v0[1]); w.y = pg8::cvt_pk_bf16(v0[2], v0[3]); w.z = pg8::cvt_pk_bf16(v1[0], v1[1]); w.w = pg8::cvt_pk_bf16(v1[2], v1[3]);
                        *(u32x4*)(rowp + bj * 128) = w; } } }
    }
};
struct MoeOrder {
    int JP, x, j, TPX, NT, NPN; const LAS int* tab; const int* list;
    __device__ bool next(int i, pg8::Unit& u) const {
        const int q = i * JP + j; const int lt = q / NPN, pn = q % NPN; if (lt >= TPX) return false; const int gt = x * TPX + lt; if (gt >= NT) return false;
        int e = 0;
        for (int k = 1; k < NE; ++k) e += (tab[32 + k] <= gt) ? 1 : 0;
        e = __builtin_amdgcn_readfirstlane(e); const int ts = __builtin_amdgcn_readfirstlane(tab[32 + e]);
        u.pm = gt; u.pn = e * NPN + pn; u.e = e; u.i0 = (gt - ts) * 256; return true;
    }
    __device__ __forceinline__ unsigned goff(const pg8::Unit& u, int r) const {
        const int idx = u.i0 + r; int tok = 0; if (idx < tab[u.e]) tok = list[(size_t)u.e * LISTCAP + idx] >> 2; return (unsigned)tok * (unsigned)(DM * 2);
    }
};

#define XB_TMO      128
#define XB_XCNT(j)  (256  + 64 * (j))
#define XB_XSUB(j)  (1280 + 64 * (j))
#define XB_XGEN(j)  (2304 + 64 * (j))
#define XB_TOP      3328
#define XB_TOPGEN   3392
#define XCD_BAR_WORDS 3456
#define XB_SPIN_CAP (1u << 20)
__device__ __forceinline__ unsigned xb_ld(unsigned* p)              { return __hip_atomic_load(p, __ATOMIC_RELAXED, __HIP_MEMORY_SCOPE_AGENT); }
__device__ __forceinline__ unsigned xb_add(unsigned* p, unsigned v) { return __hip_atomic_fetch_add(p, v, __ATOMIC_RELAXED, __HIP_MEMORY_SCOPE_AGENT); }
__device__ __forceinline__ unsigned xb_xcc_id() { return (unsigned)__builtin_amdgcn_s_getreg((3 << 11) | 20) & 0xFu; }
#define XB_SPIN(cond, bar) do { unsigned _sp = 0; while (cond) { __builtin_amdgcn_s_sleep(1); \
    if ((++_sp & 255u) == 0u) { if (xb_ld(&(bar)[XB_TMO])) break; if (_sp > XB_SPIN_CAP) { atomicAdd(&(bar)[XB_TMO], 1u); break; } } } } while (0)
struct XcdBarrier { unsigned* bar; unsigned x; volatile LAS unsigned* st; };
__device__ __forceinline__ XcdBarrier xcd_barrier_post(unsigned* bar, volatile LAS unsigned* st) {
    XcdBarrier b; b.bar = bar; b.x = xb_xcc_id(); b.st = st;
    if (threadIdx.x == 0) (void)xb_add(&bar[XB_XCNT(b.x)], 1u);
    return b;
}
__device__ __forceinline__ void xcd_barrier_complete(unsigned* bar, unsigned x, unsigned& nloc, unsigned& nx) {
    const unsigned G = gridDim.x * gridDim.y * gridDim.z;
    unsigned sum, cnt, mine, sp = 0u;
    for (;;) {
        sum = 0u; cnt = 0u; mine = 0u;
#pragma unroll
        for (unsigned j = 0; j < 16; ++j) { const unsigned c = xb_ld(&bar[XB_XCNT(j)]); sum += c; cnt += (c > 0u) ? 1u : 0u; mine = (j == x) ? c : mine; }
        if (sum == G) break;
        __builtin_amdgcn_s_sleep(1);
        if ((++sp & 255u) == 0u) { if (xb_ld(&bar[XB_TMO])) break; if (sp > XB_SPIN_CAP) { atomicAdd(&bar[XB_TMO], 1u); break; } }
    }
    nloc = mine > 0u ? mine : 1u; nx = cnt > 0u ? cnt : 1u;
}
__device__ __forceinline__ void xcd_barrier(const XcdBarrier& b) {
    asm volatile("s_waitcnt vmcnt(0)" ::: "memory");
    __syncthreads();
    if (threadIdx.x == 0) {
        unsigned* bar = b.bar;
        __builtin_amdgcn_s_waitcnt(0);
        unsigned nloc = b.st[0], nx = b.st[1];
        if (nloc == 0u) { xcd_barrier_complete(bar, b.x, nloc, nx); b.st[0] = nloc; b.st[1] = nx; }
        const unsigned old = xb_add(&bar[XB_XSUB(b.x)], 1u);
        const unsigned gen = old / nloc;
        if (old + 1u == (gen + 1u) * nloc) {
            __builtin_amdgcn_fence(__ATOMIC_RELEASE, "agent");
            asm volatile("s_waitcnt vmcnt(0)" ::: "memory");
            const unsigned og = xb_add(&bar[XB_TOP], 1u);
            const unsigned tg = og / nx;
            if (og + 1u == (tg + 1u) * nx) xb_add(&bar[XB_TOPGEN], 1u);
            else XB_SPIN(xb_ld(&bar[XB_TOPGEN]) == tg, bar);
            __builtin_amdgcn_fence(__ATOMIC_ACQUIRE, "agent");
            xb_add(&bar[XB_XGEN(b.x)], 1u);
            asm volatile("s_waitcnt vmcnt(0)" ::: "memory");
        } else {
            XB_SPIN(xb_ld(&bar[XB_XGEN(b.x)]) == gen, bar);
            __builtin_amdgcn_fence(__ATOMIC_ACQUIRE, "agent");
            asm volatile("s_waitcnt vmcnt(0)" ::: "memory");
        }
    }
    __syncthreads();
}

struct Args { const float* in[32]; float* out; unsigned char* ws; int ph_lo, ph_hi, li, pad; };
enum { I_X = 0, I_GMIX, I_WIN, I_MUP, I_MUN, I_W0F, I_W2F, I_W0B, I_W2B, I_A0F, I_A2F, I_A0B, I_A2B, I_G2, I_KK, I_KA, I_RK, I_LNG, I_LNB, I_QG, I_KG, I_RPB,
       I_WA, I_WB, I_WO, I_GFFN, I_WR, I_BR, I_W1, I_B1, I_W2, I_B2 };

__device__ __forceinline__ void p0_transpose_item(const float* W, int K, int N, bf16* WT, int k0, int n0, int drow0, LAS float* scr, int lane) {
#pragma unroll 8
    for (int i = 0; i < 32; ++i) { const int kk = 2 * i + (lane >> 5); scr[kk * 33 + (lane & 31)] = W[(size_t)(k0 + kk) * N + n0 + (lane & 31)]; }
    LDS_WAIT(); asm volatile("" ::: "memory");
    const int c = lane & 7;
#pragma unroll
    for (int j = 0; j < 4; ++j) { const int n = (lane >> 3) + 8 * j; const LAS float* s = scr + (8 * c) * 33 + n;
        u32x4 o; o.x = pk2(s[0 * 33], s[1 * 33]); o.y = pk2(s[2 * 33], s[3 * 33]); o.z = pk2(s[4 * 33], s[5 * 33]); o.w = pk2(s[6 * 33], s[7 * 33]);
        *(GAS u32x4*)(WT + (size_t)(drow0 + n) * K + k0 + 8 * c) = o; }
    LDS_WAIT(); asm volatile("" ::: "memory");
}
__device__ __forceinline__ void phase_prologue(const Args& a, LAS unsigned char* lds, int G) {
    const int tid = threadIdx.x, lane = tid & 63, wave = tid >> 6;
    unsigned char* ws = a.ws;
    LAS float* scr = (LAS float*)(lds + wave * 16384);
    const int gw = blockIdx.x * 8 + wave, NGW = G * 8;
    constexpr int I_IN = 16 * 172, I_AB = 8 * 32, I_O = 16 * 32, I_1 = 32 * 16 * 64, I_2 = 32 * 16 * 32;
    constexpr int NITEMS = I_IN + 2 * I_AB + I_O + I_1 + I_2;
    const float* x = a.in[I_X]; const float* gmix = a.in[I_GMIX]; bf16* XN = (bf16*)(ws + WS_XN);
    f32x4 gm[4];
#pragma unroll
    for (int j = 0; j < 4; ++j) gm[j] = *(const f32x4*)(gmix + 256 * j + 4 * lane);
    for (int m = gw; m < M; m += NGW) {
        const GAS f32x4* xr = (const GAS f32x4*)(x + (size_t)m * DM) + lane;
        f32x4 v[4]; float s = 0.f;
#pragma unroll
        for (int j = 0; j < 4; ++j) { v[j] = xr[64 * j]; s += (v[j].x * v[j].x + v[j].y * v[j].y) + (v[j].z * v[j].z + v[j].w * v[j].w); }
        const float rstd = 1.0f / sqrtf(wave_sum(s) * (1.f / DM) + RMS_EPS);
        GAS u32x2* o8 = (GAS u32x2*)(XN + (size_t)m * DM) + lane;
#pragma unroll
        for (int j = 0; j < 4; ++j) { u32x2 o; o.x = pk2(v[j].x * rstd * gm[j].x, v[j].y * rstd * gm[j].y); o.y = pk2(v[j].z * rstd * gm[j].z, v[j].w * rstd * gm[j].w); o8[64 * j] = o; }
    }
    for (int it = gw; it < NITEMS; it += NGW) {
        int r = it;
        if (r < I_IN) { const int kb = r / 172, nb = r % 172; p0_transpose_item(a.in[I_WIN], 1024, IN_COLS, (bf16*)(ws + WS_WIN), 64 * kb, 32 * nb, 32 * nb, scr, lane); continue; } r -= I_IN;
        if (r < I_AB) { const int kb = r / 32, nb = r % 32; p0_transpose_item(a.in[I_WA], 512, 1024, (bf16*)(ws + WS_WA), 64 * kb, 32 * nb, 32 * nb, scr, lane); continue; } r -= I_AB;
        if (r < I_AB) { const int kb = r / 32, nb = r % 32; p0_transpose_item(a.in[I_WB], 512, 1024, (bf16*)(ws + WS_WB), 64 * kb, 32 * nb, 32 * nb, scr, lane); continue; } r -= I_AB;
        if (r < I_O) { const int kb = r / 32, nb = r % 32; p0_transpose_item(a.in[I_WO], 1024, 1024, (bf16*)(ws + WS_WO), 64 * kb, 32 * nb, 32 * nb, scr, lane); continue; } r -= I_O;
        if (r < I_1) { const int e = r / 1024, rr = r % 1024, kb = rr / 64, nb = rr % 64; const int c0 = 32 * nb;
            const int drow = 256 * ((c0 & 1023) >> 7) + 128 * (c0 >> 10) + (c0 & 127);
            p0_transpose_item(a.in[I_W1] + (size_t)e * 1024 * 2048, 1024, 2048, (bf16*)(ws + WS_W1) + (size_t)e * 2048 * 1024, 64 * kb, c0, drow, scr, lane); continue; } r -= I_1;
        { const int e = r / 512, rr = r % 512, kb = rr / 32, nb = rr % 32;
            p0_transpose_item(a.in[I_W2] + (size_t)e * 1024 * 1024, 1024, 1024, (bf16*)(ws + WS_W2) + (size_t)e * 1024 * 1024, 64 * kb, 32 * nb, 32 * nb, scr, lane); }
    }
    { GAS u32x4* z = (GAS u32x4*)((bf16*)(ws + WS_WIN) + (size_t)IN_COLS * 1024);
      for (int i = blockIdx.x * 512 + tid; i < 16384; i += G * 512) z[i] = (u32x4){0u, 0u, 0u, 0u}; }
}

__device__ __forceinline__ f32x4 shift4(u32x2 pc, u32x2 pp, u32x2 pn, f32x4 mup, f32x4 mun) {
    f32x4 c = {bflo(pc.x), bfhi(pc.x), bflo(pc.y), bfhi(pc.y)}, p = {bflo(pp.x), bfhi(pp.x), bflo(pp.y), bfhi(pp.y)}, n = {bflo(pn.x), bfhi(pn.x), bflo(pn.y), bfhi(pn.y)};
    return c + mup * (p - c) + mun * (n - c);
}
__device__ __forceinline__ float fast_sigmoid(float x) { return __builtin_amdgcn_rcpf(1.0f + __expf(-x)); }
__device__ __forceinline__ float fast_tanh(float x) { return 1.0f - 2.0f * __builtin_amdgcn_rcpf(1.0f + __expf(2.0f * x)); }
__device__ __forceinline__ float fma_s(float a, float b, float c) { float r; asm("v_fma_f32 %0, %1, %2, %3" : "=v"(r) : "v"(a), "v"(b), "v"(c)); return r; }
__device__ __forceinline__ float mul_s(float a, float b) { float r; asm("v_mul_f32_e32 %0, %1, %2" : "=v"(r) : "v"(a), "v"(b)); return r; }
__device__ __forceinline__ float add_s(float a, float b) { float r; asm("v_add_f32_e32 %0, %1, %2" : "=v"(r) : "v"(a), "v"(b)); return r; }
__device__ __forceinline__ float dot4_s(const float (&s)[4], const f32x4 v) { const float m0 = mul_s(s[0], v[0]), m2 = mul_s(s[2], v[2]); return add_s(fma_s(s[1], v[1], m0), fma_s(s[3], v[3], m2)); }
__device__ __forceinline__ void dpp_sum16_x4(float& a, float& b, float& c, float& d) {
    asm("s_nop 1\n\t"
        "v_add_f32_dpp %0, %0, %0 quad_perm:[1,0,3,2] row_mask:0xf bank_mask:0xf\n\t"
        "v_add_f32_dpp %1, %1, %1 quad_perm:[1,0,3,2] row_mask:0xf bank_mask:0xf\n\t"
        "v_add_f32_dpp %2, %2, %2 quad_perm:[1,0,3,2] row_mask:0xf bank_mask:0xf\n\t"
        "v_add_f32_dpp %3, %3, %3 quad_perm:[1,0,3,2] row_mask:0xf bank_mask:0xf\n\t"
        "v_add_f32_dpp %0, %0, %0 quad_perm:[2,3,0,1] row_mask:0xf bank_mask:0xf\n\t"
        "v_add_f32_dpp %1, %1, %1 quad_perm:[2,3,0,1] row_mask:0xf bank_mask:0xf\n\t"
        "v_add_f32_dpp %2, %2, %2 quad_perm:[2,3,0,1] row_mask:0xf bank_mask:0xf\n\t"
        "v_add_f32_dpp %3, %3, %3 quad_perm:[2,3,0,1] row_mask:0xf bank_mask:0xf\n\t"
        "v_add_f32_dpp %0, %0, %0 row_half_mirror row_mask:0xf bank_mask:0xf\n\t"
        "v_add_f32_dpp %1, %1, %1 row_half_mirror row_mask:0xf bank_mask:0xf\n\t"
        "v_add_f32_dpp %2, %2, %2 row_half_mirror row_mask:0xf bank_mask:0xf\n\t"
        "v_add_f32_dpp %3, %3, %3 row_half_mirror row_mask:0xf bank_mask:0xf\n\t"
        "v_add_f32_dpp %0, %0, %0 row_mirror row_mask:0xf bank_mask:0xf\n\t"
        "v_add_f32_dpp %1, %1, %1 row_mirror row_mask:0xf bank_mask:0xf\n\t"
        "v_add_f32_dpp %2, %2, %2 row_mirror row_mask:0xf bank_mask:0xf\n\t"
        "v_add_f32_dpp %3, %3, %3 row_mirror row_mask:0xf bank_mask:0xf\n\t"
        "s_nop 0"
        : "+v"(a), "+v"(b), "+v"(c), "+v"(d));
}
#define LDS_BARRIER() do { asm volatile("s_waitcnt lgkmcnt(0)" ::: "memory"); __builtin_amdgcn_s_barrier(); asm volatile("" ::: "memory"); } while (0)
#define WAVE_LDS_SYNC() do { asm volatile("s_waitcnt lgkmcnt(0)" ::: "memory"); __builtin_amdgcn_wave_barrier(); asm volatile("" ::: "memory"); } while (0)
typedef short s16x4 __attribute__((ext_vector_type(4)));
typedef __bf16 bf16x2_t __attribute__((ext_vector_type(2)));
__device__ __forceinline__ unsigned cvtpk2(float lo, float hi) { const f32x2 v = {lo, hi}; const bf16x2_t b = __builtin_convertvector(v, bf16x2_t); return __builtin_bit_cast(unsigned, b); }
__device__ __forceinline__ s16x4 f4_to_bf4(const f32x4 v) { u32x2 w; w.x = cvtpk2(v[0], v[1]); w.y = cvtpk2(v[2], v[3]); return __builtin_bit_cast(s16x4, w); }
__device__ __forceinline__ f32x4 mfma16(s16x4 a, s16x4 b, f32x4 c) { return __builtin_amdgcn_mfma_f32_16x16x16bf16_1k(a, b, c, 0, 0, 0); }
__device__ __forceinline__ s16x4 lds_tr4(const LAS unsigned char* p) { return __builtin_bit_cast(s16x4, __builtin_amdgcn_ds_read_tr16_b64_v4i16((LAS s16x4*)p)); }
template <int CTRL> __device__ __forceinline__ float dpp0f(float x) { return __builtin_bit_cast(float, __builtin_amdgcn_update_dpp(0, __builtin_bit_cast(int, x), CTRL, 0xF, 0xF, true)); }
__device__ __forceinline__ float row_scan16(float x) { x += dpp0f<0x111>(x); x += dpp0f<0x112>(x); x += dpp0f<0x114>(x); x += dpp0f<0x118>(x); return x; }

constexpr int SC_W2T = 0, SC_A2T = 9216, SC_PRM = 18432, SC_PRIV = 22528, SC_PP = 12800, SC_HAND = 73728, SC_HP = 13056;
constexpr int HO_KAP = 0, HO_RT = 2304, HO_KDG = 4608, HO_VV = 6912, HO_BMT = 9216, HO_MBT = 9728, HO_N1T = 10240, HO_TBT = 10752, HO_GC = 12800;
constexpr int PV_XA = 0, PV_LOUT = 0, PV_BT = 8192, PV_KD = 10496;
struct Raw6 { u32x4 c0, c1, p0, p1, n0, n1; };
__device__ __forceinline__ void scan_load_seg(Raw6& R, const bf16* prow, int col, bool hp, bool hn) {
    R.c0 = *(const u32x4*)(prow + col); R.c1 = *(const u32x4*)(prow + col + 8);
    const bf16* pp = hp ? prow - PN : prow; const bf16* pn = hn ? prow + PN : prow;
    R.p0 = *(const u32x4*)(pp + col); R.p1 = *(const u32x4*)(pp + col + 8); R.n0 = *(const u32x4*)(pn + col); R.n1 = *(const u32x4*)(pn + col + 8);
    if (!hp) { R.p0 = (u32x4){0u, 0u, 0u, 0u}; R.p1 = R.p0; } if (!hn) { R.n0 = (u32x4){0u, 0u, 0u, 0u}; R.n1 = R.n0; }
}
__device__ __forceinline__ void scan_shift16(float (&x)[16], const Raw6& R, const LAS float* mup, const LAS float* mun) {
    const unsigned c[8] = {R.c0.x, R.c0.y, R.c0.z, R.c0.w, R.c1.x, R.c1.y, R.c1.z, R.c1.w}, p[8] = {R.p0.x, R.p0.y, R.p0.z, R.p0.w, R.p1.x, R.p1.y, R.p1.z, R.p1.w}, n[8] = {R.n0.x, R.n0.y, R.n0.z, R.n0.w, R.n1.x, R.n1.y, R.n1.z, R.n1.w};
#pragma unroll
    for (int q4 = 0; q4 < 4; ++q4) { const f32x4 mp = *(const LAS f32x4*)(mup + 4 * q4), mn = *(const LAS f32x4*)(mun + 4 * q4);
#pragma unroll
        for (int e = 0; e < 4; ++e) { const int j = 4 * q4 + e; const unsigned cw = c[j >> 1], pw = p[j >> 1], nw = n[j >> 1];
            const float cv = (j & 1) ? bfhi(cw) : bflo(cw), pv = (j & 1) ? bfhi(pw) : bflo(pw), nv = (j & 1) ? bfhi(nw) : bflo(nw);
            x[j] = cv + mp[e] * (pv - cv) + mn[e] * (nv - cv); } }
}
__device__ __forceinline__ f32x4 scan_shift4(const Raw6& R, int q4, const LAS float* mup, const LAS float* mun) {
    const unsigned c0 = q4 == 0 ? R.c0.x : q4 == 1 ? R.c0.z : q4 == 2 ? R.c1.x : R.c1.z, c1 = q4 == 0 ? R.c0.y : q4 == 1 ? R.c0.w : q4 == 2 ? R.c1.y : R.c1.w;
    const unsigned p0 = q4 == 0 ? R.p0.x : q4 == 1 ? R.p0.z : q4 == 2 ? R.p1.x : R.p1.z, p1 = q4 == 0 ? R.p0.y : q4 == 1 ? R.p0.w : q4 == 2 ? R.p1.y : R.p1.w;
    const unsigned n0 = q4 == 0 ? R.n0.x : q4 == 1 ? R.n0.z : q4 == 2 ? R.n1.x : R.n1.z, n1 = q4 == 0 ? R.n0.y : q4 == 1 ? R.n0.w : q4 == 2 ? R.n1.y : R.n1.w;
    const f32x4 mp = *(const LAS f32x4*)(mup + 4 * q4), mn = *(const LAS f32x4*)(mun + 4 * q4);
    const f32x4 cv = {bflo(c0), bfhi(c0), bflo(c1), bfhi(c1)}, pv = {bflo(p0), bfhi(p0), bflo(p1), bfhi(p1)}, nv = {bflo(n0), bfhi(n0), bflo(n1), bfhi(n1)};
    return cv + mp * (pv - cv) + mn * (nv - cv);
}
__device__ __forceinline__ void scan_store4_bf(LAS unsigned char* dst, const f32x4 v) { u32x2 w; w.x = cvtpk2(v[0], v[1]); w.y = cvtpk2(v[2], v[3]); *(LAS u32x2*)dst = w; }
__device__ __forceinline__ void scan_store16_bf(LAS unsigned char* dst, const float (&x)[16]) {
    u32x4 w0, w1; w0.x = cvtpk2(x[0], x[1]); w0.y = cvtpk2(x[2], x[3]); w0.z = cvtpk2(x[4], x[5]); w0.w = cvtpk2(x[6], x[7]); w1.x = cvtpk2(x[8], x[9]); w1.y = cvtpk2(x[10], x[11]); w1.z = cvtpk2(x[12], x[13]); w1.w = cvtpk2(x[14], x[15]);
    *(LAS u32x4*)dst = w0; *(LAS u32x4*)(dst + 16) = w1;
}
__device__ __forceinline__ f32x4 scan_gram(const LAS unsigned char* X, const LAS unsigned char* Y, int li, int g) {
    f32x4 c = {0.f, 0.f, 0.f, 0.f};
    const bf16x8 a0 = *(const LAS bf16x8*)(X + li * 144 + 16 * g), a1 = *(const LAS bf16x8*)(X + li * 144 + 64 + 16 * g);
    const bf16x8 b0 = *(const LAS bf16x8*)(Y + li * 144 + 16 * g), b1 = *(const LAS bf16x8*)(Y + li * 144 + 64 + 16 * g);
    c = __builtin_amdgcn_mfma_f32_16x16x32_bf16(a0, b0, c, 0, 0, 0); c = __builtin_amdgcn_mfma_f32_16x16x32_bf16(a1, b1, c, 0, 0, 0);
    return c;
}

__device__ __forceinline__ void phase_scan_unit(const Args& a, LAS unsigned char* lds, int unit) {
    const int tid = threadIdx.x, lane = tid & 63, wid = __builtin_amdgcn_readfirstlane(tid >> 6), li = lane & 15, g = lane >> 4;
    const int b = unit >> 4, h = (unit >> 1) & 7, dir = unit & 1;
    unsigned char* ws = a.ws;
    const bf16* P = (const bf16*)(ws + WS_P);
    float* Odir = (float*)(ws + (dir ? WS_OB : WS_OF));
    float* CFB = (float*)(ws + WS_CFB);
    LAS unsigned char* W2T = lds + SC_W2T; LAS unsigned char* A2T = lds + SC_A2T; LAS float* PRM = (LAS float*)(lds + SC_PRM);
    __syncthreads();
    {   const float* w2 = a.in[dir ? I_W2B : I_W2F]; const float* a2 = a.in[dir ? I_A2B : I_A2F];
#pragma unroll
        for (int i = 0; i < 8; ++i) { const int idx = tid + 512 * i, j = idx >> 6, n = idx & 63;
            *(LAS unsigned short*)(W2T + n * 144 + j * 2) = (unsigned short)f2bf(w2[j * 512 + h * 64 + n]);
            *(LAS unsigned short*)(A2T + n * 144 + j * 2) = (unsigned short)f2bf(a2[j * 512 + h * 64 + n]); }
        const int segb[5] = {C_R + h * 64, C_K + h * 64, C_V + h * 64, C_LWF + dir * 64, C_LAF + dir * 64};
        for (int i = tid; i < 15 * 64; i += 512) { const int row = i >> 6, col = i & 63; float v;
            if (row < 5) v = a.in[I_MUP][segb[row] + col]; else if (row < 10) v = a.in[I_MUN][segb[row - 5] + col];
            else if (row == 10) v = a.in[dir ? I_W0B : I_W0F][h * 64 + col]; else if (row == 11) v = a.in[dir ? I_A0B : I_A0F][h * 64 + col];
            else if (row == 12) v = a.in[I_KK][h * 64 + col]; else if (row == 13) v = a.in[I_KA][h * 64 + col]; else v = a.in[I_RK][h * 64 + col];
            PRM[i] = v; }
    }
    __syncthreads();
    if (wid >= 4) {
        const int pw = wid - 4;
        LAS unsigned char* PV = lds + SC_PRIV + pw * SC_PP;
        LAS unsigned char* HO = lds + SC_HAND + pw * SC_HP;
        LAS unsigned char* XA0 = PV + PV_XA; LAS unsigned char* XA1 = PV + PV_XA + 2304; LAS float* LOUT = (LAS float*)(PV + PV_LOUT);
        LAS unsigned char* BTm = PV + PV_BT; LAS unsigned char* KDm = PV + PV_KD;
        const LAS float* prm0 = PRM + 16 * g;
        const int cR = C_R + h * 64 + 16 * g, cK = C_K + h * 64 + 16 * g, cV = C_V + h * 64 + 16 * g, cLW = C_LWF + dir * 64 + 16 * g, cLA = C_LAF + dir * 64 + 16 * g;
        Raw6 rw, ra;
        {   const int t0_ = dir ? (SEQ - 1 - (16 * pw + li)) : (16 * pw + li); const bf16* pr0 = P + ((size_t)b * SEQ + t0_) * PN;
            scan_load_seg(rw, pr0, cLW, t0_ > 0, t0_ < SEQ - 1); scan_load_seg(ra, pr0, cLA, t0_ > 0, t0_ < SEQ - 1); }
#pragma unroll 1
        for (int bi = 0; bi < SEQ / 64; ++bi) {
#if SCAN_DBG == 1
            LDS_BARRIER(); LDS_BARRIER(); continue;
#endif
            int li_ = li, g_ = g; asm volatile("" : "+v"(li_), "+v"(g_));
            const int cidx = 4 * bi + pw;
            const int t = dir ? (SEQ - 1 - (16 * cidx + li_)) : (16 * cidx + li_);
            const size_t m = (size_t)b * SEQ + t;
            const bf16* prow = P + m * PN; const bool hp = t > 0, hn = t < SEQ - 1;
            const LAS float* prm = prm0; asm volatile("" : "+v"(prm));
            float logw[16], av[16], G[16];
            {   float xl[16];
                scan_shift16(xl, rw, prm + 3 * 64, prm + 8 * 64);
#pragma unroll
                for (int j = 0; j < 16; ++j) xl[j] = fast_tanh(xl[j]);
                scan_store16_bf(XA0 + li_ * 144 + 32 * g_, xl);
                scan_shift16(xl, ra, prm + 4 * 64, prm + 9 * 64);
                scan_store16_bf(XA1 + li_ * 144 + 32 * g_, xl);
            }
            Raw6 rk;
            scan_load_seg(rk, prow, cK, hp, hn);
            WAVE_LDS_SYNC();
            {
                f32x4 cw[4], ca[4];
                const bf16x8 aw0 = *(const LAS bf16x8*)(XA0 + li_ * 144 + 16 * g_), aw1 = *(const LAS bf16x8*)(XA0 + li_ * 144 + 64 + 16 * g_);
                const bf16x8 aa0 = *(const LAS bf16x8*)(XA1 + li_ * 144 + 16 * g_), aa1 = *(const LAS bf16x8*)(XA1 + li_ * 144 + 64 + 16 * g_);
#pragma unroll
                for (int nt = 0; nt < 4; ++nt) {
                    const LAS unsigned char* bw = W2T + (16 * nt + li_) * 144 + 16 * g_; const LAS unsigned char* ba = A2T + (16 * nt + li_) * 144 + 16 * g_;
                    f32x4 c = {0.f, 0.f, 0.f, 0.f};
                    c = __builtin_amdgcn_mfma_f32_16x16x32_bf16(aw0, *(const LAS bf16x8*)bw, c, 0, 0, 0); c = __builtin_amdgcn_mfma_f32_16x16x32_bf16(aw1, *(const LAS bf16x8*)(bw + 64), c, 0, 0, 0); cw[nt] = c;
                    c = (f32x4){0.f, 0.f, 0.f, 0.f};
                    c = __builtin_amdgcn_mfma_f32_16x16x32_bf16(aa0, *(const LAS bf16x8*)ba, c, 0, 0, 0); c = __builtin_amdgcn_mfma_f32_16x16x32_bf16(aa1, *(const LAS bf16x8*)(ba + 64), c, 0, 0, 0); ca[nt] = c;
                }
                WAVE_LDS_SYNC();
#pragma unroll
                for (int nt = 0; nt < 4; ++nt)
#pragma unroll
                    for (int rg = 0; rg < 4; ++rg) { LOUT[(4 * g_ + rg) * 64 + 16 * nt + li_] = cw[nt][rg]; LOUT[1024 + (4 * g_ + rg) * 64 + 16 * nt + li_] = ca[nt][rg]; }
            }
            WAVE_LDS_SYNC();
#pragma unroll
            for (int q4 = 0; q4 < 4; ++q4) { const f32x4 dl = *(const LAS f32x4*)(LOUT + li_ * 64 + 16 * g_ + 4 * q4), al = *(const LAS f32x4*)(LOUT + 1024 + li_ * 64 + 16 * g_ + 4 * q4);
                const f32x4 w0 = *(const LAS f32x4*)(prm + 10 * 64 + 4 * q4), a0 = *(const LAS f32x4*)(prm + 11 * 64 + 4 * q4);
#pragma unroll
                for (int e = 0; e < 4; ++e) { const int j = 4 * q4 + e; logw[j] = -DECAY_SCALE * fast_sigmoid(w0[e] + dl[e]); av[j] = fast_sigmoid(a0[e] + al[e]); G[j] = row_scan16(logw[j]); } }
            Raw6 rr, rvv;
            scan_load_seg(rr, prow, cR, hp, hn); scan_load_seg(rvv, prow, cV, hp, hn);
            LDS_BARRIER();
            LAS float* GC = (LAS float*)(HO + HO_GC);
            if (li_ == 15) {
#pragma unroll
                for (int q4 = 0; q4 < 4; ++q4) *(LAS f32x4*)(GC + 16 * g_ + 4 * q4) = (f32x4){__expf(G[4 * q4]), __expf(G[4 * q4 + 1]), __expf(G[4 * q4 + 2]), __expf(G[4 * q4 + 3])};
            }
            WAVE_LDS_SYNC();
            float kdv[16];
            {   float ss = 0.f;
#pragma unroll
                for (int q4 = 0; q4 < 4; ++q4) { const f32x4 xk = scan_shift4(rk, q4, prm + 1 * 64, prm + 6 * 64), kkp = *(const LAS f32x4*)(prm + 12 * 64 + 4 * q4); const f32x4 kr = xk * kkp; ss += (kr[0] * kr[0] + kr[1] * kr[1]) + (kr[2] * kr[2] + kr[3] * kr[3]); }
                ss += __shfl_xor(ss, 16); ss += __shfl_xor(ss, 32);
                const float inv = 1.0f / fmaxf(sqrtf(ss), 1e-12f);
#pragma unroll
                for (int q4 = 0; q4 < 4; ++q4) {
                    const f32x4 xk = scan_shift4(rk, q4, prm + 1 * 64, prm + 6 * 64), kkp = *(const LAS f32x4*)(prm + 12 * 64 + 4 * q4), kap4 = *(const LAS f32x4*)(prm + 13 * 64 + 4 * q4), gc4 = *(const LAS f32x4*)(GC + 16 * g_ + 4 * q4);
                    f32x4 okap, obt, okd, okdg;
#pragma unroll
                    for (int e = 0; e < 4; ++e) { const int j = 4 * q4 + e; const float kappa = xk[e] * kkp[e] * inv; const float eG = __expf(G[j]), eGm = __expf(G[j] - logw[j]), enG = __builtin_amdgcn_rcpf(eG);
                        const float kd = xk[e] * (1.0f + (av[j] - 1.0f) * kap4[e]); kdv[j] = kd;
                        okap[e] = kappa * eGm; obt[e] = kappa * av[j] * enG; okd[e] = kd * enG; okdg[e] = kd * enG * gc4[e]; }
                    scan_store4_bf(HO + HO_KAP + li_ * 144 + 32 * g_ + 8 * q4, okap); scan_store4_bf(BTm + li_ * 144 + 32 * g_ + 8 * q4, obt);
                    scan_store4_bf(KDm + li_ * 144 + 32 * g_ + 8 * q4, okd); scan_store4_bf(HO + HO_KDG + li_ * 144 + 32 * g_ + 8 * q4, okdg);
                }
            }
            {   float cb = 0.f;
#pragma unroll
                for (int q4 = 0; q4 < 4; ++q4) { f32x4 xr = scan_shift4(rr, q4, prm + 0 * 64, prm + 5 * 64); const f32x4 rk4 = *(const LAS f32x4*)(prm + 14 * 64 + 4 * q4);
#pragma unroll
                    for (int e = 0; e < 4; ++e) { const int j = 4 * q4 + e; cb += xr[e] * kdv[j] * rk4[e]; xr[e] *= __expf(G[j]); }
                    scan_store4_bf(HO + HO_RT + li_ * 144 + 32 * g_ + 8 * q4, xr); }
                cb += __shfl_xor(cb, 16); cb += __shfl_xor(cb, 32);
                if (g_ == 0) CFB[m * 16 + h * 2 + dir] = cb;
            }
#pragma unroll
            for (int q4 = 0; q4 < 4; ++q4) scan_store4_bf(HO + HO_VV + li_ * 144 + 32 * g_ + 8 * q4, scan_shift4(rvv, q4, prm + 2 * 64, prm + 7 * 64));
            {
                const int cn = (bi + 1 < SEQ / 64) ? cidx + 4 : cidx;
                const int tn = dir ? (SEQ - 1 - (16 * cn + li_)) : (16 * cn + li_); const bf16* prn = P + ((size_t)b * SEQ + tn) * PN;
                scan_load_seg(rw, prn, cLW, tn > 0, tn < SEQ - 1); scan_load_seg(ra, prn, cLA, tn > 0, tn < SEQ - 1); }
            WAVE_LDS_SYNC();
            f32x4 Lc = scan_gram(BTm, HO + HO_KAP, li_, g_), Lr = scan_gram(HO + HO_KAP, BTm, li_, g_), Bmc = scan_gram(KDm, HO + HO_KAP, li_, g_), MAc = scan_gram(BTm, HO + HO_RT, li_, g_), MBc = scan_gram(KDm, HO + HO_RT, li_, g_);
            f32x4 Ic;
#pragma unroll
            for (int rg = 0; rg < 4; ++rg) { const int i = 4 * g_ + rg;
                if (!(i < li_)) { Lc[rg] = 0.f; Bmc[rg] = 0.f; }
                if (!(li_ < i)) Lr[rg] = 0.f;
                if (!(i <= li_)) { MAc[rg] = 0.f; MBc[rg] = 0.f; }
                Ic[rg] = (i == li_) ? 1.0f : 0.f; }
            const f32x4 z4 = {0.f, 0.f, 0.f, 0.f};
            const s16x4 L1c = f4_to_bf4(Lc), L1r = f4_to_bf4(Lr);
            const f32x4 L2cf = mfma16(L1r, L1c, z4), L2rf = mfma16(L1c, L1r, z4);
            const s16x4 L2c = f4_to_bf4(L2cf), L2r = f4_to_bf4(L2rf);
            const f32x4 L4cf = mfma16(L2r, L2c, z4), L4rf = mfma16(L2c, L2r, z4);
            const s16x4 L4c = f4_to_bf4(L4cf), L4r = f4_to_bf4(L4rf);
            const f32x4 L8cf = mfma16(L4r, L4c, z4), L8rf = mfma16(L4c, L4r, z4);
            const s16x4 P1c = f4_to_bf4(Ic - Lc), P2r = f4_to_bf4(Ic + L2rf), P4c = f4_to_bf4(Ic + L4cf), P4r = f4_to_bf4(Ic + L4rf), P8c = f4_to_bf4(Ic + L8cf), P8r = f4_to_bf4(Ic + L8rf);
            const s16x4 T12r = f4_to_bf4(mfma16(P1c, P2r, z4));
            const s16x4 T48c = f4_to_bf4(mfma16(P4r, P8c, z4));
            const s16x4 Tr = f4_to_bf4(mfma16(T48c, T12r, z4));
            const f32x4 N1c = mfma16(Tr, f4_to_bf4(MAc), z4);
            *(LAS s16x4*)(HO + HO_BMT + li_ * 32 + g_ * 8) = f4_to_bf4(Bmc);
            *(LAS s16x4*)(HO + HO_MBT + li_ * 32 + g_ * 8) = f4_to_bf4(MBc);
            *(LAS s16x4*)(HO + HO_N1T + li_ * 32 + g_ * 8) = f4_to_bf4(-N1c);
#pragma unroll
            for (int kt = 0; kt < 4; ++kt) {
                const s16x4 bb = lds_tr4(BTm + (4 * g_ + (li_ >> 2)) * 144 + (16 * kt + 4 * (li_ & 3)) * 2);
                f32x4 d = mfma16(Tr, bb, z4);
                const float gck = -GC[16 * kt + li_];
                d = d * gck;
                *(LAS s16x4*)(HO + HO_TBT + (16 * kt + li_) * 32 + g_ * 8) = f4_to_bf4(d);
            }
            LDS_BARRIER();
        }
    } else {
        const int vt = wid;
        f32x4 St[4];
#pragma unroll
        for (int kt = 0; kt < 4; ++kt) St[kt] = (f32x4){0.f, 0.f, 0.f, 0.f};
#pragma unroll 1
        for (int bi = 0; bi < SEQ / 64; ++bi) {
            LDS_BARRIER();
            LDS_BARRIER();
#if SCAN_DBG == 2
            continue;
#endif
#pragma unroll 1
            for (int cc = 0; cc < 4; ++cc) {
                int li_ = li, g_ = g; asm volatile("" : "+v"(li_), "+v"(g_));
                const LAS unsigned char* HO = lds + SC_HAND + cc * SC_HP;
                const LAS float* GC = (const LAS float*)(HO + HO_GC);
                s16x4 Sb[4];
#pragma unroll
                for (int kt = 0; kt < 4; ++kt) Sb[kt] = f4_to_bf4(St[kt]);
                const s16x4 Vt = lds_tr4(HO + HO_VV + (4 * g_ + (li_ >> 2)) * 144 + (16 * vt + 4 * (li_ & 3)) * 2);
                f32x4 X = {0.f, 0.f, 0.f, 0.f}, O = {0.f, 0.f, 0.f, 0.f};
#pragma unroll
                for (int kt = 0; kt < 4; ++kt) {
                    const s16x4 aK = *(const LAS s16x4*)(HO + HO_KAP + li_ * 144 + (16 * kt + 4 * g_) * 2), aR = *(const LAS s16x4*)(HO + HO_RT + li_ * 144 + (16 * kt + 4 * g_) * 2);
                    X = mfma16(aK, Sb[kt], X); O = mfma16(aR, Sb[kt], O);
                }
                const s16x4 aBm = *(const LAS s16x4*)(HO + HO_BMT + li_ * 32 + g_ * 8), aMB = *(const LAS s16x4*)(HO + HO_MBT + li_ * 32 + g_ * 8), aN1 = *(const LAS s16x4*)(HO + HO_N1T + li_ * 32 + g_ * 8);
                X = mfma16(aBm, Vt, X);
                const s16x4 Xb = f4_to_bf4(X);
                O = mfma16(aMB, Vt, O); O = mfma16(aN1, Xb, O);
#pragma unroll
                for (int kt = 0; kt < 4; ++kt) {
                    const f32x4 gc = *(const LAS f32x4*)(GC + 16 * kt + 4 * g_);
                    f32x4 acc = St[kt] * gc;
                    const s16x4 aTB = *(const LAS s16x4*)(HO + HO_TBT + (16 * kt + li_) * 32 + g_ * 8);
                    const s16x4 aKD = lds_tr4(HO + HO_KDG + (4 * g_ + (li_ >> 2)) * 144 + (16 * kt + 4 * (li_ & 3)) * 2);
                    acc = mfma16(aTB, Xb, acc); acc = mfma16(aKD, Vt, acc);
                    St[kt] = acc;
                }
                const int cidx = 4 * bi + cc;
#pragma unroll
                for (int rg = 0; rg < 4; ++rg) { const int pidx = 16 * cidx + 4 * g_ + rg; const int t = dir ? (SEQ - 1 - pidx) : pidx;
                    Odir[((size_t)b * SEQ + t) * DA + h * 64 + 16 * vt + li_] = O[rg]; }
            }
        }
    }
    __syncthreads();
}

typedef short v4i16_t __attribute__((ext_vector_type(4)));
__device__ __forceinline__ unsigned cvtpk(float lo, float hi) { return cvtpk2(lo, hi); }
__device__ __forceinline__ void na_load_row(const bf16* P, int b, int h, int row, int col, int ch, u32x4& kc, u32x4& vc) {
    const size_t tok = (size_t)b * SEQ + row * 64 + col;
    kc = *(const u32x4*)(P + tok * PN + C_BK + h * 64 + 8 * ch);
    vc = *(const u32x4*)(P + tok * PN + C_BV + h * 64 + 8 * ch);
}
__device__ __forceinline__ void na_write_row(LAS unsigned char* Ks, LAS unsigned char* Vs, int row, int col, int ch, f32x4 g0, f32x4 g1, u32x4 kc, u32x4 vc) {
    const float e0 = bflo(kc.x), e1 = bfhi(kc.x), e2 = bflo(kc.y), e3 = bfhi(kc.y), e4 = bflo(kc.z), e5 = bfhi(kc.z), e6 = bflo(kc.w), e7 = bfhi(kc.w);
    float ss = (e0 * e0 + e1 * e1) + (e2 * e2 + e3 * e3) + (e4 * e4 + e5 * e5) + (e6 * e6 + e7 * e7);
    ss = dpp_sum8(ss);
    const float rk = 1.0f / sqrtf(ss * (1.f / 64.f) + RMS_EPS);
    u32x4 o; o.x = cvtpk(e0 * rk * g0.x, e1 * rk * g0.y); o.y = cvtpk(e2 * rk * g0.z, e3 * rk * g0.w); o.z = cvtpk(e4 * rk * g1.x, e5 * rk * g1.y); o.w = cvtpk(e6 * rk * g1.z, e7 * rk * g1.w);
    const int off = (((row & 7) * 64 + col) << 7) + ((ch ^ (col & 7)) << 4);
    *(LAS u32x4*)(Ks + off) = o;
    *(LAS u32x4*)(Vs + off) = vc;
}
__device__ __forceinline__ void phase_na_unit(const Args& a, LAS unsigned char* lds, int unit) {
    const int tid = threadIdx.x, lane = tid & 63, wid = __builtin_amdgcn_readfirstlane(tid >> 6);
    const int b = unit >> 4, h = (unit >> 1) & 7, rh = unit & 1;
    const int c = wid & 3, dhalf = wid >> 2, g = lane >> 4, li = lane & 15;
    unsigned char* ws = a.ws;
    const bf16* P = (const bf16*)(ws + WS_P);
    bf16* YB = (bf16*)(ws + WS_YB);
    LAS unsigned char* Ks = lds; LAS unsigned char* Vs = lds + 65536; LAS float* RPB = (LAS float*)(lds + 131072);
    const int scol = tid >> 3, sch = tid & 7;
    const f32x4 kg0 = *(const f32x4*)(a.in[I_KG] + 8 * sch), kg1 = *(const f32x4*)(a.in[I_KG] + 8 * sch + 4);
    __syncthreads();
    for (int i = tid; i < 465; i += 512) RPB[i] = a.in[I_RPB][h * 465 + i];
    const int r0 = rh * 16;
    u32x4 kraw, vraw;
    { const int rs0 = min(max(r0 - 4, 0), 24);
#pragma unroll 2
      for (int i = 0; i < 8; ++i) { na_load_row(P, b, h, rs0 + i, scol, sch, kraw, vraw); na_write_row(Ks, Vs, rs0 + i, scol, sch, kg0, kg1, kraw, vraw); } }
    const int q = 16 * c + li;
    const int kc0 = (c == 0) ? 0 : (c == 1) ? 8 : (c == 2) ? 24 : 32;
    const int cs = min(max(q - 8, 0), 48);
    float qg[16];
#pragma unroll
    for (int j = 0; j < 8; ++j) { qg[j] = a.in[I_QG][8 * g + j]; qg[8 + j] = a.in[I_QG][32 + 8 * g + j]; }
    int prev_rs = min(max(r0 - 4, 0), 24);
    const bf16* qbase = P + ((size_t)b * SEQ + q) * PN + C_Q + h * 64 + 8 * g;
    u32x4 q0 = *(const u32x4*)(qbase + (size_t)r0 * 64 * PN), q1 = *(const u32x4*)(qbase + (size_t)r0 * 64 * PN + 32);
    { const int rsn = min(max(r0 + 1 - 4, 0), 24); if (rsn != prev_rs) na_load_row(P, b, h, rsn + 7, scol, sch, kraw, vraw); }
#pragma unroll 1
    for (int r = r0; r < r0 + 16; ++r) {
        const int rs = min(max(r - 4, 0), 24);
        if (rs != prev_rs) { __syncthreads(); na_write_row(Ks, Vs, rs + 7, scol, sch, kg0, kg1, kraw, vraw); prev_rs = rs; }
        __syncthreads();
        const size_t qtok = (size_t)b * SEQ + r * 64 + q;
        bf16x8 qf0, qf1;
        {   float e[16] = {bflo(q0.x), bfhi(q0.x), bflo(q0.y), bfhi(q0.y), bflo(q0.z), bfhi(q0.z), bflo(q0.w), bfhi(q0.w), bflo(q1.x), bfhi(q1.x), bflo(q1.y), bfhi(q1.y), bflo(q1.z), bfhi(q1.z), bflo(q1.w), bfhi(q1.w)};
            float ss = 0.f;
#pragma unroll
            for (int j = 0; j < 16; ++j) ss += e[j] * e[j];
            ss += __shfl_xor(ss, 16); ss += __shfl_xor(ss, 32);
            const float rq = 0.125f / sqrtf(ss * (1.f / 64.f) + RMS_EPS);
#pragma unroll
            for (int j = 0; j < 16; ++j) e[j] *= rq * qg[j];
            u32x4 w0, w1; w0.x = cvtpk(e[0], e[1]); w0.y = cvtpk(e[2], e[3]); w0.z = cvtpk(e[4], e[5]); w0.w = cvtpk(e[6], e[7]); w1.x = cvtpk(e[8], e[9]); w1.y = cvtpk(e[10], e[11]); w1.z = cvtpk(e[12], e[13]); w1.w = cvtpk(e[14], e[15]);
            qf0 = __builtin_bit_cast(bf16x8, w0); qf1 = __builtin_bit_cast(bf16x8, w1);
        }
        if (r + 1 < r0 + 16) {
            q0 = *(const u32x4*)(qbase + (size_t)(r + 1) * 64 * PN); q1 = *(const u32x4*)(qbase + (size_t)(r + 1) * 64 * PN + 32);
            const int rsn = min(max(r + 1 - 4, 0), 24); if (rsn != rs) na_load_row(P, b, h, rsn + 7, scol, sch, kraw, vraw);
        }
        f32x4 st[16];
#pragma unroll
        for (int i = 0; i < 8; ++i) {
            const int sl = (rs + i) & 7;
#pragma unroll
            for (int ch2 = 0; ch2 < 2; ++ch2) {
                const int col = kc0 + 16 * ch2 + li; const LAS unsigned char* kr = Ks + ((sl * 64 + col) << 7);
                const bf16x8 a0 = *(const LAS bf16x8*)(kr + ((g ^ (col & 7)) << 4)), a1 = *(const LAS bf16x8*)(kr + (((g + 4) ^ (col & 7)) << 4));
                f32x4 s = {0.f, 0.f, 0.f, 0.f};
                s = __builtin_amdgcn_mfma_f32_16x16x32_bf16(a0, qf0, s, 0, 0, 0); s = __builtin_amdgcn_mfma_f32_16x16x32_bf16(a1, qf1, s, 0, 0, 0);
                st[2 * i + ch2] = s;
            }
        }
        float mx = -1e30f;
#pragma unroll
        for (int i = 0; i < 8; ++i) {
            const LAS float* rb = RPB + (i + rs - r + 7) * 31;
#pragma unroll
            for (int ch2 = 0; ch2 < 2; ++ch2)
#pragma unroll
                for (int k = 0; k < 4; ++k) {
                    const int kcol = kc0 + 16 * ch2 + 4 * g + k; const bool valid = (kcol >= cs) && (kcol < cs + 16);
                    const int di = min(max(kcol - q + 15, 0), 30);
                    const float v = valid ? st[2 * i + ch2][k] + rb[di] : -1e30f;
                    st[2 * i + ch2][k] = v; mx = fmaxf(mx, v);
                }
        }
        mx = fmaxf(mx, __shfl_xor(mx, 16)); mx = fmaxf(mx, __shfl_xor(mx, 32));
        float sum = 0.f;
#pragma unroll
        for (int t = 0; t < 16; ++t)
#pragma unroll
            for (int k = 0; k < 4; ++k) { const float p = __expf(st[t][k] - mx); st[t][k] = p; sum += p; }
        sum += __shfl_xor(sum, 16); sum += __shfl_xor(sum, 32);
        const float rinv = 1.0f / sum;
        bf16x8 pf[8];
#pragma unroll
        for (int i = 0; i < 8; ++i) { u32x4 pw; pw.x = cvtpk(st[2 * i][0], st[2 * i][1]); pw.y = cvtpk(st[2 * i][2], st[2 * i][3]); pw.z = cvtpk(st[2 * i + 1][0], st[2 * i + 1][1]); pw.w = cvtpk(st[2 * i + 1][2], st[2 * i + 1][3]); pf[i] = __builtin_bit_cast(bf16x8, pw); }
#pragma unroll
        for (int dt = 0; dt < 2; ++dt) {
            const int dtt = 2 * dhalf + dt;
            f32x4 o = {0.f, 0.f, 0.f, 0.f};
#pragma unroll
            for (int i = 0; i < 8; ++i) {
                const int sl = (rs + i) & 7; const int qq = li >> 2, pp = li & 3;
                const int ca = kc0 + 4 * g + qq, cb = ca + 16;
                const LAS unsigned char* pa = Vs + ((sl * 64 + ca) << 7) + (((2 * dtt + (pp >> 1)) ^ (ca & 7)) << 4) + 8 * (pp & 1);
                const LAS unsigned char* pb = Vs + ((sl * 64 + cb) << 7) + (((2 * dtt + (pp >> 1)) ^ (cb & 7)) << 4) + 8 * (pp & 1);
                const v4i16_t va = __builtin_amdgcn_ds_read_tr16_b64_v4i16((LAS v4i16_t*)pa), vb = __builtin_amdgcn_ds_read_tr16_b64_v4i16((LAS v4i16_t*)pb);
                const bf16x8 vf = {va[0], va[1], va[2], va[3], vb[0], vb[1], vb[2], vb[3]};
                o = __builtin_amdgcn_mfma_f32_16x16x32_bf16(vf, pf[i], o, 0, 0, 0);
            }
            u32x2 w; w.x = cvtpk(o[0] * rinv, o[1] * rinv); w.y = cvtpk(o[2] * rinv, o[3] * rinv);
            *(u32x2*)(YB + qtok * DA + h * 64 + 16 * dtt + 4 * g) = w;
        }
    }
    __syncthreads();
}

__device__ __forceinline__ void phase_combine(const Args& a, LAS unsigned char* lds, int G) {
    const int tid = threadIdx.x;
    unsigned char* ws = a.ws;
    const bf16* P = (const bf16*)(ws + WS_P);
    const float* OF = (const float*)(ws + WS_OF); const float* OB = (const float*)(ws + WS_OB); const float* CFB = (const float*)(ws + WS_CFB);
    bf16* YA = (bf16*)(ws + WS_YA);
    LAS unsigned char* G2B = lds;
    LAS float* SIG = (LAS float*)(lds + 131072);
    const float* g2 = a.in[I_G2];
    __syncthreads();
#pragma unroll 4
    for (int i = 0; i < 32; ++i) { const int idx = tid * 4 + 2048 * i; const f32x4 v = *(const f32x4*)(g2 + idx); u32x2 o; o.x = pk2(v.x, v.y); o.y = pk2(v.z, v.w); *(LAS u32x2*)(G2B + idx * 2) = o; }
    const float* mup = a.in[I_MUP]; const float* mun = a.in[I_MUN];
    const int ng = tid & 63, ts = tid >> 6, c0 = 8 * ng, hh = ng >> 3;
    f32x4 lg0 = *(const f32x4*)(a.in[I_LNG] + c0), lg1 = *(const f32x4*)(a.in[I_LNG] + c0 + 4), lb0 = *(const f32x4*)(a.in[I_LNB] + c0), lb1 = *(const f32x4*)(a.in[I_LNB] + c0 + 4);
    f32x4 mpv0 = *(const f32x4*)(mup + C_V + c0), mpv1 = *(const f32x4*)(mup + C_V + c0 + 4), mnv0 = *(const f32x4*)(mun + C_V + c0), mnv1 = *(const f32x4*)(mun + C_V + c0 + 4);
    const int st = tid >> 5, sj = (tid & 31) * 4;
    const f32x4 mpg = *(const f32x4*)(mup + C_LG + sj), mng = *(const f32x4*)(mun + C_LG + sj);
    for (int grp = blockIdx.x; grp < M / 16; grp += G) {
        const int m0 = grp * 16;
        __syncthreads();
        {   const int m = m0 + st, t = m & (SEQ - 1); const bf16* prow = P + (size_t)m * PN + C_LG + sj;
            const u32x2 pc = *(const u32x2*)prow; u32x2 pp = {0u, 0u}, pn = {0u, 0u};
            if (t > 0) pp = *(const u32x2*)(prow - PN); if (t < SEQ - 1) pn = *(const u32x2*)(prow + PN);
            f32x4 xa = shift4(pc, pp, pn, mpg, mng); xa.x = sigmoidf_(xa.x); xa.y = sigmoidf_(xa.y); xa.z = sigmoidf_(xa.z); xa.w = sigmoidf_(xa.w);
            *(LAS f32x4*)(SIG + st * 128 + sj) = xa; }
        __syncthreads();
        float g0[8], g1[8];
#pragma unroll
        for (int k = 0; k < 8; ++k) { g0[k] = 0.f; g1[k] = 0.f; }
#pragma unroll 4
        for (int j = 0; j < 128; ++j) { const u32x4 gv = *(const LAS u32x4*)(G2B + (j * 512 + c0) * 2); const float s0 = SIG[(2 * ts) * 128 + j], s1 = SIG[(2 * ts + 1) * 128 + j];
            const float e[8] = {bflo(gv.x), bfhi(gv.x), bflo(gv.y), bfhi(gv.y), bflo(gv.z), bfhi(gv.z), bflo(gv.w), bfhi(gv.w)};
#pragma unroll
            for (int k = 0; k < 8; ++k) { g0[k] += s0 * e[k]; g1[k] += s1 * e[k]; } }
#pragma unroll
        for (int tk = 0; tk < 2; ++tk) {
            const int m = m0 + 2 * ts + tk, t = m & (SEQ - 1);
            const f32x4 f0 = *(const f32x4*)(OF + (size_t)m * DA + c0), f1 = *(const f32x4*)(OF + (size_t)m * DA + c0 + 4);
            const f32x4 b0 = *(const f32x4*)(OB + (size_t)m * DA + c0), b1 = *(const f32x4*)(OB + (size_t)m * DA + c0 + 4);
            float o[8] = {f0.x + b0.x, f0.y + b0.y, f0.z + b0.z, f0.w + b0.w, f1.x + b1.x, f1.y + b1.y, f1.z + b1.z, f1.w + b1.w};
            float s = 0.f;
#pragma unroll
            for (int k = 0; k < 8; ++k) s += o[k];
            const float mu = dpp_sum8(s) * (1.f / 64.f);
            float vq = 0.f;
#pragma unroll
            for (int k = 0; k < 8; ++k) { o[k] -= mu; vq += o[k] * o[k]; }
            const float rstd = 1.0f / sqrtf(dpp_sum8(vq) * (1.f / 64.f) + GN_EPS);
            const float cfb = CFB[(size_t)m * 16 + hh * 2] + CFB[(size_t)m * 16 + hh * 2 + 1];
            const bf16* prow = P + (size_t)m * PN + C_V + c0;
            const u32x4 pc = *(const u32x4*)prow; u32x4 pp = {0u, 0u, 0u, 0u}, pn = {0u, 0u, 0u, 0u};
            if (t > 0) pp = *(const u32x4*)(prow - PN); if (t < SEQ - 1) pn = *(const u32x4*)(prow + PN);
            const f32x4 xv0 = shift4((u32x2){pc.x, pc.y}, (u32x2){pp.x, pp.y}, (u32x2){pn.x, pn.y}, mpv0, mnv0), xv1 = shift4((u32x2){pc.z, pc.w}, (u32x2){pp.z, pp.w}, (u32x2){pn.z, pn.w}, mpv1, mnv1);
            const float xv[8] = {xv0.x, xv0.y, xv0.z, xv0.w, xv1.x, xv1.y, xv1.z, xv1.w};
            const float lgv[8] = {lg0.x, lg0.y, lg0.z, lg0.w, lg1.x, lg1.y, lg1.z, lg1.w}, lbv[8] = {lb0.x, lb0.y, lb0.z, lb0.w, lb1.x, lb1.y, lb1.z, lb1.w};
            float y[8];
#pragma unroll
            for (int k = 0; k < 8; ++k) y[k] = (o[k] * rstd * lgv[k] + lbv[k] + cfb * xv[k]) * (tk ? g1[k] : g0[k]);
            u32x4 w; w.x = pk2(y[0], y[1]); w.y = pk2(y[2], y[3]); w.z = pk2(y[4], y[5]); w.w = pk2(y[6], y[7]);
            *(u32x4*)(YA + (size_t)m * DA + c0) = w;
        }
    }
    __syncthreads();
}

__device__ __forceinline__ void phase_router(const Args& a, LAS unsigned char* lds, int G, bool dry) {
    const int tid = threadIdx.x, lane = tid & 63, wave = tid >> 6;
    unsigned char* ws = a.ws;
    const float* X1 = a.out; bf16* H2 = (bf16*)(ws + WS_XN);
    int* list = (int*)(ws + WS_LIST); float* gwt = (float*)(ws + WS_GW);
    unsigned* cnt = (unsigned*)(ws + WS_CTL) + CW_CNT;
    LAS float* WRT = (LAS float*)lds;
    LAS int* rowE = (LAS int*)(lds + 131584); LAS float* rowW = (LAS float*)(lds + 133632); LAS int* rowPos = (LAS int*)(lds + 135680);
    LAS int* bcnt = (LAS int*)(lds + 137728); LAS int* bbase = (LAS int*)(lds + 137856);
    const float* wr = a.in[I_WR];
    __syncthreads();
    for (int i = 0; i < 64; ++i) { const int idx = tid + 512 * i; WRT[(idx & 31) * 1028 + (idx >> 5)] = wr[idx]; }
    f32x4 gf[4];
#pragma unroll
    for (int j = 0; j < 4; ++j) gf[j] = *(const f32x4*)(a.in[I_GFFN] + 256 * j + 4 * lane);
    const float brl = a.in[I_BR][(lane >> 1) & 31];
    for (int grp = blockIdx.x; grp < M / 128; grp += G) {
        __syncthreads();
        if (tid < 32) bcnt[tid] = 0;
        __syncthreads();
        for (int rr = 0; rr < 16; ++rr) {
            const int rl = wave * 16 + rr, m = grp * 128 + rl;
            const f32x4* xr = (const f32x4*)(X1 + (size_t)m * DM) + lane;
            f32x4 v[4]; float s = 0.f;
#pragma unroll
            for (int j = 0; j < 4; ++j) { v[j] = xr[64 * j]; s += (v[j].x * v[j].x + v[j].y * v[j].y) + (v[j].z * v[j].z + v[j].w * v[j].w); }
            const float rstd = 1.0f / sqrtf(wave_sum(s) * (1.f / DM) + RMS_EPS);
            u32x2* o8 = (u32x2*)(H2 + (size_t)m * DM) + lane;
#pragma unroll
            for (int j = 0; j < 4; ++j) { v[j] = v[j] * rstd * gf[j]; u32x2 o; o.x = pk2(v[j].x, v[j].y); o.y = pk2(v[j].z, v[j].w); o8[64 * j] = o; }
            float p[32];
#pragma unroll
            for (int e = 0; e < 32; ++e) { float acc = 0.f;
#pragma unroll
                for (int j = 0; j < 4; ++j) { const f32x4 w = *(const LAS f32x4*)(WRT + e * 1028 + 256 * j + 4 * lane); acc += (v[j].x * w.x + v[j].y * w.y) + (v[j].z * w.z + v[j].w * w.w); }
                p[e] = acc; }
            {   const bool h5 = (lane & 32) != 0;
#pragma unroll
                for (int i = 0; i < 16; ++i) { const float send = h5 ? p[i] : p[i + 16], keep = h5 ? p[i + 16] : p[i]; p[i] = keep + __shfl_xor(send, 32); }
                const bool h4 = (lane & 16) != 0;
#pragma unroll
                for (int i = 0; i < 8; ++i) { const float send = h4 ? p[i] : p[i + 8], keep = h4 ? p[i + 8] : p[i]; p[i] = keep + __shfl_xor(send, 16); }
                const bool h3 = (lane & 8) != 0;
#pragma unroll
                for (int i = 0; i < 4; ++i) { const float send = h3 ? p[i] : p[i + 4], keep = h3 ? p[i + 4] : p[i]; p[i] = keep + __shfl_xor(send, 8); }
                const bool h2 = (lane & 4) != 0;
#pragma unroll
                for (int i = 0; i < 2; ++i) { const float send = h2 ? p[i] : p[i + 2], keep = h2 ? p[i + 2] : p[i]; p[i] = keep + __shfl_xor(send, 4); }
                const bool h1 = (lane & 2) != 0;
                { const float send = h1 ? p[0] : p[1], keep = h1 ? p[1] : p[0]; p[0] = keep + __shfl_xor(send, 2); }
                p[0] += __shfl_xor(p[0], 1);
            }
            float val = p[0] + brl;
            int te[4]; float tv[4];
#pragma unroll
            for (int i = 0; i < 4; ++i) { const float mxv = wave_max(val); const unsigned long long mk = __ballot(val == mxv); const int src = mk ? __ffsll((long long)mk) - 1 : 2 * i; te[i] = src >> 1; tv[i] = mxv; if ((lane >> 1) == te[i]) val = -3.0e38f; }
            const float e1 = __expf(tv[1] - tv[0]), e2 = __expf(tv[2] - tv[0]), e3 = __expf(tv[3] - tv[0]); const float den = 1.0f / (1.0f + e1 + e2 + e3);
            if (lane < 4) { const int ee = lane == 0 ? te[0] : lane == 1 ? te[1] : lane == 2 ? te[2] : te[3]; const float wv = (lane == 0 ? 1.0f : lane == 1 ? e1 : lane == 2 ? e2 : e3) * den;
                const int pos = __hip_atomic_fetch_add(bcnt + ee, 1, __ATOMIC_RELAXED, __HIP_MEMORY_SCOPE_WORKGROUP);
                rowE[rl * 4 + lane] = ee; rowW[rl * 4 + lane] = wv; rowPos[rl * 4 + lane] = pos; }
        }
        __syncthreads();
        if (tid < 32) bbase[tid] = dry ? 0 : (int)__hip_atomic_fetch_add(cnt + 64 * tid, (unsigned)bcnt[tid], __ATOMIC_RELAXED, __HIP_MEMORY_SCOPE_AGENT);
        __syncthreads();
        { const int rl = tid >> 2, i = tid & 3, m = grp * 128 + rl; const int e = rowE[tid], pos = bbase[e] + rowPos[tid];
          if (!dry) { list[(size_t)e * LISTCAP + pos] = m * 4 + i; gwt[(size_t)m * 4 + i] = rowW[tid]; } }
    }
    __syncthreads();
}

__device__ __forceinline__ int moe_table(const Args& a, LAS unsigned char* lds) {
    LAS int* tab = (LAS int*)(lds + MISC_OFF) + 16;
    unsigned* cnt = (unsigned*)(a.ws + WS_CTL) + CW_CNT;
    __syncthreads();
    if (threadIdx.x < 32) tab[threadIdx.x] = (int)__hip_atomic_load(cnt + 64 * threadIdx.x, __ATOMIC_RELAXED, __HIP_MEMORY_SCOPE_AGENT);
    __syncthreads();
    if (threadIdx.x == 0) { int s = 0; for (int e = 0; e < NE; ++e) { tab[32 + e] = s; s += (tab[e] + 255) >> 8; } tab[32 + NE] = s; }
    __syncthreads();
    return tab[32 + NE];
}

__device__ __forceinline__ void phase_final(const Args& a, int G, bool dry) {
    const int tid = threadIdx.x, lane = tid & 63, wave = tid >> 6;
    const bf16* YBUF = (const bf16*)(a.ws + WS_YBUF); float* out = a.out;
    const int gw = blockIdx.x * 8 + wave, NGW = G * 8;
    for (int m = gw; m < M; m += NGW) {
        f32x4* xr = (f32x4*)(out + (size_t)m * DM) + lane; f32x4* xw = dry ? (f32x4*)((float*)(a.ws + WS_P) + (size_t)m * DM) + lane : xr;
#pragma unroll
        for (int j = 0; j < 4; ++j) { f32x4 v = xr[64 * j];
#pragma unroll
            for (int s = 0; s < 4; ++s) { const u32x2 y = *((const u32x2*)(YBUF + ((size_t)s * M + m) * DM) + lane + 64 * j); v.x += bflo(y.x); v.y += bfhi(y.x); v.z += bflo(y.y); v.w += bfhi(y.y); }
            xw[64 * j] = v; }
    }
}

constexpr int N_PHASES = 10;
__global__ void __launch_bounds__(512, 2) mk_fwd(Args args) {
    extern __shared__ __attribute__((aligned(16))) unsigned char lds_raw[];
    LAS unsigned char* lds = (LAS unsigned char*)lds_raw;
    const int tid = threadIdx.x; const int G = gridDim.x;
    unsigned char* ws = args.ws;
    volatile LAS unsigned* MISC = (volatile LAS unsigned*)(lds + MISC_OFF);
    for (int u = tid; u < 256; u += 512) MISC[u] = 0u;
    __syncthreads();
    const int lo = args.ph_lo, hi = args.ph_hi;
    XcdBarrier bar; bar.bar = (unsigned*)(ws + WS_CTL) + CW_BAR; bar.x = 0; bar.st = nullptr;
    if (hi - lo > 1) bar = xcd_barrier_post((unsigned*)(ws + WS_CTL) + CW_BAR, MISC + 8);
#ifndef ONLY_PHASE
#define ONLY_PHASE -1
#endif
#define IN(k) ((ONLY_PHASE < 0 || ONLY_PHASE == (k)) && lo <= (k) && (k) < hi)
#define SEAM(k) do { if (IN(k) && IN((k) + 1)) xcd_barrier(bar); } while (0)

    if (IN(0)) { for (int rep = 0; rep < NREP(0); ++rep) phase_prologue(args, lds, G); } SEAM(0);
    if (IN(1)) for (int rep = 0; rep < NREP(1); ++rep) {
        pg8::StaticOrder S; S.init(M, PN, G, (int)blockIdx.x);
        EpiStoreBf16 E{(bf16*)(ws + WS_P), PN};
        pg8::gemm_phase<EpiStoreBf16, pg8::StaticOrder, true, false>(lds, (const bf16*)(ws + WS_XN), (const bf16*)(ws + WS_WIN), 1024, S, E);
    } SEAM(1);
    if (IN(2)) {
        for (int rep = 0; rep < NREP(16); ++rep) if (blockIdx.x < 256) phase_scan_unit(args, lds, (int)blockIdx.x);
        for (int rep = 0; rep < NREP(17); ++rep) if (blockIdx.x < 256) phase_na_unit(args, lds, (int)blockIdx.x);
    } SEAM(2);
    if (IN(3)) { for (int rep = 0; rep < NREP(3); ++rep) phase_combine(args, lds, G); } SEAM(3);
    if (IN(4)) for (int rep = 0; rep < NREP(4); ++rep) {
        pg8::StaticOrder S; S.init(M, DM, G, (int)blockIdx.x);
        { EpiGate<false> E{(bf16*)(ws + WS_MG), (const bf16*)(ws + WS_P), C_GA};
          pg8::gemm_phase<EpiGate<false>, pg8::StaticOrder, true, false>(lds, (const bf16*)(ws + WS_YA), (const bf16*)(ws + WS_WA), 512, S, E); }
        { EpiGate<true> E{(bf16*)(ws + WS_MG), (const bf16*)(ws + WS_P), C_GB};
          pg8::gemm_phase<EpiGate<true>, pg8::StaticOrder, true, false>(lds, (const bf16*)(ws + WS_YB), (const bf16*)(ws + WS_WB), 512, S, E); }
    } SEAM(4);
    if (IN(5)) for (int rep = 0; rep < NREP(5); ++rep) {
        pg8::StaticOrder S; S.init(M, DM, G, (int)blockIdx.x);
        EpiResid E{args.in[I_X], args.out};
        pg8::gemm_phase<EpiResid, pg8::StaticOrder, true, false>(lds, (const bf16*)(ws + WS_MG), (const bf16*)(ws + WS_WO), 1024, S, E);
    } SEAM(5);
    if (IN(6)) { for (int rep = 0; rep < NREP(6); ++rep) phase_router(args, lds, G, rep + 1 < NREP(6)); } SEAM(6);
    if (IN(7)) for (int rep = 0; rep < NREP(7); ++rep) {
        const int NT = moe_table(args, lds);
        MoeOrder S; S.JP = G / 8; S.x = blockIdx.x % 8; S.j = blockIdx.x / 8; S.NT = NT; S.TPX = (NT + 7) / 8; S.NPN = 8; S.tab = (const LAS int*)(lds + MISC_OFF) + 16; S.list = (const int*)(ws + WS_LIST);
        EpiMoe1 E{(bf16*)(ws + WS_P), args.in[I_B1]};
        pg8::gemm_phase<EpiMoe1, MoeOrder, true, true>(lds, (const bf16*)(ws + WS_XN), (const bf16*)(ws + WS_W1), 1024, S, E);
    } SEAM(7);
    if (IN(8)) for (int rep = 0; rep < NREP(8); ++rep) {
        const int NT = moe_table(args, lds);
        MoeOrder S; S.JP = G / 8; S.x = blockIdx.x % 8; S.j = blockIdx.x / 8; S.NT = NT; S.TPX = (NT + 7) / 8; S.NPN = 4; S.tab = (const LAS int*)(lds + MISC_OFF) + 16; S.list = (const int*)(ws + WS_LIST);
        EpiMoe2 E{(bf16*)(ws + WS_YBUF), args.in[I_B2], (const int*)(ws + WS_LIST), (const float*)(ws + WS_GW), (const LAS int*)(lds + MISC_OFF) + 16};
        pg8::gemm_phase<EpiMoe2, MoeOrder, true, false>(lds, (const bf16*)(ws + WS_P), (const bf16*)(ws + WS_W2), 1024, S, E);
    } SEAM(8);
    if (IN(9)) { for (int rep = 0; rep < NREP(9); ++rep) phase_final(args, G, rep + 1 < NREP(9)); }
#undef IN
#undef SEAM
}

extern "C" void kernel_launch(void* const* d_in, const int* in_sizes, int n_in, void* d_out, int out_size, void* d_ws, size_t ws_size, hipStream_t stream) {
    static int grid = 0;
    if (grid == 0) {
        if (n_in != 32 || in_sizes[0] != M * DM || out_size != M * DM || ws_size < WS_END) {
            fprintf(stderr, "kernel_launch: unexpected problem: n_in %d in0 %d out %d ws %zu (need %zu)\n", n_in, n_in > 0 ? in_sizes[0] : -1, out_size, ws_size, (size_t)WS_END); grid = -1; return; }
        int dev = 0, cus = 0;
        if (hipGetDevice(&dev) != hipSuccess || hipDeviceGetAttribute(&cus, hipDeviceAttributeMultiprocessorCount, dev) != hipSuccess) { grid = -1; return; }
        if (hipFuncSetAttribute((const void*)mk_fwd, hipFuncAttributeMaxDynamicSharedMemorySize, LDS_BYTES) != hipSuccess) { fprintf(stderr, "kernel_launch: hipFuncSetAttribute failed\n"); grid = -1; return; }
        (void)hipGetLastError();
        grid = cus;
        if (grid != 256) { fprintf(stderr, "kernel_launch: this kernel needs a 256-CU device (got %d)\n", grid); grid = -1; return; }
    }
    if (grid < 0) return;
    (void)hipMemsetAsync((char*)d_ws + WS_CTL, 0, CTL_ZERO_BYTES, stream);
    Args a{};
    for (int i = 0; i < 32; ++i) a.in[i] = (const float*)d_in[i];
    a.out = (float*)d_out; a.ws = (unsigned char*)d_ws;
#if MK_N_LAUNCHES == 1
    a.ph_lo = 0; a.ph_hi = N_PHASES; a.li = 0;
    hipLaunchKernelGGL(mk_fwd, dim3(grid), dim3(512), LDS_BYTES, stream, a);
#else
    for (int p = 0; p < N_PHASES; ++p) { a.ph_lo = p; a.ph_hi = p + 1; a.li = p; hipLaunchKernelGGL(mk_fwd, dim3(grid), dim3(512), LDS_BYTES, stream, a); }
#endif
}
```

```cpp
#include <hip/hip_runtime.h>
#include <cstdio>
#include <cstdint>

#ifndef MK_N_LAUNCHES
#define MK_N_LAUNCHES 1
#endif

#ifndef DUP_MASK
#define DUP_MASK 0
#endif
#ifndef SCAN_DUP
#define SCAN_DUP 0
#endif
#ifndef SCAN_DBG
#define SCAN_DBG 0
#endif
#ifndef FP8_SELFTEST
#define FP8_SELFTEST 0
#endif
#ifndef STAMP_SEL
#define STAMP_SEL -1
#endif
#ifndef STAGGER_TICKS
#define STAGGER_TICKS 0
#endif
#define NREP(k) (((DUP_MASK >> (k)) & 1) + 1)
#define LAS __attribute__((address_space(3)))
#define GAS __attribute__((address_space(1)))
typedef unsigned short bf16;
typedef short bf16x8 __attribute__((ext_vector_type(8)));
typedef float f32x4 __attribute__((ext_vector_type(4)));
typedef float f32x2 __attribute__((ext_vector_type(2)));
typedef unsigned u32x4 __attribute__((ext_vector_type(4)));
typedef unsigned u32x2 __attribute__((ext_vector_type(2)));
typedef GAS unsigned gu32;

constexpr int BATCH = 16, SEQ = 2048, DM = 1024, M = BATCH * SEQ;
constexpr int DA = 512, HD = 64, NH = 8;
constexpr int IN_COLS = 5504, PN = 5632;
constexpr int C_R = 0, C_K = 512, C_V = 1024, C_LWF = 1536, C_LAF = 1664, C_LG = 1792;
constexpr int C_Q = 1920, C_BK = 2432, C_BV = 2944, C_GA = 3456, C_GB = 4480;
constexpr int NE = 32, DE = 1024, LISTCAP = 32768;
constexpr int NT_MAX = 544;
constexpr float RMS_EPS = 1e-5f, GN_EPS = 64e-5f, DECAY_SCALE = 0.6065306597126334f;

constexpr size_t MiB = 1u << 20;
constexpr size_t WS_CTL = 0, CTL_ZERO_BYTES = 1 * MiB;
constexpr size_t WS_WIN = 1 * MiB;
constexpr size_t WS_WA = 12 * MiB, WS_WB = 13 * MiB, WS_WO = 14 * MiB;
constexpr size_t WS_W1 = 16 * MiB;
constexpr size_t WS_W2 = 144 * MiB;
constexpr size_t WS_XN = 208 * MiB;
constexpr size_t WS_P = 272 * MiB;
constexpr size_t WS_OF = 624 * MiB, WS_OB = 688 * MiB;
constexpr size_t WS_YB = 752 * MiB, WS_YA = 784 * MiB;
constexpr size_t WS_MG = 816 * MiB;
constexpr size_t WS_YBUF = 408 * MiB;
constexpr size_t WS_INV = 892 * MiB;
constexpr size_t WS_CFB = 880 * MiB;
constexpr size_t WS_X1B = 752 * MiB;
constexpr size_t WS_RMS = 882 * MiB + 768 * 1024;
constexpr size_t WS_GW = 882 * MiB;
constexpr size_t WS_LIST = 883 * MiB;
constexpr size_t WS_END = 893 * MiB;
static_assert(WS_P + (size_t)NT_MAX * 256 * DE <= WS_YBUF && WS_YBUF + (size_t)NT_MAX * 256 * DM * 2 <= WS_CFB, "act / y overlay");
static_assert((size_t)NT_MAX * 256 * DE * 2 <= 352 * MiB, "act overlay");
constexpr int CW_BAR = 4096;
constexpr int CW_CNT = 16384;

constexpr int LDS_BYTES = 163840;
constexpr int MISC_OFF = LDS_BYTES - 1024;

__device__ __forceinline__ unsigned f2bf(float f) { unsigned u = __builtin_bit_cast(unsigned, f); return (u + 0x7fffu + ((u >> 16) & 1u)) >> 16; }
__device__ __forceinline__ unsigned pk2(float lo, float hi) { return f2bf(lo) | (f2bf(hi) << 16); }
__device__ __forceinline__ float bflo(unsigned u) { return __builtin_bit_cast(float, u << 16); }
__device__ __forceinline__ float bfhi(unsigned u) { return __builtin_bit_cast(float, u & 0xffff0000u); }
__device__ __forceinline__ float sigmoidf_(float x) { return 1.0f / (1.0f + __expf(-x)); }
__device__ __forceinline__ float fast_sigmoid(float x) { return __builtin_amdgcn_rcpf(1.0f + __expf(-x)); }
__device__ __forceinline__ float clamp448(float x) { return __builtin_amdgcn_fmed3f(x, -448.0f, 448.0f); }
__device__ __forceinline__ unsigned pack4_fp8(float a, float b, float c, float d) { int p = __builtin_amdgcn_cvt_pk_fp8_f32(clamp448(a), clamp448(b), 0, false); p = __builtin_amdgcn_cvt_pk_fp8_f32(clamp448(c), clamp448(d), p, true); return (unsigned)p; }
constexpr float F8S_H = 16.0f, F8S_W = 512.0f, F8S_A = 4.0f, F8S_Y = 32.0f;

__device__ __forceinline__ float fast_tanh(float x) { return 1.0f - 2.0f * __builtin_amdgcn_rcpf(1.0f + __expf(2.0f * x)); }
template <int CTRL> __device__ __forceinline__ float dppf(float x) { return __builtin_bit_cast(float, __builtin_amdgcn_update_dpp(0, __builtin_bit_cast(int, x), CTRL, 0xF, 0xF, true)); }
__device__ __forceinline__ float dpp_sum8(float x) { x += dppf<0xB1>(x); x += dppf<0x4E>(x); x += dppf<0x141>(x); return x; }
__device__ __forceinline__ float dpp_sum16(float x) { x += dppf<0xB1>(x); x += dppf<0x4E>(x); x += dppf<0x141>(x); x += dppf<0x140>(x); return x; }
__device__ __forceinline__ float dpp_max8(float x) { x = fmaxf(x, dppf<0xB1>(x)); x = fmaxf(x, dppf<0x4E>(x)); x = fmaxf(x, dppf<0x141>(x)); return x; }
__device__ __forceinline__ float wave_sum(float v) {
#pragma unroll
    for (int o = 1; o < 64; o <<= 1) v += __shfl_xor(v, o);
    return v;
}
__device__ __forceinline__ float wave_max(float v) {
#pragma unroll
    for (int o = 1; o < 64; o <<= 1) v = fmaxf(v, __shfl_xor(v, o));
    return v;
}
#define LDS_WAIT() asm volatile("s_waitcnt lgkmcnt(0)" ::: "memory")
#define VM_WAIT() asm volatile("s_waitcnt vmcnt(0)" ::: "memory")

namespace pg8 {
constexpr int BM = 256, BK = 64, HALF = 128, HTB = HALF * BK * 2, STAGE_BYTES = 8 * HTB, NXCD = 8, WGM = 8;
template <int SW = 5> __host__ __device__ __forceinline__ int lds_byte(int r, int c) { const int st = (r >> 4) * 2 + (c >> 5), rr = r & 15, cc = c & 31, ob = rr * 64 + cc * 2; return st * 1024 + (ob ^ (((ob >> 9) & 1) << SW)); }
template <int SW = 5> __host__ __device__ __forceinline__ void stage_rc(int b, int& R, int& C) { const int st = b / 1024, sb = b % 1024, swz = sb ^ (((sb >> 9) & 1) << SW); R = (st >> 1) * 16 + swz / 64; C = (st & 1) * 32 + (swz % 64) / 2; }
__host__ __device__ __forceinline__ int perm32(int rho) { const int n = rho >> 4, i = rho & 15; return 8 * (i >> 2) + 4 * n + (i & 3); }

struct Unit { int pm, pn, e, i0; };

struct StaticOrder {
    int nM, nN, nwg, G, c;
    __device__ void init(int M_, int N_, int G_, int c_) { nM = M_ / BM; nN = N_ / BM; nwg = nM * nN; G = G_; c = c_; }
    __device__ bool next(int i, Unit& u) const {
        const long L = (long)i * G + c; if (L >= nwg) return false;
        int wgid = (int)L; { const int q = nwg / NXCD, r = nwg % NXCD, xcd = wgid % NXCD, off = wgid / NXCD; wgid = (xcd < r ? xcd * (q + 1) : r * (q + 1) + (xcd - r) * q) + off; }
        const int nig = WGM * nN, gid = wgid / nig, fm = gid * WGM, gsz = (nM - fm) < WGM ? (nM - fm) : WGM;
        u.pm = fm + ((wgid % nig) % gsz); u.pn = (wgid % nig) / gsz; u.e = 0; u.i0 = 0; return true;
    }
    __device__ __forceinline__ unsigned goff(const Unit&, int) const { return 0u; }
};

__device__ __forceinline__ unsigned cvt_pk_bf16(float lo, float hi) { unsigned r; asm volatile("v_cvt_pk_bf16_f32 %0, %1, %2" : "=v"(r) : "v"(lo), "v"(hi)); return r; }

typedef int i32x8 __attribute__((ext_vector_type(8)));
template <bool FP8> struct Frag;
template <> struct Frag<false> { bf16x8 k0, k1; };
template <> struct Frag<true> { i32x8 v; };
template <bool FP8> __device__ __forceinline__ Frag<FP8> ldfrag(const LAS unsigned char* p, int o0, int o1) {
    Frag<FP8> f;
    if constexpr (FP8) { typedef int i32x4_t __attribute__((ext_vector_type(4))); f.v.lo = *(const LAS i32x4_t*)(p + o0); f.v.hi = *(const LAS i32x4_t*)(p + o1); }
    else { f.k0 = *(const LAS bf16x8*)(p + o0); f.k1 = *(const LAS bf16x8*)(p + o1); }
    return f;
}
template <bool FP8> __device__ __forceinline__ f32x4 mmafrag(const Frag<FP8>& b, const Frag<FP8>& a, f32x4 c) {
    if constexpr (FP8) {
        const int sc = 127;
#if defined(__HIP_DEVICE_COMPILE__)
        asm("v_mfma_scale_f32_16x16x128_f8f6f4 %0, %1, %2, %0, %3, %3 op_sel_hi:[0,0,0]" : "+v"(c) : "v"(b.v), "v"(a.v), "v"(sc));
#else
        (void)sc;
#endif
        return c; }
    else { c = __builtin_amdgcn_mfma_f32_16x16x32_bf16(b.k0, a.k0, c, 0, 0, 0); return __builtin_amdgcn_mfma_f32_16x16x32_bf16(b.k1, a.k1, c, 0, 0, 0); }
}
template <class Epi, class Sched, bool ALIGN_EPI, bool GATHER, bool FP8 = false>
__device__ __forceinline__ void gemm_phase(LAS unsigned char* lds, const void* Aall, const void* Ball, const int Kel, const Sched& S, const Epi& E) {
    const int K = FP8 ? (Kel >> 1) : Kel;
    const int tid = threadIdx.x, wid = __builtin_amdgcn_readfirstlane(tid >> 6), lane = tid & 63, wr = wid >> 2, wc = wid & 3, fr = lane & 15, fq = lane >> 4;
    const int nt = K / BK;
    int Ri[2], Ci[2]; unsigned voffB[2];
    constexpr int SW = FP8 ? 4 : 5;
#pragma unroll
    for (int i = 0; i < 2; ++i) { stage_rc<SW>(tid * 16 + i * 8192, Ri[i], Ci[i]); const int Rb = Epi::PERM ? ((Ri[i] & ~31) + perm32(Ri[i] & 31)) : Ri[i]; voffB[i] = (unsigned)(Rb * K + Ci[i]) * 2u; }
    const size_t kstep = (size_t)(BK * 2);
    const size_t hstep = (size_t)HALF * K * 2;
    const size_t tstep = 2 * hstep;
    const unsigned ldsw = (unsigned)wid * 1024u;
    const int aoff = FP8 ? lds_byte<SW>(wr * 64 + fr, fq * 16) : lds_byte<SW>(wr * 64 + fr, fq * 8), boff = FP8 ? lds_byte<SW>(wc * 32 + fr, fq * 16) : lds_byte<SW>(wc * 32 + fr, fq * 8);
    const int aoff1 = FP8 ? lds_byte<SW>(wr * 64 + fr, fq * 16 + 8) : aoff + 1024, boff1 = FP8 ? lds_byte<SW>(wc * 32 + fr, fq * 16 + 8) : boff + 1024;
#define PG8_SA(b, h) (((b) * 2 + (h)) * HTB)
#define PG8_SB(b, h) ((4 + (b) * 2 + (h)) * HTB)
#define PG8_STAGE(bufoff, gbase, v0, v1) do { \
        __builtin_amdgcn_global_load_lds((const unsigned*)((const char*)(gbase) + (v0)), (LAS unsigned*)(lds + (bufoff) + ldsw), 16, 0, 0); \
        __builtin_amdgcn_global_load_lds((const unsigned*)((const char*)(gbase) + (v1)), (LAS unsigned*)(lds + (bufoff) + ldsw + 8192), 16, 0, 0); } while (0)
#define PG8_STAGE_B(bufoff, gbase) PG8_STAGE(bufoff, gbase, voffB[0], voffB[1])
#define PG8_LDA(dst, b, h) do { _Pragma("unroll") for (int m = 0; m < 4; ++m) dst[m] = ldfrag<FP8>(lds + PG8_SA(b, h) + m * 2048, aoff, aoff1); } while (0)
#define PG8_LDB(dst, b, h) do { _Pragma("unroll") for (int n = 0; n < 2; ++n) dst[n] = ldfrag<FP8>(lds + PG8_SB(b, h) + n * 2048, boff, boff1); } while (0)
#define PG8_MMA(ai, bj, At, Bt) do { __builtin_amdgcn_s_setprio(1); _Pragma("unroll") for (int m = 0; m < 4; ++m) _Pragma("unroll") for (int n = 0; n < 2; ++n) \
        acc[ai][bj][m][n] = mmafrag<FP8>(Bt[n], At[m], acc[ai][bj][m][n]); __builtin_amdgcn_s_setprio(0); } while (0)
#define PG8_WAIT_V(n) asm volatile("s_waitcnt vmcnt(" #n ")" ::: "memory")
#define PG8_WAIT_V_SEL_N(flag, nrel) asm volatile("s_cmp_eq_u32 %0, 0\n\ts_cbranch_scc1 1f\n\ts_waitcnt vmcnt(" #nrel ")\n\ts_branch 2f\n1:\n\ts_waitcnt vmcnt(8)\n2:" :: "s"(flag) : "memory", "scc")
#define PG8_WAIT_V_SEL(flag) do { if constexpr (Epi::NSTORE == 8) PG8_WAIT_V_SEL_N(flag, 16); else if constexpr (Epi::NSTORE == 16) PG8_WAIT_V_SEL_N(flag, 24); else if constexpr (Epi::NSTORE == 32) PG8_WAIT_V_SEL_N(flag, 40); else PG8_WAIT_V(8); } while (0)
#define PG8_WAIT_L(n) asm volatile("s_waitcnt lgkmcnt(" #n ")" ::: "memory")
#define PG8_BAR __builtin_amdgcn_s_barrier()
#define PG8_SCHED __builtin_amdgcn_sched_barrier(0)
    Unit cur, nxt; int ui = 0;
    if (!S.next(0, cur)) return;
    f32x4 acc[2][2][4][2];
#pragma unroll
    for (int a = 0; a < 2; ++a)
#pragma unroll
        for (int b = 0; b < 2; ++b)
#pragma unroll
            for (int m = 0; m < 4; ++m)
#pragma unroll
                for (int n = 0; n < 2; ++n) acc[a][b][m][n] = (f32x4){0.f, 0.f, 0.f, 0.f};
    Frag<FP8> At[4], B0[2], B1[2];
    unsigned vc00, vc01, vc10, vc11, vn00, vn01, vn10, vn11;
    if constexpr (GATHER) {
        vc00 = S.goff(cur, Ri[0]) + (unsigned)Ci[0] * 2u; vc01 = S.goff(cur, Ri[1]) + (unsigned)Ci[1] * 2u;
        vc10 = S.goff(cur, 128 + Ri[0]) + (unsigned)Ci[0] * 2u; vc11 = S.goff(cur, 128 + Ri[1]) + (unsigned)Ci[1] * 2u;
    } else {
        vc00 = (unsigned)(Ri[0] * K + Ci[0]) * 2u; vc01 = (unsigned)(Ri[1] * K + Ci[1]) * 2u; vc10 = vc00 + (unsigned)hstep; vc11 = vc01 + (unsigned)hstep;
    }
    vn00 = vc00; vn01 = vc01; vn10 = vc10; vn11 = vc11;
    const char* cA = GATHER ? (const char*)Aall : (const char*)Aall + (size_t)cur.pm * tstep;
    const char* cB = (const char*)Ball + (size_t)cur.pn * tstep;
    PG8_STAGE_B(PG8_SB(0, 0), cB); PG8_STAGE_B(PG8_SB(0, 1), cB + hstep); PG8_STAGE(PG8_SA(0, 0), cA, vc00, vc01); PG8_STAGE(PG8_SA(0, 1), cA, vc10, vc11);
    if (wr == 1) PG8_BAR;
    PG8_WAIT_V(2); PG8_BAR;
    PG8_STAGE_B(PG8_SB(1, 0), cB + kstep); PG8_STAGE(PG8_SA(1, 0), cA + kstep, vc00, vc01); PG8_STAGE_B(PG8_SB(1, 1), cB + hstep + kstep);
    PG8_WAIT_V(6); PG8_BAR;
    for (;;) {
        const bool has_next = S.next(ui + 1, nxt);
        const char* nA = has_next ? (GATHER ? (const char*)Aall : (const char*)Aall + (size_t)nxt.pm * tstep) : cA;
        const char* nB = has_next ? (const char*)Ball + (size_t)nxt.pn * tstep : cB;
        if constexpr (GATHER) {
            if (has_next) {
                vn00 = S.goff(nxt, Ri[0]) + (unsigned)Ci[0] * 2u; vn01 = S.goff(nxt, Ri[1]) + (unsigned)Ci[1] * 2u;
                vn10 = S.goff(nxt, 128 + Ri[0]) + (unsigned)Ci[0] * 2u; vn11 = S.goff(nxt, 128 + Ri[1]) + (unsigned)Ci[1] * 2u;
            }
        }
#pragma unroll 1
        for (int t = 0; t < nt; t += 2) {
            const bool last = (t == nt - 2);
            const char* a1 = cA + (size_t)(t + 1) * kstep;
            const char* a2 = last ? nA : cA + (size_t)(t + 2) * kstep; const char* b2 = last ? nB : cB + (size_t)(t + 2) * kstep;
            const char* a3 = a2 + kstep; const char* b3 = b2 + kstep;
            const unsigned s00 = last ? vn00 : vc00, s01 = last ? vn01 : vc01, s10 = last ? vn10 : vc10, s11 = last ? vn11 : vc11;
            const int relax = __builtin_amdgcn_readfirstlane(((t == 0) && (ui > 0)) ? 1 : 0);
            PG8_LDB(B0, 0, 0); PG8_LDB(B1, 0, 1); PG8_SCHED; PG8_LDA(At, 0, 0); PG8_STAGE(PG8_SA(1, 1), a1, vc10, vc11);
            PG8_WAIT_V_SEL(relax); PG8_WAIT_L(0); PG8_BAR; PG8_MMA(0, 0, At, B0); PG8_MMA(0, 1, At, B1); PG8_BAR; PG8_SCHED;
            PG8_LDA(At, 0, 1); PG8_STAGE_B(PG8_SB(0, 0), b2); PG8_STAGE_B(PG8_SB(0, 1), b2 + hstep); PG8_STAGE(PG8_SA(0, 0), a2, s00, s01);
            PG8_WAIT_V_SEL(relax); PG8_WAIT_L(0); PG8_BAR; PG8_MMA(1, 0, At, B0); PG8_MMA(1, 1, At, B1); PG8_BAR; PG8_SCHED;
            PG8_LDB(B0, 1, 0); PG8_LDB(B1, 1, 1); PG8_SCHED; PG8_LDA(At, 1, 0); PG8_STAGE(PG8_SA(0, 1), a2, s10, s11);
            PG8_WAIT_V(8); PG8_WAIT_L(0); PG8_BAR; PG8_MMA(0, 0, At, B0); PG8_MMA(0, 1, At, B1); PG8_BAR; PG8_SCHED;
            PG8_LDA(At, 1, 1); PG8_STAGE_B(PG8_SB(1, 0), b3); PG8_STAGE_B(PG8_SB(1, 1), b3 + hstep); PG8_STAGE(PG8_SA(1, 0), a3, s00, s01);
            PG8_WAIT_V(8); PG8_WAIT_L(0); PG8_BAR; PG8_MMA(1, 0, At, B0); PG8_MMA(1, 1, At, B1); PG8_BAR; PG8_SCHED;
        }
        if constexpr (ALIGN_EPI) { if (wr == 0) PG8_BAR; }
        if constexpr (FP8) asm volatile("s_nop 7\n\ts_nop 7" ::: "memory");
        E(acc, cur, wr, wc, fr, fq);
#if (DUP_MASK >> 20) & 1
        if constexpr (Epi::IDEMP) { asm volatile("" ::: "memory"); E(acc, cur, wr, wc, fr, fq); }
#endif
#if (DUP_MASK >> 21) & 1
        if constexpr (Epi::ISP1) { asm volatile("" ::: "memory"); E(acc, cur, wr, wc, fr, fq); }
#endif
        if (!has_next) break;
#pragma unroll
        for (int a = 0; a < 2; ++a)
#pragma unroll
            for (int b = 0; b < 2; ++b)
#pragma unroll
                for (int m = 0; m < 4; ++m)
#pragma unroll
                    for (int n = 0; n < 2; ++n) acc[a][b][m][n] = (f32x4){0.f, 0.f, 0.f, 0.f};
        cur = nxt; cA = nA; cB = nB; ++ui;
        vc00 = vn00; vc01 = vn01; vc10 = vn10; vc11 = vn11;
        if constexpr (ALIGN_EPI) { if (wr == 1) PG8_BAR; }
    }
    PG8_WAIT_V(0);
    if constexpr (!ALIGN_EPI) { if (wr == 0) PG8_BAR; }
    PG8_BAR;
#undef PG8_SA
#undef PG8_SB
#undef PG8_STAGE
#undef PG8_STAGE_B
#undef PG8_LDA
#undef PG8_LDB
#undef PG8_MMA
#undef PG8_WAIT_V
#undef PG8_WAIT_V_SEL
#undef PG8_WAIT_V_SEL_N
#undef PG8_WAIT_L
#undef PG8_BAR
#undef PG8_SCHED
}
}

__device__ __forceinline__ void phase_stagger(int dticks) {
    const int s = ((int)blockIdx.x >> 3) & 7;
    if (s && dticks > 0) { const unsigned long long t0 = __builtin_amdgcn_s_memrealtime(); const unsigned long long want = (unsigned long long)(s * dticks);
        while (__builtin_amdgcn_s_memrealtime() - t0 < want) __builtin_amdgcn_s_sleep(16); }
}
struct EpiStoreBf16 {
    static constexpr bool PERM = true, IDEMP = true, ISP1 = true;
    static constexpr int NSTORE = 16;
    bf16* O; int ldc; int sig_from;
    __device__ __forceinline__ void operator()(const f32x4 (&acc)[2][2][4][2], const pg8::Unit& u, int wr, int wc, int fr, int fq) const {
        const int row0 = u.pm * 256 + wr * 64 + fr, col0 = u.pn * 256 + wc * 32 + 8 * fq;
#pragma unroll
        for (int ai = 0; ai < 2; ++ai)
#pragma unroll
            for (int m = 0; m < 4; ++m) { bf16* rowp = O + (size_t)(row0 + ai * 128 + m * 16) * ldc + col0;
#pragma unroll
                for (int bj = 0; bj < 2; ++bj) { const f32x4 v0 = acc[ai][bj][m][0], v1 = acc[ai][bj][m][1];
                    if (sig_from >= 0 && u.pn * 256 + bj * 128 >= sig_from) {
                        unsigned q[8];
                        {   f32x4 kone = {1.0f, 1.0f, 1.0f, 1.0f}, k255 = {255.0f, 255.0f, 255.0f, 255.0f}, khalf = {0.5f, 0.5f, 0.5f, 0.5f}; asm volatile("" : "+v"(kone), "+v"(k255), "+v"(khalf));
                            const f32x4 t0 = v0 * -1.4426950408889634f, t1 = v1 * -1.4426950408889634f; f32x4 e0, e1;
#pragma unroll
                            for (int k = 0; k < 4; ++k) { e0[k] = __builtin_amdgcn_exp2f(t0[k]); e1[k] = __builtin_amdgcn_exp2f(t1[k]); }
                            const f32x4 d0 = e0 + kone, d1 = e1 + kone; f32x4 r0, r1;
#pragma unroll
                            for (int k = 0; k < 4; ++k) { r0[k] = __builtin_amdgcn_rcpf(d0[k]); r1[k] = __builtin_amdgcn_rcpf(d1[k]); }
                            const f32x4 s0 = __builtin_elementwise_fma(r0, k255, khalf), s1 = __builtin_elementwise_fma(r1, k255, khalf);
#pragma unroll
                            for (int k = 0; k < 4; ++k) { q[k] = (unsigned)s0[k]; q[4 + k] = (unsigned)s1[k]; } }
                        u32x2 w; w.x = q[0] | (q[1] << 8) | (q[2] << 16) | (q[3] << 24); w.y = q[4] | (q[5] << 8) | (q[6] << 16) | (q[7] << 24);
                        *(u32x2*)((unsigned char*)(rowp - col0) + 2 * sig_from + (col0 + bj * 128 - sig_from)) = w;
                    } else { u32x4 w;
                        w.x = pg8::cvt_pk_bf16(v0[0], v0[1]); w.y = pg8::cvt_pk_bf16(v0[2], v0[3]); w.z = pg8::cvt_pk_bf16(v1[0], v1[1]); w.w = pg8::cvt_pk_bf16(v1[2], v1[3]);
                        *(u32x4*)(rowp + bj * 128) = w; } } }
    }
};
template <bool ADD> struct EpiGate {
    static constexpr bool PERM = true, IDEMP = !ADD, ISP1 = false;
    static constexpr int NSTORE = 16;
    bf16* MG; const bf16* P; int gcol0;
    __device__ __forceinline__ void operator()(const f32x4 (&acc)[2][2][4][2], const pg8::Unit& u, int wr, int wc, int fr, int fq) const {
        const int row0 = u.pm * 256 + wr * 64 + fr, col0 = u.pn * 256 + wc * 32 + 8 * fq;
#pragma unroll
        for (int ai = 0; ai < 2; ++ai)
#pragma unroll
            for (int m = 0; m < 4; ++m) { const size_t row = (size_t)(row0 + ai * 128 + m * 16);
#pragma unroll
                for (int bj = 0; bj < 2; ++bj) { const int col = col0 + bj * 128;
                    const u32x2 g = *(const u32x2*)((const unsigned char*)(P + row * PN) + 2 * C_GA + (gcol0 - C_GA) + col);
                    float o[8]; const f32x4 v0 = acc[ai][bj][m][0], v1 = acc[ai][bj][m][1];
                    constexpr float Q = 1.0f / 255.0f;
                    {   const f32x4 b0 = {(float)(g.x & 0xffu), (float)((g.x >> 8) & 0xffu), (float)((g.x >> 16) & 0xffu), (float)(g.x >> 24)}, b1 = {(float)(g.y & 0xffu), (float)((g.y >> 8) & 0xffu), (float)((g.y >> 16) & 0xffu), (float)(g.y >> 24)};
                        const f32x4 p0 = (v0 * Q) * b0, p1 = (v1 * Q) * b1;
                        o[0] = p0[0]; o[1] = p0[1]; o[2] = p0[2]; o[3] = p0[3]; o[4] = p1[0]; o[5] = p1[1]; o[6] = p1[2]; o[7] = p1[3]; }
                    bf16* dst = MG + row * DM + col;
                    if (ADD) { const u32x4 p = *(const u32x4*)dst;
                        o[0] += bflo(p.x); o[1] += bfhi(p.x); o[2] += bflo(p.y); o[3] += bfhi(p.y); o[4] += bflo(p.z); o[5] += bfhi(p.z); o[6] += bflo(p.w); o[7] += bfhi(p.w); }
                    u32x4 w; w.x = pg8::cvt_pk_bf16(o[0], o[1]); w.y = pg8::cvt_pk_bf16(o[2], o[3]); w.z = pg8::cvt_pk_bf16(o[4], o[5]); w.w = pg8::cvt_pk_bf16(o[6], o[7]);
                    *(u32x4*)dst = w; } }
    }
};
struct EpiResid {
    static constexpr bool PERM = true, IDEMP = true, ISP1 = false;
    static constexpr int NSTORE = 16;
    const bf16* XN; const float* RMS; const float* GM; bf16* O;
    __device__ __forceinline__ void operator()(const f32x4 (&acc)[2][2][4][2], const pg8::Unit& u, int wr, int wc, int fr, int fq) const {
        const int row0 = u.pm * 256 + wr * 64 + fr, col0 = u.pn * 256 + wc * 32 + 8 * fq;
        f32x4 gi[2][2];
#pragma unroll
        for (int bj = 0; bj < 2; ++bj)
#pragma unroll
            for (int n = 0; n < 2; ++n) { const f32x4 gv = *(const f32x4*)(GM + col0 + bj * 128 + 4 * n); gi[bj][n] = (f32x4){1.0f / gv[0], 1.0f / gv[1], 1.0f / gv[2], 1.0f / gv[3]}; }
#pragma unroll
        for (int ai = 0; ai < 2; ++ai)
#pragma unroll
            for (int m = 0; m < 4; ++m) { const int row = row0 + ai * 128 + m * 16; const size_t off = (size_t)row * DM + col0; const float rms = RMS[row];
#pragma unroll
                for (int bj = 0; bj < 2; ++bj) { const u32x4 xb = *(const u32x4*)(XN + off + bj * 128);
                    const f32x4 x0 = {bflo(xb.x), bfhi(xb.x), bflo(xb.y), bfhi(xb.y)}, x1 = {bflo(xb.z), bfhi(xb.z), bflo(xb.w), bfhi(xb.w)};
                    const f32x4 v0 = x0 * rms * gi[bj][0] + acc[ai][bj][m][0], v1 = x1 * rms * gi[bj][1] + acc[ai][bj][m][1]; u32x4 w;
                    w.x = pg8::cvt_pk_bf16(v0[0], v0[1]); w.y = pg8::cvt_pk_bf16(v0[2], v0[3]); w.z = pg8::cvt_pk_bf16(v1[0], v1[1]); w.w = pg8::cvt_pk_bf16(v1[2], v1[3]);
                    *(u32x4*)(O + off + bj * 128) = w; } }
    }
};
struct EpiMoe1 {
    static constexpr bool PERM = true, IDEMP = true, ISP1 = false;
    static constexpr int NSTORE = 8;
    unsigned char* ACT; const float* b1;
    __device__ __forceinline__ void operator()(const f32x4 (&acc)[2][2][4][2], const pg8::Unit& u, int wr, int wc, int fr, int fq) const {
        const int pnl = u.pn & 7; const int row0 = u.pm * 256 + wr * 64 + fr, j0 = pnl * 128 + wc * 32 + 8 * fq;
        const float* bg = b1 + (size_t)u.e * 2048 + j0; const float* bl = bg + 1024;
        const f32x4 bg0 = *(const f32x4*)bg, bg1 = *(const f32x4*)(bg + 4), bl0 = *(const f32x4*)bl, bl1 = *(const f32x4*)(bl + 4);
        constexpr float dq = 1.0f / (F8S_H * F8S_W);
        f32x4 dqv = {dq, dq, dq, dq}, one4 = {1.0f, 1.0f, 1.0f, 1.0f}; asm volatile("" : "+v"(dqv), "+v"(one4));
#pragma unroll
        for (int ai = 0; ai < 2; ++ai)
#pragma unroll
            for (int m = 0; m < 4; ++m) { unsigned char* dst = ACT + (size_t)(row0 + ai * 128 + m * 16) * DE + j0; u32x2 w;
#pragma unroll
                for (int n = 0; n < 2; ++n) {
                    const f32x4 gv = __builtin_elementwise_fma(acc[ai][0][m][n], dqv, (n ? bg1 : bg0)), lv = __builtin_elementwise_fma(acc[ai][1][m][n], dqv, (n ? bl1 : bl0));
                    f32x4 g, l;
#pragma unroll
                    for (int k = 0; k < 4; ++k) { g[k] = fminf(gv[k], 7.0f); l[k] = __builtin_amdgcn_fmed3f(lv[k], -7.0f, 7.0f); }
                    const f32x4 t = g * (-1.702f * 1.4426950408889634f);
                    f32x4 e;
#pragma unroll
                    for (int k = 0; k < 4; ++k) e[k] = __builtin_amdgcn_exp2f(t[k]);
                    const f32x4 d = e + one4;
                    f32x4 r;
#pragma unroll
                    for (int k = 0; k < 4; ++k) r[k] = __builtin_amdgcn_rcpf(d[k]);
                    const f32x4 o = (g * r) * (l * F8S_A + F8S_A);
                    int p = __builtin_amdgcn_cvt_pk_fp8_f32(o[0], o[1], 0, false); p = __builtin_amdgcn_cvt_pk_fp8_f32(o[2], o[3], p, true);
                    if (n) w.y = (unsigned)p; else w.x = (unsigned)p; }
                *(u32x2*)dst = w; }
    }
};
struct EpiMoe2 {
    static constexpr bool PERM = true, IDEMP = true, ISP1 = false;
    static constexpr int NSTORE = 16;
    unsigned char* Y; const float* b2;
    __device__ __forceinline__ void operator()(const f32x4 (&acc)[2][2][4][2], const pg8::Unit& u, int wr, int wc, int fr, int fq) const {
        const int pnl = u.pn & 3; const int row0 = u.pm * 256 + wr * 64 + fr, col0 = pnl * 256 + wc * 32 + 8 * fq;
        f32x4 bv[2][2];
#pragma unroll
        for (int bj = 0; bj < 2; ++bj)
#pragma unroll
            for (int n = 0; n < 2; ++n) bv[bj][n] = *(const f32x4*)(b2 + (size_t)u.e * 1024 + col0 + bj * 128 + 4 * n) * F8S_Y;
        constexpr float dq = 1.0f / (F8S_A * F8S_W);
#pragma unroll
        for (int ai = 0; ai < 2; ++ai)
#pragma unroll
            for (int m = 0; m < 4; ++m) { unsigned char* rowp = Y + (size_t)(row0 + ai * 128 + m * 16) * DM + col0;
#pragma unroll
                for (int bj = 0; bj < 2; ++bj) { const f32x4 v0 = acc[ai][bj][m][0] * (dq * F8S_Y) + bv[bj][0], v1 = acc[ai][bj][m][1] * (dq * F8S_Y) + bv[bj][1]; u32x2 w;
                    w.x = pack4_fp8(v0[0], v0[1], v0[2], v0[3]); w.y = pack4_fp8(v1[0], v1[1], v1[2], v1[3]);
                    *(u32x2*)(rowp + bj * 128) = w; } }
    }
};
struct MoeOrder {
    int JP, x, j, TPX, NT, NPN; const LAS int* tab; const int2* list;
    __device__ bool next(int i, pg8::Unit& u) const {
        const int q = i * JP + j; const int lt = q / NPN, pn = q % NPN; if (lt >= TPX) return false; const int gt = x * TPX + lt; if (gt >= NT) return false;
        int e = 0;
        for (int k = 1; k < NE; ++k) e += (tab[32 + k] <= gt) ? 1 : 0;
        e = __builtin_amdgcn_readfirstlane(e); const int ts = __builtin_amdgcn_readfirstlane(tab[32 + e]);
        u.pm = gt; u.pn = e * NPN + pn; u.e = e; u.i0 = (gt - ts) * 256; return true;
    }
    __device__ __forceinline__ unsigned goff(const pg8::Unit& u, int r) const {
        const int idx = u.i0 + r; int tok = 0; if (idx < tab[u.e]) tok = list[(size_t)u.e * LISTCAP + idx].x >> 2; return (unsigned)tok * (unsigned)DM;
    }
};

#define XB_TMO      128
#define XB_XCNT(j)  (256  + 64 * (j))
#define XB_XSUB(j)  (1280 + 64 * (j))
#define XB_XGEN(j)  (2304 + 64 * (j))
#define XB_TOP      3328
#define XB_TOPGEN   3392
#define XCD_BAR_WORDS 3456
#define XB_SPIN_CAP (1u << 20)
__device__ __forceinline__ unsigned xb_ld(unsigned* p)              { return __hip_atomic_load(p, __ATOMIC_RELAXED, __HIP_MEMORY_SCOPE_AGENT); }
__device__ __forceinline__ unsigned xb_add(unsigned* p, unsigned v) { return __hip_atomic_fetch_add(p, v, __ATOMIC_RELAXED, __HIP_MEMORY_SCOPE_AGENT); }
__device__ __forceinline__ unsigned xb_xcc_id() { return (unsigned)__builtin_amdgcn_s_getreg((3 << 11) | 20) & 0xFu; }
#define XB_SPIN(cond, bar) do { unsigned _sp = 0; while (cond) { __builtin_amdgcn_s_sleep(1); \
    if ((++_sp & 255u) == 0u) { if (xb_ld(&(bar)[XB_TMO])) break; if (_sp > XB_SPIN_CAP) { atomicAdd(&(bar)[XB_TMO], 1u); break; } } } } while (0)
struct XcdBarrier { unsigned* bar; unsigned x; volatile LAS unsigned* st; };
__device__ __forceinline__ XcdBarrier xcd_barrier_post(unsigned* bar, volatile LAS unsigned* st) {
    XcdBarrier b; b.bar = bar; b.x = xb_xcc_id(); b.st = st;
    if (threadIdx.x == 0) (void)xb_add(&bar[XB_XCNT(b.x)], 1u);
    return b;
}
__device__ __forceinline__ void xcd_barrier_complete(unsigned* bar, unsigned x, unsigned& nloc, unsigned& nx) {
    const unsigned G = gridDim.x * gridDim.y * gridDim.z;
    unsigned sum, cnt, mine, sp = 0u;
    for (;;) {
        sum = 0u; cnt = 0u; mine = 0u;
#pragma unroll
        for (unsigned j = 0; j < 16; ++j) { const unsigned c = xb_ld(&bar[XB_XCNT(j)]); sum += c; cnt += (c > 0u) ? 1u : 0u; mine = (j == x) ? c : mine; }
        if (sum == G) break;
        __builtin_amdgcn_s_sleep(1);
        if ((++sp & 255u) == 0u) { if (xb_ld(&bar[XB_TMO])) break; if (sp > XB_SPIN_CAP) { atomicAdd(&bar[XB_TMO], 1u); break; } }
    }
    nloc = mine > 0u ? mine : 1u; nx = cnt > 0u ? cnt : 1u;
}
__device__ __forceinline__ void xcd_barrier(const XcdBarrier& b) {
    asm volatile("s_waitcnt vmcnt(0)" ::: "memory");
    __syncthreads();
    if (threadIdx.x == 0) {
        unsigned* bar = b.bar;
        __builtin_amdgcn_s_waitcnt(0);
        unsigned nloc = b.st[0], nx = b.st[1];
        if (nloc == 0u) { xcd_barrier_complete(bar, b.x, nloc, nx); b.st[0] = nloc; b.st[1] = nx; }
        const unsigned old = xb_add(&bar[XB_XSUB(b.x)], 1u);
        const unsigned gen = old / nloc;
        if (old + 1u == (gen + 1u) * nloc) {
            __builtin_amdgcn_fence(__ATOMIC_RELEASE, "agent");
            asm volatile("s_waitcnt vmcnt(0)" ::: "memory");
            const unsigned og = xb_add(&bar[XB_TOP], 1u);
            const unsigned tg = og / nx;
            if (og + 1u == (tg + 1u) * nx) xb_add(&bar[XB_TOPGEN], 1u);
            else XB_SPIN(xb_ld(&bar[XB_TOPGEN]) == tg, bar);
            __builtin_amdgcn_fence(__ATOMIC_ACQUIRE, "agent");
            asm volatile("s_waitcnt vmcnt(0)" ::: "memory");
        } else {
            XB_SPIN(xb_ld(&bar[XB_TOPGEN]) == gen, bar);
            __builtin_amdgcn_fence(__ATOMIC_ACQUIRE, "agent");
            asm volatile("s_waitcnt vmcnt(0)" ::: "memory");
        }
    }
    __syncthreads();
}

struct Args { const float* in[32]; float* out; unsigned char* ws; int ph_lo, ph_hi, li, pad; };
enum { I_X = 0, I_GMIX, I_WIN, I_MUP, I_MUN, I_W0F, I_W2F, I_W0B, I_W2B, I_A0F, I_A2F, I_A0B, I_A2B, I_G2, I_KK, I_KA, I_RK, I_LNG, I_LNB, I_QG, I_KG, I_RPB,
       I_WA, I_WB, I_WO, I_GFFN, I_WR, I_BR, I_W1, I_B1, I_W2, I_B2 };

__device__ __forceinline__ void p0_transpose_item(const float* W, int K, int N, bf16* WT, int k0, int n0, int drow0, LAS float* scr, int lane) {
#pragma unroll 8
    for (int i = 0; i < 32; ++i) { const int kk = 2 * i + (lane >> 5); scr[kk * 33 + (lane & 31)] = W[(size_t)(k0 + kk) * N + n0 + (lane & 31)]; }
    LDS_WAIT(); asm volatile("" ::: "memory");
    const int c = lane & 7;
#pragma unroll
    for (int j = 0; j < 4; ++j) { const int n = (lane >> 3) + 8 * j; const LAS float* s = scr + (8 * c) * 33 + n;
        u32x4 o; o.x = pk2(s[0 * 33], s[1 * 33]); o.y = pk2(s[2 * 33], s[3 * 33]); o.z = pk2(s[4 * 33], s[5 * 33]); o.w = pk2(s[6 * 33], s[7 * 33]);
        *(GAS u32x4*)(WT + (size_t)(drow0 + n) * K + k0 + 8 * c) = o; }
    LDS_WAIT(); asm volatile("" ::: "memory");
}
__device__ __forceinline__ void phase_prologue(const Args& a, LAS unsigned char* lds, int G) {
    const int tid = threadIdx.x, lane = tid & 63, wave = tid >> 6;
    unsigned char* ws = a.ws;
    LAS float* scr = (LAS float*)(lds + wave * 16384);
    const int gw = blockIdx.x * 8 + wave, NGW = G * 8;
    constexpr int I_IN = 16 * 172, I_AB = 8 * 32, I_O = 16 * 32, I_1 = 32 * 16 * 64, I_2 = 32 * 16 * 32;
    constexpr int NITEMS = I_IN + 2 * I_AB + I_O;
    const float* x = a.in[I_X]; const float* gmix = a.in[I_GMIX]; bf16* XN = (bf16*)(ws + WS_XN);
    f32x4 gm[4];
#pragma unroll
    for (int j = 0; j < 4; ++j) gm[j] = *(const f32x4*)(gmix + 256 * j + 4 * lane);
    for (int m = gw; m < M; m += NGW) {
        const GAS f32x4* xr = (const GAS f32x4*)(x + (size_t)m * DM) + lane;
        f32x4 v[4]; float s = 0.f;
#pragma unroll
        for (int j = 0; j < 4; ++j) { v[j] = xr[64 * j]; s += (v[j].x * v[j].x + v[j].y * v[j].y) + (v[j].z * v[j].z + v[j].w * v[j].w); }
        const float rms = sqrtf(wave_sum(s) * (1.f / DM) + RMS_EPS); const float rstd = 1.0f / rms;
        if (lane == 0) ((float*)(ws + WS_RMS))[m] = rms;
        GAS u32x2* o8 = (GAS u32x2*)(XN + (size_t)m * DM) + lane;
#pragma unroll
        for (int j = 0; j < 4; ++j) { u32x2 o; o.x = pk2(v[j].x * rstd * gm[j].x, v[j].y * rstd * gm[j].y); o.y = pk2(v[j].z * rstd * gm[j].z, v[j].w * rstd * gm[j].w); o8[64 * j] = o; }
    }
    for (int it = gw; it < NITEMS; it += NGW) {
        int r = it;
        if (r < I_IN) { const int kb = r / 172, nb = r % 172; p0_transpose_item(a.in[I_WIN], 1024, IN_COLS, (bf16*)(ws + WS_WIN), 64 * kb, 32 * nb, 32 * nb, scr, lane); continue; } r -= I_IN;
        if (r < I_AB) { const int kb = r / 32, nb = r % 32; p0_transpose_item(a.in[I_WA], 512, 1024, (bf16*)(ws + WS_WA), 64 * kb, 32 * nb, 32 * nb, scr, lane); continue; } r -= I_AB;
        if (r < I_AB) { const int kb = r / 32, nb = r % 32; p0_transpose_item(a.in[I_WB], 512, 1024, (bf16*)(ws + WS_WB), 64 * kb, 32 * nb, 32 * nb, scr, lane); continue; } r -= I_AB;
        { const int kb = r / 32, nb = r % 32; p0_transpose_item(a.in[I_WO], 1024, 1024, (bf16*)(ws + WS_WO), 64 * kb, 32 * nb, 32 * nb, scr, lane); }
    }
    { GAS u32x4* z = (GAS u32x4*)((bf16*)(ws + WS_WIN) + (size_t)IN_COLS * 1024);
      for (int i = blockIdx.x * 512 + tid; i < 16384; i += G * 512) z[i] = (u32x4){0u, 0u, 0u, 0u}; }
}

__device__ __forceinline__ f32x4 shift4(u32x2 pc, u32x2 pp, u32x2 pn, f32x4 mup, f32x4 mun) {
    f32x4 c = {bflo(pc.x), bfhi(pc.x), bflo(pc.y), bfhi(pc.y)}, p = {bflo(pp.x), bfhi(pp.x), bflo(pp.y), bfhi(pp.y)}, n = {bflo(pn.x), bfhi(pn.x), bflo(pn.y), bfhi(pn.y)};
    return c + mup * (p - c) + mun * (n - c);
}
__device__ __forceinline__ float fma_s(float a, float b, float c) { float r; asm("v_fma_f32 %0, %1, %2, %3" : "=v"(r) : "v"(a), "v"(b), "v"(c)); return r; }
__device__ __forceinline__ float mul_s(float a, float b) { float r; asm("v_mul_f32_e32 %0, %1, %2" : "=v"(r) : "v"(a), "v"(b)); return r; }
__device__ __forceinline__ float add_s(float a, float b) { float r; asm("v_add_f32_e32 %0, %1, %2" : "=v"(r) : "v"(a), "v"(b)); return r; }
__device__ __forceinline__ float dot4_s(const float (&s)[4], const f32x4 v) { const float m0 = mul_s(s[0], v[0]), m2 = mul_s(s[2], v[2]); return add_s(fma_s(s[1], v[1], m0), fma_s(s[3], v[3], m2)); }
__device__ __forceinline__ void dpp_sum16_x4(float& a, float& b, float& c, float& d) {
    asm("s_nop 1\n\t"
        "v_add_f32_dpp %0, %0, %0 quad_perm:[1,0,3,2] row_mask:0xf bank_mask:0xf\n\t"
        "v_add_f32_dpp %1, %1, %1 quad_perm:[1,0,3,2] row_mask:0xf bank_mask:0xf\n\t"
        "v_add_f32_dpp %2, %2, %2 quad_perm:[1,0,3,2] row_mask:0xf bank_mask:0xf\n\t"
        "v_add_f32_dpp %3, %3, %3 quad_perm:[1,0,3,2] row_mask:0xf bank_mask:0xf\n\t"
        "v_add_f32_dpp %0, %0, %0 quad_perm:[2,3,0,1] row_mask:0xf bank_mask:0xf\n\t"
        "v_add_f32_dpp %1, %1, %1 quad_perm:[2,3,0,1] row_mask:0xf bank_mask:0xf\n\t"
        "v_add_f32_dpp %2, %2, %2 quad_perm:[2,3,0,1] row_mask:0xf bank_mask:0xf\n\t"
        "v_add_f32_dpp %3, %3, %3 quad_perm:[2,3,0,1] row_mask:0xf bank_mask:0xf\n\t"
        "v_add_f32_dpp %0, %0, %0 row_half_mirror row_mask:0xf bank_mask:0xf\n\t"
        "v_add_f32_dpp %1, %1, %1 row_half_mirror row_mask:0xf bank_mask:0xf\n\t"
        "v_add_f32_dpp %2, %2, %2 row_half_mirror row_mask:0xf bank_mask:0xf\n\t"
        "v_add_f32_dpp %3, %3, %3 row_half_mirror row_mask:0xf bank_mask:0xf\n\t"
        "v_add_f32_dpp %0, %0, %0 row_mirror row_mask:0xf bank_mask:0xf\n\t"
        "v_add_f32_dpp %1, %1, %1 row_mirror row_mask:0xf bank_mask:0xf\n\t"
        "v_add_f32_dpp %2, %2, %2 row_mirror row_mask:0xf bank_mask:0xf\n\t"
        "v_add_f32_dpp %3, %3, %3 row_mirror row_mask:0xf bank_mask:0xf\n\t"
        "s_nop 0"
        : "+v"(a), "+v"(b), "+v"(c), "+v"(d));
}
#define LDS_BARRIER() do { asm volatile("s_waitcnt lgkmcnt(0)" ::: "memory"); __builtin_amdgcn_s_barrier(); asm volatile("" ::: "memory"); } while (0)
#define WAVE_LDS_SYNC() do { asm volatile("s_waitcnt lgkmcnt(0)" ::: "memory"); __builtin_amdgcn_wave_barrier(); asm volatile("" ::: "memory"); } while (0)
typedef short s16x4 __attribute__((ext_vector_type(4)));
typedef __bf16 bf16x2_t __attribute__((ext_vector_type(2)));
__device__ __forceinline__ unsigned cvtpk2(float lo, float hi) { const f32x2 v = {lo, hi}; const bf16x2_t b = __builtin_convertvector(v, bf16x2_t); return __builtin_bit_cast(unsigned, b); }
__device__ __forceinline__ s16x4 f4_to_bf4(const f32x4 v) { u32x2 w; w.x = cvtpk2(v[0], v[1]); w.y = cvtpk2(v[2], v[3]); return __builtin_bit_cast(s16x4, w); }
__device__ __forceinline__ f32x4 mfma16(s16x4 a, s16x4 b, f32x4 c) { return __builtin_amdgcn_mfma_f32_16x16x16bf16_1k(a, b, c, 0, 0, 0); }
__device__ __forceinline__ s16x4 lds_tr4(const LAS unsigned char* p) { return __builtin_bit_cast(s16x4, __builtin_amdgcn_ds_read_tr16_b64_v4i16((LAS s16x4*)p)); }
template <int CTRL> __device__ __forceinline__ float dpp0f(float x) { return __builtin_bit_cast(float, __builtin_amdgcn_update_dpp(0, __builtin_bit_cast(int, x), CTRL, 0xF, 0xF, true)); }
template <int CTRL> __device__ __forceinline__ float dpp1f(float x) { return __builtin_bit_cast(float, __builtin_amdgcn_update_dpp(0x3f800000, __builtin_bit_cast(int, x), CTRL, 0xF, 0xF, false)); }
__device__ __forceinline__ void row_scanmul16_x4(float& a, float& b, float& c, float& d) {
    asm("s_nop 1\n\t"
        "v_mul_f32_dpp %0, %0, %0 row_shr:1 row_mask:0xf bank_mask:0xf\n\t" "v_mul_f32_dpp %1, %1, %1 row_shr:1 row_mask:0xf bank_mask:0xf\n\t"
        "v_mul_f32_dpp %2, %2, %2 row_shr:1 row_mask:0xf bank_mask:0xf\n\t" "v_mul_f32_dpp %3, %3, %3 row_shr:1 row_mask:0xf bank_mask:0xf\n\t"
        "v_mul_f32_dpp %0, %0, %0 row_shr:2 row_mask:0xf bank_mask:0xf\n\t" "v_mul_f32_dpp %1, %1, %1 row_shr:2 row_mask:0xf bank_mask:0xf\n\t"
        "v_mul_f32_dpp %2, %2, %2 row_shr:2 row_mask:0xf bank_mask:0xf\n\t" "v_mul_f32_dpp %3, %3, %3 row_shr:2 row_mask:0xf bank_mask:0xf\n\t"
        "v_mul_f32_dpp %0, %0, %0 row_shr:4 row_mask:0xf bank_mask:0xf\n\t" "v_mul_f32_dpp %1, %1, %1 row_shr:4 row_mask:0xf bank_mask:0xf\n\t"
        "v_mul_f32_dpp %2, %2, %2 row_shr:4 row_mask:0xf bank_mask:0xf\n\t" "v_mul_f32_dpp %3, %3, %3 row_shr:4 row_mask:0xf bank_mask:0xf\n\t"
        "v_mul_f32_dpp %0, %0, %0 row_shr:8 row_mask:0xf bank_mask:0xf\n\t" "v_mul_f32_dpp %1, %1, %1 row_shr:8 row_mask:0xf bank_mask:0xf\n\t"
        "v_mul_f32_dpp %2, %2, %2 row_shr:8 row_mask:0xf bank_mask:0xf\n\t" "v_mul_f32_dpp %3, %3, %3 row_shr:8 row_mask:0xf bank_mask:0xf\n\t"
        "s_nop 0"
        : "+v"(a), "+v"(b), "+v"(c), "+v"(d));
}
__device__ __forceinline__ float row_scanmul16(float x) { x *= dpp1f<0x111>(x); x *= dpp1f<0x112>(x); x *= dpp1f<0x114>(x); x *= dpp1f<0x118>(x); return x; }

struct ConvItem { const float* src; unsigned char* dst; int N; };
__device__ __forceinline__ ConvItem conv_decode(const Args& a, int id) {
    unsigned char* ws = a.ws; ConvItem c;
    if (id < 65536) { const int e = id >> 11, r = id & 2047, kb = r >> 7, nb = r & 127; const int c0 = 16 * nb;
        const int drow = 256 * ((c0 & 1023) >> 7) + 128 * (c0 >> 10) + (c0 & 127);
        c.src = a.in[I_W1] + (size_t)e * 1024 * 2048 + (size_t)(64 * kb) * 2048 + c0; c.dst = ws + WS_W1 + (size_t)e * 2048 * 1024 + (size_t)drow * 1024 + 64 * kb; c.N = 2048;
    } else { const int r2 = id - 65536; const int e = r2 >> 10, r = r2 & 1023, kb = r >> 6, nb = r & 63;
        c.src = a.in[I_W2] + (size_t)e * 1024 * 1024 + (size_t)(64 * kb) * 1024 + 16 * nb; c.dst = ws + WS_W2 + (size_t)e * 1024 * 1024 + (size_t)(16 * nb) * 1024 + 64 * kb; c.N = 1024; }
    return c;
}
__device__ __forceinline__ void conv_load(const ConvItem& c, float (&v)[16], int lane) {
#pragma unroll
    for (int i = 0; i < 16; ++i) v[i] = c.src[(size_t)(4 * i + (lane >> 4)) * c.N + (lane & 15)];
}
__device__ __forceinline__ void conv_store(const ConvItem& c, const float (&v)[16], LAS float* scr, int lane) {
#pragma unroll
    for (int i = 0; i < 16; ++i) scr[(4 * i + (lane >> 4)) * 17 + (lane & 15)] = v[i];
    asm volatile("s_waitcnt lgkmcnt(0)" ::: "memory"); __builtin_amdgcn_wave_barrier();
    const int n = lane >> 2, q = lane & 3; const LAS float* s = scr + (16 * q) * 17 + n;
    u32x4 o0;
    o0.x = pack4_fp8(s[0 * 17] * F8S_W, s[1 * 17] * F8S_W, s[2 * 17] * F8S_W, s[3 * 17] * F8S_W); o0.y = pack4_fp8(s[4 * 17] * F8S_W, s[5 * 17] * F8S_W, s[6 * 17] * F8S_W, s[7 * 17] * F8S_W);
    o0.z = pack4_fp8(s[8 * 17] * F8S_W, s[9 * 17] * F8S_W, s[10 * 17] * F8S_W, s[11 * 17] * F8S_W); o0.w = pack4_fp8(s[12 * 17] * F8S_W, s[13 * 17] * F8S_W, s[14 * 17] * F8S_W, s[15 * 17] * F8S_W);
    *(u32x4*)(c.dst + (size_t)n * 1024 + 16 * q) = o0;
    asm volatile("s_waitcnt lgkmcnt(0)" ::: "memory"); __builtin_amdgcn_wave_barrier();
}
constexpr int SC_W2T = 0, SC_A2T = 9216, SC_PRM = 18432, SC_PRIV = 22528, SC_PP = 13312, SC_HAND = 75776, SC_HP = 13056;
constexpr int HO_KAP = 0, HO_RT = 2304, HO_KDG = 4608, HO_VV = 6912, HO_BMT = 9216, HO_MBT = 9728, HO_N1T = 10240, HO_TBT = 10752, HO_GC = 12800;
constexpr int PV_XA = 0, PV_LOUT = 0, PV_BT = 8704, PV_KD = 11008, LOP = 68;
struct Raw6 { u32x4 c0, c1, h0, h1; };
__device__ __forceinline__ void scan_load_seg(Raw6& R, const bf16* prow, int col, bool hp, bool hn, int li, int dir) {
    R.c0 = *(const u32x4*)(prow + col); R.c1 = *(const u32x4*)(prow + col + 8);
    R.h0 = (u32x4){0u, 0u, 0u, 0u}; R.h1 = R.h0;
    const bool wantprev = (li == 0) ? (dir == 0) : (dir != 0);
    if ((li == 0 || li == 15) && (wantprev ? hp : hn)) { const bf16* hr = wantprev ? prow - PN : prow + PN; R.h0 = *(const u32x4*)(hr + col); R.h1 = *(const u32x4*)(hr + col + 8); }
}
template <int CTRL> __device__ __forceinline__ unsigned dpp_nbr(unsigned cur, unsigned halo) { return (unsigned)__builtin_amdgcn_update_dpp((int)halo, (int)cur, CTRL, 0xF, 0xF, false); }
template <int DIR> __device__ __forceinline__ f32x4 scan_shift4_t(const Raw6& R, int q4, const LAS float* mup, const LAS float* mun) {
    const unsigned c0 = q4 == 0 ? R.c0.x : q4 == 1 ? R.c0.z : q4 == 2 ? R.c1.x : R.c1.z, c1 = q4 == 0 ? R.c0.y : q4 == 1 ? R.c0.w : q4 == 2 ? R.c1.y : R.c1.w;
    const unsigned h0 = q4 == 0 ? R.h0.x : q4 == 1 ? R.h0.z : q4 == 2 ? R.h1.x : R.h1.z, h1 = q4 == 0 ? R.h0.y : q4 == 1 ? R.h0.w : q4 == 2 ? R.h1.y : R.h1.w;
    constexpr int CP = DIR ? 0x101 : 0x111, CN = DIR ? 0x111 : 0x101;
    const unsigned p0 = dpp_nbr<CP>(c0, h0), p1 = dpp_nbr<CP>(c1, h1), n0 = dpp_nbr<CN>(c0, h0), n1 = dpp_nbr<CN>(c1, h1);
    const f32x4 mp = *(const LAS f32x4*)(mup + 4 * q4), mn = *(const LAS f32x4*)(mun + 4 * q4);
    const f32x4 cv = {bflo(c0), bfhi(c0), bflo(c1), bfhi(c1)}, pv = {bflo(p0), bfhi(p0), bflo(p1), bfhi(p1)}, nv = {bflo(n0), bfhi(n0), bflo(n1), bfhi(n1)};
    return cv + mp * (pv - cv) + mn * (nv - cv);
}
template <int DIR> __device__ __forceinline__ f32x4 scan_shift4_v(const Raw6& R, int q4, const f32x4 mp, const f32x4 mn) {
    const unsigned c0 = q4 == 0 ? R.c0.x : q4 == 1 ? R.c0.z : q4 == 2 ? R.c1.x : R.c1.z, c1 = q4 == 0 ? R.c0.y : q4 == 1 ? R.c0.w : q4 == 2 ? R.c1.y : R.c1.w;
    const unsigned h0 = q4 == 0 ? R.h0.x : q4 == 1 ? R.h0.z : q4 == 2 ? R.h1.x : R.h1.z, h1 = q4 == 0 ? R.h0.y : q4 == 1 ? R.h0.w : q4 == 2 ? R.h1.y : R.h1.w;
    constexpr int CP = DIR ? 0x101 : 0x111, CN = DIR ? 0x111 : 0x101;
    const unsigned p0 = dpp_nbr<CP>(c0, h0), p1 = dpp_nbr<CP>(c1, h1), n0 = dpp_nbr<CN>(c0, h0), n1 = dpp_nbr<CN>(c1, h1);
    const f32x4 cv = {bflo(c0), bfhi(c0), bflo(c1), bfhi(c1)}, pv = {bflo(p0), bfhi(p0), bflo(p1), bfhi(p1)}, nv = {bflo(n0), bfhi(n0), bflo(n1), bfhi(n1)};
    return cv + mp * (pv - cv) + mn * (nv - cv);
}
#define PRM_LOAD4(dst, off, row) do { _Pragma("unroll") for (int q_ = 0; q_ < 4; ++q_) dst[(off) + q_] = *(const LAS f32x4*)(prm + (row) * 64 + 4 * q_); } while (0)
__device__ __forceinline__ f32x4 scan_shift4(const Raw6& R, int q4, const LAS float* mup, const LAS float* mun, int dir) { return dir ? scan_shift4_t<1>(R, q4, mup, mun) : scan_shift4_t<0>(R, q4, mup, mun); }
__device__ __forceinline__ void scan_shift16(float (&x)[16], const Raw6& R, const LAS float* mup, const LAS float* mun, int dir) {
#pragma unroll
    for (int q4 = 0; q4 < 4; ++q4) { const f32x4 v = scan_shift4(R, q4, mup, mun, dir); x[4 * q4] = v[0]; x[4 * q4 + 1] = v[1]; x[4 * q4 + 2] = v[2]; x[4 * q4 + 3] = v[3]; }
}
__device__ __forceinline__ void scan_store4_bf(LAS unsigned char* dst, const f32x4 v) { u32x2 w; w.x = cvtpk2(v[0], v[1]); w.y = cvtpk2(v[2], v[3]); *(LAS u32x2*)dst = w; }
__device__ __forceinline__ void scan_store16_bf(LAS unsigned char* dst, const float (&x)[16]) {
    u32x4 w0, w1; w0.x = cvtpk2(x[0], x[1]); w0.y = cvtpk2(x[2], x[3]); w0.z = cvtpk2(x[4], x[5]); w0.w = cvtpk2(x[6], x[7]); w1.x = cvtpk2(x[8], x[9]); w1.y = cvtpk2(x[10], x[11]); w1.z = cvtpk2(x[12], x[13]); w1.w = cvtpk2(x[14], x[15]);
    *(LAS u32x4*)dst = w0; *(LAS u32x4*)(dst + 16) = w1;
}
__device__ __forceinline__ f32x4 scan_gram(const LAS unsigned char* X, const LAS unsigned char* Y, int li, int g) {
    f32x4 c = {0.f, 0.f, 0.f, 0.f};
    const bf16x8 a0 = *(const LAS bf16x8*)(X + li * 144 + 16 * g), a1 = *(const LAS bf16x8*)(X + li * 144 + 64 + 16 * g);
    const bf16x8 b0 = *(const LAS bf16x8*)(Y + li * 144 + 16 * g), b1 = *(const LAS bf16x8*)(Y + li * 144 + 64 + 16 * g);
    c = __builtin_amdgcn_mfma_f32_16x16x32_bf16(a0, b0, c, 0, 0, 0); c = __builtin_amdgcn_mfma_f32_16x16x32_bf16(a1, b1, c, 0, 0, 0);
    return c;
}

template <int DIR> __device__ __forceinline__ void phase_scan_unit_t(const Args& a, LAS unsigned char* lds, int unit) {
    const int tid = threadIdx.x, lane = tid & 63, wid = __builtin_amdgcn_readfirstlane(tid >> 6), li = lane & 15, g = lane >> 4;
    const int b = unit >> 4, h = (unit >> 1) & 7; constexpr int dir = DIR;
    unsigned char* ws = a.ws;
    const bf16* P = (const bf16*)(ws + WS_P);
    bf16* Odir = (bf16*)(ws + (dir ? WS_OB : WS_OF));
    float* CFB = (float*)(ws + WS_CFB);
    LAS unsigned char* W2T = lds + SC_W2T; LAS unsigned char* A2T = lds + SC_A2T; LAS float* PRM = (LAS float*)(lds + SC_PRM);
    Raw6 rw, ra, rk, rr;
    Raw6 rvv;
    ConvItem cv0, cv1, cv2; float v0[16], v1[16], v2[16];
    if (wid >= 4) { const int pw_ = wid - 4; const int t0_ = dir ? (SEQ - 1 - (16 * pw_ + li)) : (16 * pw_ + li); const bf16* pr0 = P + ((size_t)b * SEQ + t0_) * PN; const bool hp0 = t0_ > 0, hn0 = t0_ < SEQ - 1;
        scan_load_seg(rw, pr0, C_LWF + dir * 64 + 16 * g, hp0, hn0, li, dir); scan_load_seg(ra, pr0, C_LAF + dir * 64 + 16 * g, hp0, hn0, li, dir);
        scan_load_seg(rk, pr0, C_K + h * 64 + 16 * g, hp0, hn0, li, dir); scan_load_seg(rr, pr0, C_R + h * 64 + 16 * g, hp0, hn0, li, dir);
    } else { const int vt_ = wid; const int t0_ = dir ? (SEQ - 1 - (16 * vt_ + li)) : (16 * vt_ + li); scan_load_seg(rvv, P + ((size_t)b * SEQ + t0_) * PN, C_V + h * 64 + 16 * g, t0_ > 0, t0_ < SEQ - 1, li, dir);
        const int cb0 = (((int)blockIdx.x * 4 + vt_) * 32) * 3; cv0 = conv_decode(a, cb0); cv1 = conv_decode(a, cb0 + 1); cv2 = conv_decode(a, cb0 + 2);
        conv_load(cv0, v0, lane); conv_load(cv1, v1, lane); conv_load(cv2, v2, lane); }
    __syncthreads();
    {   const float* w2 = a.in[dir ? I_W2B : I_W2F]; const float* a2 = a.in[dir ? I_A2B : I_A2F];
#pragma unroll
        for (int i = 0; i < 8; ++i) { const int idx = tid + 512 * i, j = idx >> 6, n = idx & 63;
            const int pr_ = 16 * ((n >> 2) & 3) + 4 * (n >> 4) + (n & 3);
            *(LAS unsigned short*)(W2T + pr_ * 144 + j * 2) = (unsigned short)f2bf(w2[j * 512 + h * 64 + n]);
            *(LAS unsigned short*)(A2T + pr_ * 144 + j * 2) = (unsigned short)f2bf(a2[j * 512 + h * 64 + n]); }
        const int segb[5] = {C_R + h * 64, C_K + h * 64, C_V + h * 64, C_LWF + dir * 64, C_LAF + dir * 64};
        for (int i = tid; i < 15 * 64; i += 512) { const int row = i >> 6, col = i & 63; float v;
            if (row < 5) v = a.in[I_MUP][segb[row] + col]; else if (row < 10) v = a.in[I_MUN][segb[row - 5] + col];
            else if (row == 10) v = a.in[dir ? I_W0B : I_W0F][h * 64 + col]; else if (row == 11) v = a.in[dir ? I_A0B : I_A0F][h * 64 + col];
            else if (row == 12) v = a.in[I_KK][h * 64 + col]; else if (row == 13) v = a.in[I_KA][h * 64 + col]; else v = a.in[I_RK][h * 64 + col];
            PRM[i] = v; }
    }
    __syncthreads();
    if (wid >= 4) {
        const int pw = wid - 4;
        LAS unsigned char* PV = lds + SC_PRIV + pw * SC_PP;
        LAS unsigned char* HO = lds + SC_HAND + pw * SC_HP;
        LAS unsigned char* XA0 = PV + PV_XA; LAS unsigned char* XA1 = PV + PV_XA + 2304; LAS float* LOUT = (LAS float*)(PV + PV_LOUT);
        LAS unsigned char* BTm = PV + PV_BT; LAS unsigned char* KDm = PV + PV_KD;
        const LAS float* prm0 = PRM + 16 * g;
        const int cR = C_R + h * 64 + 16 * g, cK = C_K + h * 64 + 16 * g, cV = C_V + h * 64 + 16 * g, cLW = C_LWF + dir * 64 + 16 * g, cLA = C_LAF + dir * 64 + 16 * g;
#if STAMP_SEL >= 0
        unsigned stacc[8] = {0u, 0u, 0u, 0u, 0u, 0u, 0u, 0u}; unsigned long long stprev = __builtin_amdgcn_s_memrealtime();
#define STAMP(k) do { __builtin_amdgcn_sched_barrier(0); const unsigned long long tn_ = __builtin_amdgcn_s_memrealtime(); stacc[k] += (unsigned)(tn_ - stprev); stprev = tn_; __builtin_amdgcn_sched_barrier(0); } while (0)
#else
#define STAMP(k) do { } while (0)
#endif
#pragma unroll 1
        for (int bi = 0; bi < SEQ / 64; ++bi) {
#if SCAN_DBG == 1
            LDS_BARRIER(); LDS_BARRIER(); continue;
#endif
            int li_ = li, g_ = g; asm volatile("" : "+v"(li_), "+v"(g_));
            const int cidx = 4 * bi + pw;
            const int t = dir ? (SEQ - 1 - (16 * cidx + li_)) : (16 * cidx + li_);
            const size_t m = (size_t)b * SEQ + t;
            const bf16* prow = P + m * PN; const bool hp = t > 0, hn = t < SEQ - 1;
            const LAS float* prm = prm0; asm volatile("" : "+v"(prm));
            float av[16], eG[16];
            {
            f32x4 cw[4], ca[4];
            {
                bf16x8 bw0, bw1, ba0, ba1;
                {   float xl[16];
                    f32x4 pm[16]; PRM_LOAD4(pm, 0, 3); PRM_LOAD4(pm, 4, 8); PRM_LOAD4(pm, 8, 4); PRM_LOAD4(pm, 12, 9);
                    __builtin_amdgcn_sched_barrier(0);
#pragma unroll
                    for (int q4 = 0; q4 < 4; ++q4) { const f32x4 v = scan_shift4_v<DIR>(rw, q4, pm[q4], pm[4 + q4]); xl[4 * q4] = v[0]; xl[4 * q4 + 1] = v[1]; xl[4 * q4 + 2] = v[2]; xl[4 * q4 + 3] = v[3]; }
#pragma unroll
                    for (int j = 0; j < 16; ++j) xl[j] = fast_tanh(xl[j]);
                    u32x4 w; w.x = cvtpk2(xl[0], xl[1]); w.y = cvtpk2(xl[2], xl[3]); w.z = cvtpk2(xl[4], xl[5]); w.w = cvtpk2(xl[6], xl[7]); bw0 = __builtin_bit_cast(bf16x8, w);
                    w.x = cvtpk2(xl[8], xl[9]); w.y = cvtpk2(xl[10], xl[11]); w.z = cvtpk2(xl[12], xl[13]); w.w = cvtpk2(xl[14], xl[15]); bw1 = __builtin_bit_cast(bf16x8, w);
#pragma unroll
                    for (int q4 = 0; q4 < 4; ++q4) { const f32x4 v = scan_shift4_v<DIR>(ra, q4, pm[8 + q4], pm[12 + q4]); xl[4 * q4] = v[0]; xl[4 * q4 + 1] = v[1]; xl[4 * q4 + 2] = v[2]; xl[4 * q4 + 3] = v[3]; }
                    w.x = cvtpk2(xl[0], xl[1]); w.y = cvtpk2(xl[2], xl[3]); w.z = cvtpk2(xl[4], xl[5]); w.w = cvtpk2(xl[6], xl[7]); ba0 = __builtin_bit_cast(bf16x8, w);
                    w.x = cvtpk2(xl[8], xl[9]); w.y = cvtpk2(xl[10], xl[11]); w.z = cvtpk2(xl[12], xl[13]); w.w = cvtpk2(xl[14], xl[15]); ba1 = __builtin_bit_cast(bf16x8, w);
                }
                STAMP(0);
#pragma unroll
                for (int nt = 0; nt < 4; ++nt) {
                    const LAS unsigned char* aw = W2T + (16 * nt + li_) * 144 + 32 * g_; const LAS unsigned char* aa = A2T + (16 * nt + li_) * 144 + 32 * g_;
                    f32x4 c = {0.f, 0.f, 0.f, 0.f};
                    c = __builtin_amdgcn_mfma_f32_16x16x32_bf16(*(const LAS bf16x8*)aw, bw0, c, 0, 0, 0); c = __builtin_amdgcn_mfma_f32_16x16x32_bf16(*(const LAS bf16x8*)(aw + 16), bw1, c, 0, 0, 0); cw[nt] = c;
                    c = (f32x4){0.f, 0.f, 0.f, 0.f};
                    c = __builtin_amdgcn_mfma_f32_16x16x32_bf16(*(const LAS bf16x8*)aa, ba0, c, 0, 0, 0); c = __builtin_amdgcn_mfma_f32_16x16x32_bf16(*(const LAS bf16x8*)(aa + 16), ba1, c, 0, 0, 0); ca[nt] = c;
                }
            }
#if SCAN_DUP == 8
            for (int rp_ = 0; rp_ < 2; ++rp_) { asm volatile("" : "+v"(li_), "+v"(g_));
#else
            {
#endif
            STAMP(1);
            f32x4 pwa[8]; PRM_LOAD4(pwa, 0, 10); PRM_LOAD4(pwa, 4, 11);
            __builtin_amdgcn_sched_barrier(0);
#pragma unroll
            for (int q4 = 0; q4 < 4; ++q4) { const f32x4 dl = cw[q4], al = ca[q4];
                const f32x4 w0 = pwa[q4], a0 = pwa[4 + q4];
#pragma unroll
                for (int e = 0; e < 4; ++e) { const int j = 4 * q4 + e; eG[j] = __expf(-DECAY_SCALE * fast_sigmoid(w0[e] + dl[e])); av[j] = fast_sigmoid(a0[e] + al[e]); }
                row_scanmul16_x4(eG[4 * q4], eG[4 * q4 + 1], eG[4 * q4 + 2], eG[4 * q4 + 3]); }
            }
            }
            STAMP(2);
            LAS float* GC = (LAS float*)(HO + HO_GC);
            float kdv[16]; u32x2 prt[4]; f32x4 krr[4]; float inv;
#if SCAN_DUP == 5
            for (int rp_ = 0; rp_ < 2; ++rp_) { asm volatile("" : "+v"(li_), "+v"(g_));
#else
            {
#endif
            {   float ss = 0.f;
                f32x4 pk[16]; PRM_LOAD4(pk, 0, 1); PRM_LOAD4(pk, 4, 6); PRM_LOAD4(pk, 8, 12); PRM_LOAD4(pk, 12, 13);
                __builtin_amdgcn_sched_barrier(0);
#pragma unroll
                for (int q4 = 0; q4 < 4; ++q4) { const f32x4 xk = scan_shift4_v<DIR>(rk, q4, pk[q4], pk[4 + q4]); const f32x4 kr = xk * pk[8 + q4]; krr[q4] = kr; ss += (kr[0] * kr[0] + kr[1] * kr[1]) + (kr[2] * kr[2] + kr[3] * kr[3]);
#pragma unroll
                    for (int e = 0; e < 4; ++e) { const int j = 4 * q4 + e; kdv[j] = xk[e] * (1.0f + (av[j] - 1.0f) * pk[12 + q4][e]); } }
                ss += __shfl_xor(ss, 16); ss += __shfl_xor(ss, 32);
                inv = __builtin_amdgcn_rcpf(fmaxf(sqrtf(ss), 1e-12f));
            }
            {   float cb = 0.f;
                f32x4 pr[12]; PRM_LOAD4(pr, 0, 0); PRM_LOAD4(pr, 4, 5); PRM_LOAD4(pr, 8, 14);
                __builtin_amdgcn_sched_barrier(0);
#pragma unroll
                for (int q4 = 0; q4 < 4; ++q4) { f32x4 xr = scan_shift4_v<DIR>(rr, q4, pr[q4], pr[4 + q4]); const f32x4 rk4 = pr[8 + q4];
#pragma unroll
                    for (int e = 0; e < 4; ++e) { const int j = 4 * q4 + e; cb += xr[e] * kdv[j] * rk4[e]; xr[e] *= eG[j]; }
                    prt[q4].x = cvtpk2(xr[0], xr[1]); prt[q4].y = cvtpk2(xr[2], xr[3]); }
                cb += __shfl_xor(cb, 16); cb += __shfl_xor(cb, 32);
                if (g_ == 0) CFB[m * 16 + h * 2 + dir] = cb;
            }
            LDS_BARRIER();
            STAMP(3);
            if (li_ == 15) {
#pragma unroll
                for (int q4 = 0; q4 < 4; ++q4) *(LAS f32x4*)(GC + 16 * g_ + 4 * q4) = (f32x4){eG[4 * q4], eG[4 * q4 + 1], eG[4 * q4 + 2], eG[4 * q4 + 3]};
            }
#pragma unroll
            for (int q4 = 0; q4 < 4; ++q4) *(LAS u32x2*)(HO + HO_RT + li_ * 144 + 32 * g_ + 8 * q4) = prt[q4];
#pragma unroll
            for (int q4 = 0; q4 < 4; ++q4) {
                f32x4 okap, obt, okd, okdg;
#pragma unroll
                for (int e = 0; e < 4; ++e) { const int j = 4 * q4 + e; const float kappa = krr[q4][e] * inv; const float eGm = dpp1f<0x111>(eG[j]), enG = __builtin_amdgcn_rcpf(eG[j]);
                    const float kd = kdv[j];
                    const float gcj = __int_as_float(__builtin_amdgcn_update_dpp(0, __float_as_int(eG[j]), 0x15F, 0xF, 0xF, false));
                    okap[e] = kappa * eGm; obt[e] = kappa * av[j] * enG; okd[e] = kd * enG; okdg[e] = kd * enG * gcj; }
                scan_store4_bf(HO + HO_KAP + li_ * 144 + 32 * g_ + 8 * q4, okap); scan_store4_bf(BTm + li_ * 144 + 32 * g_ + 8 * q4, obt);
                scan_store4_bf(KDm + li_ * 144 + 32 * g_ + 8 * q4, okd); scan_store4_bf(HO + HO_KDG + li_ * 144 + 32 * g_ + 8 * q4, okdg);
            }
            }
            STAMP(4);
            {
                const int cn = (bi + 1 < SEQ / 64) ? cidx + 4 : cidx;
                const int tn = dir ? (SEQ - 1 - (16 * cn + li_)) : (16 * cn + li_); const bf16* prn = P + ((size_t)b * SEQ + tn) * PN;
                const bool hpn = tn > 0, hnn = tn < SEQ - 1;
                scan_load_seg(rw, prn, cLW, hpn, hnn, li_, dir); scan_load_seg(ra, prn, cLA, hpn, hnn, li_, dir); scan_load_seg(rk, prn, cK, hpn, hnn, li_, dir); scan_load_seg(rr, prn, cR, hpn, hnn, li_, dir); }
            WAVE_LDS_SYNC();
#if SCAN_DUP == 3
            for (int rp_ = 0; rp_ < 2; ++rp_) { asm volatile("" : "+v"(li_), "+v"(g_));
#else
            {
#endif
            f32x4 Lc = scan_gram(BTm, HO + HO_KAP, li_, g_), Lr = scan_gram(HO + HO_KAP, BTm, li_, g_), Bmc = scan_gram(KDm, HO + HO_KAP, li_, g_), MAc = scan_gram(BTm, HO + HO_RT, li_, g_), MBc = scan_gram(KDm, HO + HO_RT, li_, g_);
            f32x4 Ic;
#pragma unroll
            for (int rg = 0; rg < 4; ++rg) { const int i = 4 * g_ + rg;
                if (!(i < li_)) { Lc[rg] = 0.f; Bmc[rg] = 0.f; }
                if (!(li_ < i)) Lr[rg] = 0.f;
                if (!(i <= li_)) { MAc[rg] = 0.f; MBc[rg] = 0.f; }
                Ic[rg] = (i == li_) ? 1.0f : 0.f; }
            const f32x4 z4 = {0.f, 0.f, 0.f, 0.f};
            const s16x4 L1c = f4_to_bf4(Lc), L1r = f4_to_bf4(Lr);
            const f32x4 L2cf = mfma16(L1r, L1c, z4), L2rf = mfma16(L1c, L1r, z4);
            const s16x4 L2c = f4_to_bf4(L2cf), L2r = f4_to_bf4(L2rf);
            const f32x4 L4cf = mfma16(L2r, L2c, z4), L4rf = mfma16(L2c, L2r, z4);
            const s16x4 L4c = f4_to_bf4(L4cf), L4r = f4_to_bf4(L4rf);
            const f32x4 L8cf = mfma16(L4r, L4c, z4), L8rf = mfma16(L4c, L4r, z4);
            const s16x4 P1c = f4_to_bf4(Ic - Lc), P2r = f4_to_bf4(Ic + L2rf), P4c = f4_to_bf4(Ic + L4cf), P4r = f4_to_bf4(Ic + L4rf), P8c = f4_to_bf4(Ic + L8cf), P8r = f4_to_bf4(Ic + L8rf);
            const s16x4 T12r = f4_to_bf4(mfma16(P1c, P2r, z4));
            const s16x4 T48c = f4_to_bf4(mfma16(P4r, P8c, z4));
            const s16x4 Tr = f4_to_bf4(mfma16(T48c, T12r, z4));
            const f32x4 N1c = mfma16(Tr, f4_to_bf4(MAc), z4);
            *(LAS s16x4*)(HO + HO_BMT + li_ * 32 + g_ * 8) = f4_to_bf4(Bmc);
            *(LAS s16x4*)(HO + HO_MBT + li_ * 32 + g_ * 8) = f4_to_bf4(MBc);
            *(LAS s16x4*)(HO + HO_N1T + li_ * 32 + g_ * 8) = f4_to_bf4(-N1c);
#pragma unroll
            for (int kt = 0; kt < 4; ++kt) {
                const s16x4 bb = lds_tr4(BTm + (4 * g_ + (li_ >> 2)) * 144 + (16 * kt + 4 * (li_ & 3)) * 2);
                f32x4 d = mfma16(Tr, bb, z4);
                const float gck = -GC[16 * kt + li_];
                d = d * gck;
                *(LAS s16x4*)(HO + HO_TBT + (16 * kt + li_) * 32 + g_ * 8) = f4_to_bf4(d);
            }
            }
            STAMP(5);
            LDS_BARRIER();
            STAMP(6);
        }
#if STAMP_SEL >= 0
        if (blockIdx.x == 0 && pw == 0 && lane == 0) { float tot = 0.f; for (int k = 0; k < 7; ++k) tot += (float)stacc[k]; float* stp = (float*)(ws + WS_GW); for (int k = 0; k < 7; ++k) stp[k] = floorf((float)stacc[k] / tot * 16.0f + 0.5f) * (1.0f / 16.0f); stp[7] = floorf(tot * 0.01f / 32.0f + 0.5f); }
#endif
    } else {
        const int vt = wid;
        f32x4 St[4];
#pragma unroll
        for (int kt = 0; kt < 4; ++kt) St[kt] = (f32x4){0.f, 0.f, 0.f, 0.f};
        const int cVc = C_V + h * 64 + 16 * g;
#pragma unroll 1
        for (int bi = 0; bi < SEQ / 64; ++bi) {
            LDS_BARRIER();
            {
                {   const int tv = dir ? (SEQ - 1 - (16 * (4 * bi + vt) + li)) : (16 * (4 * bi + vt) + li); const bool hpv = tv > 0, hnv = tv < SEQ - 1;
                    LAS unsigned char* HOv = lds + SC_HAND + vt * SC_HP; const LAS float* prmv = PRM + 16 * g;
#pragma unroll
                    for (int q4 = 0; q4 < 4; ++q4) scan_store4_bf(HOv + HO_VV + li * 144 + 32 * g + 8 * q4, scan_shift4(rvv, q4, prmv + 2 * 64, prmv + 7 * 64, dir));
                    const int cn = (bi + 1 < SEQ / 64) ? 4 * (bi + 1) + vt : 4 * bi + vt; const int tn = dir ? (SEQ - 1 - (16 * cn + li)) : (16 * cn + li);
                    scan_load_seg(rvv, P + ((size_t)b * SEQ + tn) * PN, cVc, tn > 0, tn < SEQ - 1, li, dir); }
                LAS float* cscr = (LAS float*)(lds + 128000 + vt * 4352);
                conv_store(cv0, v0, cscr, lane); conv_store(cv1, v1, cscr, lane); conv_store(cv2, v2, cscr, lane);
            }
            LDS_BARRIER();
            {   const int cbn = (((int)blockIdx.x * 4 + vt) * 32 + (bi + 1 < SEQ / 64 ? bi + 1 : bi)) * 3;
                cv0 = conv_decode(a, cbn); cv1 = conv_decode(a, cbn + 1); cv2 = conv_decode(a, cbn + 2);
                conv_load(cv0, v0, lane); conv_load(cv1, v1, lane); conv_load(cv2, v2, lane); }
#if SCAN_DBG == 2
            continue;
#endif
#pragma unroll 1
            for (int cc = 0; cc < 4; ++cc) {
                int li_ = li, g_ = g; asm volatile("" : "+v"(li_), "+v"(g_));
                const LAS unsigned char* HO = lds + SC_HAND + cc * SC_HP;
                const LAS float* GC = (const LAS float*)(HO + HO_GC);
#if SCAN_DUP == 4
                f32x4 Ssv[4] = {St[0], St[1], St[2], St[3]}; f32x4 O;
                for (int rp_ = 0; rp_ < 2; ++rp_) { asm volatile("" : "+v"(li_), "+v"(g_)); if (rp_ == 1) { St[0] = Ssv[0]; St[1] = Ssv[1]; St[2] = Ssv[2]; St[3] = Ssv[3]; }
#else
                f32x4 O;
                {
#endif
                s16x4 Sb[4];
#pragma unroll
                for (int kt = 0; kt < 4; ++kt) Sb[kt] = f4_to_bf4(St[kt]);
                const s16x4 Vt = lds_tr4(HO + HO_VV + (4 * g_ + (li_ >> 2)) * 144 + (16 * vt + 4 * (li_ & 3)) * 2);
                f32x4 X = {0.f, 0.f, 0.f, 0.f}; O = (f32x4){0.f, 0.f, 0.f, 0.f};
#pragma unroll
                for (int kt = 0; kt < 4; ++kt) {
                    const s16x4 aK = *(const LAS s16x4*)(HO + HO_KAP + li_ * 144 + (16 * kt + 4 * g_) * 2), aR = *(const LAS s16x4*)(HO + HO_RT + li_ * 144 + (16 * kt + 4 * g_) * 2);
                    X = mfma16(aK, Sb[kt], X); O = mfma16(aR, Sb[kt], O);
                }
                const s16x4 aBm = *(const LAS s16x4*)(HO + HO_BMT + li_ * 32 + g_ * 8), aMB = *(const LAS s16x4*)(HO + HO_MBT + li_ * 32 + g_ * 8), aN1 = *(const LAS s16x4*)(HO + HO_N1T + li_ * 32 + g_ * 8);
                X = mfma16(aBm, Vt, X);
                const s16x4 Xb = f4_to_bf4(X);
                O = mfma16(aMB, Vt, O); O = mfma16(aN1, Xb, O);
#pragma unroll
                for (int kt = 0; kt < 4; ++kt) {
                    const f32x4 gc = *(const LAS f32x4*)(GC + 16 * kt + 4 * g_);
                    f32x4 acc = St[kt] * gc;
                    const s16x4 aTB = *(const LAS s16x4*)(HO + HO_TBT + (16 * kt + li_) * 32 + g_ * 8);
                    const s16x4 aKD = lds_tr4(HO + HO_KDG + (4 * g_ + (li_ >> 2)) * 144 + (16 * kt + 4 * (li_ & 3)) * 2);
                    acc = mfma16(aTB, Xb, acc); acc = mfma16(aKD, Vt, acc);
                    St[kt] = acc;
                }
                }
                const int cidx = 4 * bi + cc;
#pragma unroll
                for (int pr = 0; pr < 2; ++pr) {
                    const bool odd = li_ & 1; const float oa = O[2 * pr], ob_ = O[2 * pr + 1];
                    const float recv = __int_as_float(__builtin_amdgcn_update_dpp(0, __float_as_int(odd ? oa : ob_), 0xB1, 0xF, 0xF, false));
                    const unsigned w = odd ? cvtpk2(recv, ob_) : cvtpk2(oa, recv);
                    const int pidx = 16 * cidx + 4 * g_ + 2 * pr + (odd ? 1 : 0); const int t = dir ? (SEQ - 1 - pidx) : pidx;
                    *(unsigned*)(Odir + ((size_t)b * SEQ + t) * DA + h * 64 + 16 * vt + (li_ & ~1)) = w; }
            }
        }
    }
    __syncthreads();
}

typedef short v4i16_t __attribute__((ext_vector_type(4)));
__device__ __forceinline__ unsigned cvtpk(float lo, float hi) { return cvtpk2(lo, hi); }
__device__ __forceinline__ void na_load_row(const bf16* P, int b, int h, int row, int col, int ch, u32x4& kc, u32x4& vc) {
    const size_t tok = (size_t)b * SEQ + row * 64 + col;
    kc = *(const u32x4*)(P + tok * PN + C_BK + h * 64 + 8 * ch);
    vc = *(const u32x4*)(P + tok * PN + C_BV + h * 64 + 8 * ch);
}
__device__ __forceinline__ void na_write_row(LAS unsigned char* Ks, LAS unsigned char* Vs, int row, int col, int ch, f32x4 g0, f32x4 g1, u32x4 kc, u32x4 vc) {
    const float e0 = bflo(kc.x), e1 = bfhi(kc.x), e2 = bflo(kc.y), e3 = bfhi(kc.y), e4 = bflo(kc.z), e5 = bfhi(kc.z), e6 = bflo(kc.w), e7 = bfhi(kc.w);
    float ss = (e0 * e0 + e1 * e1) + (e2 * e2 + e3 * e3) + (e4 * e4 + e5 * e5) + (e6 * e6 + e7 * e7);
    ss = dpp_sum8(ss);
    const float rk = 1.0f / sqrtf(ss * (1.f / 64.f) + RMS_EPS);
    u32x4 o; o.x = cvtpk(e0 * rk * g0.x, e1 * rk * g0.y); o.y = cvtpk(e2 * rk * g0.z, e3 * rk * g0.w); o.z = cvtpk(e4 * rk * g1.x, e5 * rk * g1.y); o.w = cvtpk(e6 * rk * g1.z, e7 * rk * g1.w);
    const int off = (((row & 7) * 64 + col) << 7) + ((ch ^ (col & 7)) << 4);
    *(LAS u32x4*)(Ks + off) = o;
    *(LAS u32x4*)(Vs + off) = vc;
}
__device__ __forceinline__ void phase_na_unit(const Args& a, LAS unsigned char* lds, int unit) {
    const int tid = threadIdx.x, lane = tid & 63, wid = __builtin_amdgcn_readfirstlane(tid >> 6);
    const int b = unit >> 4, h = (unit >> 1) & 7, rh = unit & 1;
    const int c = wid & 3, dhalf = wid >> 2, g = lane >> 4, li = lane & 15;
    unsigned char* ws = a.ws;
    const bf16* P = (const bf16*)(ws + WS_P);
    bf16* YB = (bf16*)(ws + WS_YB);
    LAS unsigned char* Ks = lds; LAS unsigned char* Vs = lds + 65536; LAS float* RPB = (LAS float*)(lds + 131072);
    const int scol = tid >> 3, sch = tid & 7;
    const f32x4 kg0 = *(const f32x4*)(a.in[I_KG] + 8 * sch), kg1 = *(const f32x4*)(a.in[I_KG] + 8 * sch + 4);
    __syncthreads();
    for (int i = tid; i < 15 * 32; i += 512) { const int rr_ = i >> 5, cc_ = i & 31; RPB[i] = (cc_ < 31) ? a.in[I_RPB][h * 465 + rr_ * 31 + cc_] * 1.4426950408889634f : -1e30f; }
    const int r0 = rh * 16;
    u32x4 kraw, vraw;
    const int q = 16 * c + li;
    const int kc0 = (c == 0) ? 0 : (c == 1) ? 8 : (c == 2) ? 24 : 32;
    const int cs = min(max(q - 8, 0), 48);
    const bf16* qbase = P + ((size_t)b * SEQ + q) * PN + C_Q + h * 64 + 8 * g;
    float qg[16]; u32x4 q0, q1;
    { const int rs0 = min(max(r0 - 4, 0), 24);
      u32x4 kr8[8], vr8[8];
#pragma unroll
      for (int i = 0; i < 8; ++i) na_load_row(P, b, h, rs0 + i, scol, sch, kr8[i], vr8[i]);
      q0 = *(const u32x4*)(qbase + (size_t)r0 * 64 * PN); q1 = *(const u32x4*)(qbase + (size_t)r0 * 64 * PN + 32);
#pragma unroll
      for (int j = 0; j < 8; ++j) { qg[j] = a.in[I_QG][8 * g + j]; qg[8 + j] = a.in[I_QG][32 + 8 * g + j]; }
#pragma unroll
      for (int i = 0; i < 8; ++i) na_write_row(Ks, Vs, rs0 + i, scol, sch, kg0, kg1, kr8[i], vr8[i]); }
    int boff[8];
#pragma unroll
    for (int ch2 = 0; ch2 < 2; ++ch2)
#pragma unroll
        for (int k = 0; k < 4; ++k) { const int kcol = kc0 + 16 * ch2 + 4 * g + k; const bool valid = (kcol >= cs) && (kcol < cs + 16); boff[4 * ch2 + k] = valid ? (kcol - q + 15) : 31; }
    __syncthreads();
    float cshift;
    {   float mq = fabsf(a.in[I_QG][lane]), mk = fabsf(a.in[I_KG][lane]), bm = -1e30f;
        for (int i = lane; i < 15 * 32; i += 64) bm = fmaxf(bm, RPB[i]);
#pragma unroll
        for (int o = 1; o < 64; o <<= 1) { mq = fmaxf(mq, __shfl_xor(mq, o)); mk = fmaxf(mk, __shfl_xor(mk, o)); bm = fmaxf(bm, __shfl_xor(bm, o)); }
        cshift = fminf(8.0f * 1.4426950408889634f * mq * mk + fmaxf(bm, 0.f), 60.0f); }
    f32x4 barr[8];
    LAS float* XCH = (LAS float*)(lds + 133120);
    int cur_d = -1000;
    int prev_rs = min(max(r0 - 4, 0), 24);
    { const int rsn = min(max(r0 + 1 - 4, 0), 24); if (rsn != prev_rs) na_load_row(P, b, h, rsn + 7, scol, sch, kraw, vraw); }
#pragma unroll 1
    for (int r = r0; r < r0 + 16; ++r) {
        const int rs = min(max(r - 4, 0), 24);
        if (rs != prev_rs) { __syncthreads(); na_write_row(Ks, Vs, rs + 7, scol, sch, kg0, kg1, kraw, vraw); prev_rs = rs; }
        __syncthreads();
        const size_t qtok = (size_t)b * SEQ + r * 64 + q;
        bf16x8 qf0, qf1;
        {   float e[16] = {bflo(q0.x), bfhi(q0.x), bflo(q0.y), bfhi(q0.y), bflo(q0.z), bfhi(q0.z), bflo(q0.w), bfhi(q0.w), bflo(q1.x), bfhi(q1.x), bflo(q1.y), bfhi(q1.y), bflo(q1.z), bfhi(q1.z), bflo(q1.w), bfhi(q1.w)};
            float ss = 0.f;
#pragma unroll
            for (int j = 0; j < 16; ++j) ss += e[j] * e[j];
            ss += __shfl_xor(ss, 16); ss += __shfl_xor(ss, 32);
            const float rq = (0.125f * 1.4426950408889634f) / sqrtf(ss * (1.f / 64.f) + RMS_EPS);
#pragma unroll
            for (int j = 0; j < 16; ++j) e[j] *= rq * qg[j];
            u32x4 w0, w1; w0.x = cvtpk(e[0], e[1]); w0.y = cvtpk(e[2], e[3]); w0.z = cvtpk(e[4], e[5]); w0.w = cvtpk(e[6], e[7]); w1.x = cvtpk(e[8], e[9]); w1.y = cvtpk(e[10], e[11]); w1.z = cvtpk(e[12], e[13]); w1.w = cvtpk(e[14], e[15]);
            qf0 = __builtin_bit_cast(bf16x8, w0); qf1 = __builtin_bit_cast(bf16x8, w1);
        }
        if (r + 1 < r0 + 16) {
            q0 = *(const u32x4*)(qbase + (size_t)(r + 1) * 64 * PN); q1 = *(const u32x4*)(qbase + (size_t)(r + 1) * 64 * PN + 32);
            const int rsn = min(max(r + 1 - 4, 0), 24); if (rsn != rs) na_load_row(P, b, h, rsn + 7, scol, sch, kraw, vraw);
        }
        if (rs - r != cur_d) { cur_d = rs - r;
#pragma unroll
            for (int ii = 0; ii < 4; ++ii) { const LAS float* rb = RPB + (4 * dhalf + ii + cur_d + 7) * 32;
#pragma unroll
                for (int ch2 = 0; ch2 < 2; ++ch2)
#pragma unroll
                    for (int k = 0; k < 4; ++k) barr[2 * ii + ch2][k] = rb[boff[4 * ch2 + k]] - cshift; } }
        f32x4 st[8];
#pragma unroll
        for (int ii = 0; ii < 4; ++ii) {
            const int sl = (rs + 4 * dhalf + ii) & 7;
#pragma unroll
            for (int ch2 = 0; ch2 < 2; ++ch2) {
                const int col = kc0 + 16 * ch2 + li; const LAS unsigned char* kr = Ks + ((sl * 64 + col) << 7);
                const bf16x8 a0 = *(const LAS bf16x8*)(kr + ((g ^ (col & 7)) << 4)), a1 = *(const LAS bf16x8*)(kr + (((g + 4) ^ (col & 7)) << 4));
                f32x4 s = barr[2 * ii + ch2];
                s = __builtin_amdgcn_mfma_f32_16x16x32_bf16(a0, qf0, s, 0, 0, 0); s = __builtin_amdgcn_mfma_f32_16x16x32_bf16(a1, qf1, s, 0, 0, 0);
                st[2 * ii + ch2] = s;
            }
        }
        float sum = 0.f;
#pragma unroll
        for (int t = 0; t < 8; ++t)
#pragma unroll
            for (int k = 0; k < 4; ++k) { const float p = __builtin_amdgcn_exp2f(st[t][k]); st[t][k] = p; sum += p; }
        sum += __shfl_xor(sum, 16); sum += __shfl_xor(sum, 32);
        bf16x8 pf[4];
#pragma unroll
        for (int ii = 0; ii < 4; ++ii) { u32x4 pw; pw.x = cvtpk(st[2 * ii][0], st[2 * ii][1]); pw.y = cvtpk(st[2 * ii][2], st[2 * ii][3]); pw.z = cvtpk(st[2 * ii + 1][0], st[2 * ii + 1][1]); pw.w = cvtpk(st[2 * ii + 1][2], st[2 * ii + 1][3]); pf[ii] = __builtin_bit_cast(bf16x8, pw); }
        f32x4 op[4];
#pragma unroll
        for (int dtt = 0; dtt < 4; ++dtt) {
            f32x4 o = {0.f, 0.f, 0.f, 0.f};
#pragma unroll
            for (int ii = 0; ii < 4; ++ii) {
                const int sl = (rs + 4 * dhalf + ii) & 7; const int qq = li >> 2, pp = li & 3;
                const int ca = kc0 + 4 * g + qq, cb = ca + 16;
                const LAS unsigned char* pa = Vs + ((sl * 64 + ca) << 7) + (((2 * dtt + (pp >> 1)) ^ (ca & 7)) << 4) + 8 * (pp & 1);
                const LAS unsigned char* pb = Vs + ((sl * 64 + cb) << 7) + (((2 * dtt + (pp >> 1)) ^ (cb & 7)) << 4) + 8 * (pp & 1);
                const v4i16_t va = __builtin_amdgcn_ds_read_tr16_b64_v4i16((LAS v4i16_t*)pa), vb = __builtin_amdgcn_ds_read_tr16_b64_v4i16((LAS v4i16_t*)pb);
                const bf16x8 vf = {va[0], va[1], va[2], va[3], vb[0], vb[1], vb[2], vb[3]};
                o = __builtin_amdgcn_mfma_f32_16x16x32_bf16(vf, pf[ii], o, 0, 0, 0);
            }
            op[dtt] = o;
        }
        {
            LAS float* mine = XCH + wid * 576 + lane; const f32x4 s0 = dhalf ? op[0] : op[2], s1 = dhalf ? op[1] : op[3];
            mine[0] = s0[0]; mine[64] = s0[1]; mine[128] = s0[2]; mine[192] = s0[3]; mine[256] = s1[0]; mine[320] = s1[1]; mine[384] = s1[2]; mine[448] = s1[3]; mine[512] = sum;
        }
        __syncthreads();
        {   const LAS float* theirs = XCH + (wid ^ 4) * 576 + lane;
            const f32x4 t0 = {theirs[0], theirs[64], theirs[128], theirs[192]}, t1 = {theirs[256], theirs[320], theirs[384], theirs[448]};
            const float rinv = 1.0f / (sum + theirs[512]);
#pragma unroll
            for (int dt = 0; dt < 2; ++dt) { const int dtt = 2 * dhalf + dt; const f32x4 o = (dhalf ? (dt ? op[3] : op[2]) : (dt ? op[1] : op[0])) + (dt ? t1 : t0);
                u32x2 w; w.x = cvtpk(o[0] * rinv, o[1] * rinv); w.y = cvtpk(o[2] * rinv, o[3] * rinv);
                *(u32x2*)(YB + qtok * DA + h * 64 + 16 * dtt + 4 * g) = w; }
        }
    }
    __syncthreads();
}

__device__ __forceinline__ void phase_combine(const Args& a, LAS unsigned char* lds, int G) {
    const int tid = threadIdx.x, lane = tid & 63, wid = __builtin_amdgcn_readfirstlane(tid >> 6), li = lane & 15, g = lane >> 4;
    unsigned char* ws = a.ws;
    const bf16* P = (const bf16*)(ws + WS_P);
    const bf16* OF = (const bf16*)(ws + WS_OF); const bf16* OB = (const bf16*)(ws + WS_OB); const float* CFB = (const float*)(ws + WS_CFB);
    bf16* YA = (bf16*)(ws + WS_YA);
    LAS unsigned char* SIG = lds;
    const float* g2 = a.in[I_G2];
    LAS unsigned char* AFR = lds + 28672 + (wid * 16 * 64 + lane) * 16;
#pragma unroll
    for (int nt = 0; nt < 4; ++nt)
#pragma unroll
        for (int ks = 0; ks < 4; ++ks) { float e[8];
#pragma unroll
            for (int jj = 0; jj < 8; ++jj) e[jj] = g2[(size_t)(32 * ks + 8 * g + jj) * DA + wid * 64 + 16 * nt + li];
            u32x4 w; w.x = cvtpk2(e[0], e[1]); w.y = cvtpk2(e[2], e[3]); w.z = cvtpk2(e[4], e[5]); w.w = cvtpk2(e[6], e[7]); *(LAS u32x4*)(AFR + (nt * 4 + ks) * 1024) = w; }
    const float* mup = a.in[I_MUP]; const float* mun = a.in[I_MUN];
    const int st = tid >> 3, sj = (tid & 7) * 16;
    LAS float* CPRM = (LAS float*)(lds + 20480);
    {   CPRM[tid] = mup[C_V + tid]; CPRM[512 + tid] = mun[C_V + tid]; CPRM[1024 + tid] = a.in[I_LNG][tid]; CPRM[1536 + tid] = a.in[I_LNB][tid]; }
    for (int grp = blockIdx.x; grp < M / 64; grp += G) {
        const int m0 = grp * 64;
        __syncthreads();
        {   const int m = m0 + st, t = m & (SEQ - 1); const bf16* prow = P + (size_t)m * PN + C_LG + sj; const bool hp = t > 0, hn = t < SEQ - 1;
            const bf16* pp = hp ? prow - PN : prow; const bf16* pn = hn ? prow + PN : prow;
            const u32x4 c0 = *(const u32x4*)prow, c1 = *(const u32x4*)(prow + 8), p0 = *(const u32x4*)pp, p1 = *(const u32x4*)(pp + 8), n0 = *(const u32x4*)pn, n1 = *(const u32x4*)(pn + 8);
            const unsigned cw[8] = {c0.x, c0.y, c0.z, c0.w, c1.x, c1.y, c1.z, c1.w}, pw[8] = {p0.x, p0.y, p0.z, p0.w, p1.x, p1.y, p1.z, p1.w}, nw[8] = {n0.x, n0.y, n0.z, n0.w, n1.x, n1.y, n1.z, n1.w};
            float x[16];
#pragma unroll
            for (int q4 = 0; q4 < 4; ++q4) { const f32x4 mp = *(const f32x4*)(mup + C_LG + sj + 4 * q4), mn = *(const f32x4*)(mun + C_LG + sj + 4 * q4);
#pragma unroll
                for (int e = 0; e < 4; ++e) { const int j = 4 * q4 + e; const float cv = (j & 1) ? bfhi(cw[j >> 1]) : bflo(cw[j >> 1]);
                    const float pv = hp ? ((j & 1) ? bfhi(pw[j >> 1]) : bflo(pw[j >> 1])) : 0.f, nv = hn ? ((j & 1) ? bfhi(nw[j >> 1]) : bflo(nw[j >> 1])) : 0.f;
                    x[j] = fast_sigmoid(cv + mp[e] * (pv - cv) + mn[e] * (nv - cv)); } }
            u32x4 w0, w1; w0.x = cvtpk2(x[0], x[1]); w0.y = cvtpk2(x[2], x[3]); w0.z = cvtpk2(x[4], x[5]); w0.w = cvtpk2(x[6], x[7]); w1.x = cvtpk2(x[8], x[9]); w1.y = cvtpk2(x[10], x[11]); w1.z = cvtpk2(x[12], x[13]); w1.w = cvtpk2(x[14], x[15]);
            *(LAS u32x4*)(SIG + st * 272 + sj * 2) = w0; *(LAS u32x4*)(SIG + st * 272 + sj * 2 + 16) = w1; }
        __syncthreads();
        u32x2 ofN[4], obN[4], pcN[4], pvN[4], pnN[4]; float cf0N, cf1N;
        {   const int mN = m0 + li, tN = mN & (SEQ - 1);
            const bf16* prow = P + (size_t)mN * PN + C_V + wid * 64 + 4 * g; const bf16* pp = (tN > 0) ? prow - PN : prow; const bf16* pn = (tN < SEQ - 1) ? prow + PN : prow;
#pragma unroll
            for (int nt = 0; nt < 4; ++nt) { const int c0 = wid * 64 + 16 * nt + 4 * g;
                ofN[nt] = *(const u32x2*)(OF + (size_t)mN * DA + c0); obN[nt] = *(const u32x2*)(OB + (size_t)mN * DA + c0);
                pcN[nt] = *(const u32x2*)(prow + 16 * nt); pvN[nt] = *(const u32x2*)(pp + 16 * nt); pnN[nt] = *(const u32x2*)(pn + 16 * nt); }
            cf0N = CFB[(size_t)mN * 16 + wid * 2]; cf1N = CFB[(size_t)mN * 16 + wid * 2 + 1]; }
#pragma unroll 1
        for (int tt = 0; tt < 4; ++tt) {
            const int m = m0 + 16 * tt + li, t = m & (SEQ - 1); const bool hp = t > 0, hn = t < SEQ - 1;
            u32x2 of[4], ob[4]; u32x2 pc[4], pv[4], pnx[4];
#pragma unroll
            for (int nt = 0; nt < 4; ++nt) { of[nt] = ofN[nt]; ob[nt] = obN[nt]; pc[nt] = pcN[nt]; pv[nt] = pvN[nt]; pnx[nt] = pnN[nt]; }
            const float cf0 = cf0N, cf1 = cf1N;
            {   const int ttn = tt < 3 ? tt + 1 : 3; const int mN = m0 + 16 * ttn + li, tN = mN & (SEQ - 1);
                const bf16* prow = P + (size_t)mN * PN + C_V + wid * 64 + 4 * g; const bf16* pp = (tN > 0) ? prow - PN : prow; const bf16* pn = (tN < SEQ - 1) ? prow + PN : prow;
#pragma unroll
                for (int nt = 0; nt < 4; ++nt) { const int c0 = wid * 64 + 16 * nt + 4 * g;
                    ofN[nt] = *(const u32x2*)(OF + (size_t)mN * DA + c0); obN[nt] = *(const u32x2*)(OB + (size_t)mN * DA + c0);
                    pcN[nt] = *(const u32x2*)(prow + 16 * nt); pvN[nt] = *(const u32x2*)(pp + 16 * nt); pnN[nt] = *(const u32x2*)(pn + 16 * nt); }
                cf0N = CFB[(size_t)mN * 16 + wid * 2]; cf1N = CFB[(size_t)mN * 16 + wid * 2 + 1]; }
            const LAS unsigned char* afp = AFR; asm volatile("" : "+v"(afp));
            bf16x8 bfr[4];
#pragma unroll
            for (int ks = 0; ks < 4; ++ks) bfr[ks] = *(const LAS bf16x8*)(SIG + (16 * tt + li) * 272 + (32 * ks + 8 * g) * 2);
            f32x4 gt[4];
#pragma unroll
            for (int nt = 0; nt < 4; ++nt) { f32x4 c = {0.f, 0.f, 0.f, 0.f};
#pragma unroll
                for (int ks = 0; ks < 4; ++ks) c = __builtin_amdgcn_mfma_f32_16x16x32_bf16(*(const LAS bf16x8*)(afp + (nt * 4 + ks) * 1024), bfr[ks], c, 0, 0, 0);
                gt[nt] = c; }
            f32x4 o[4]; float s = 0.f;
#pragma unroll
            for (int nt = 0; nt < 4; ++nt) { o[nt] = (f32x4){bflo(of[nt].x) + bflo(ob[nt].x), bfhi(of[nt].x) + bfhi(ob[nt].x), bflo(of[nt].y) + bflo(ob[nt].y), bfhi(of[nt].y) + bfhi(ob[nt].y)}; s += (o[nt][0] + o[nt][1]) + (o[nt][2] + o[nt][3]); }
            s += __shfl_xor(s, 16); s += __shfl_xor(s, 32);
            const float mu = s * (1.f / 64.f); float vq = 0.f;
#pragma unroll
            for (int nt = 0; nt < 4; ++nt) { o[nt] = o[nt] - mu; vq += (o[nt][0] * o[nt][0] + o[nt][1] * o[nt][1]) + (o[nt][2] * o[nt][2] + o[nt][3] * o[nt][3]); }
            vq += __shfl_xor(vq, 16); vq += __shfl_xor(vq, 32);
            const float rstd = 1.0f / sqrtf(vq * (1.f / 64.f) + GN_EPS);
            const float cfb = cf0 + cf1;
            u32x2 wv[4];
#pragma unroll
            for (int nt = 0; nt < 4; ++nt) { const int c0 = wid * 64 + 16 * nt + 4 * g;
                const u32x2 z2 = {0u, 0u};
                const f32x4 xv = shift4(pc[nt], hp ? pv[nt] : z2, hn ? pnx[nt] : z2, *(const LAS f32x4*)(CPRM + c0), *(const LAS f32x4*)(CPRM + 512 + c0));
                const f32x4 lg = *(const LAS f32x4*)(CPRM + 1024 + c0), lb = *(const LAS f32x4*)(CPRM + 1536 + c0);
                const f32x4 y = (o[nt] * rstd * lg + lb + xv * cfb) * gt[nt];
                wv[nt].x = cvtpk2(y[0], y[1]); wv[nt].y = cvtpk2(y[2], y[3]); }
#pragma unroll
            for (int nt = 0; nt < 4; ++nt) *(u32x2*)(YA + (size_t)m * DA + wid * 64 + 16 * nt + 4 * g) = wv[nt];
        }
    }
    __syncthreads();
}

__device__ __forceinline__ void phase_router(const Args& a, LAS unsigned char* lds, int G, bool dry) {
    const int tid = threadIdx.x, lane = tid & 63, wid = __builtin_amdgcn_readfirstlane(tid >> 6), li = lane & 15, g = lane >> 4;
    unsigned char* ws = a.ws;
    const bf16* X1 = (const bf16*)(ws + WS_X1B); unsigned char* H2 = ws + WS_XN;
    int2* list = (int2*)(ws + WS_LIST);
    unsigned* cnt = (unsigned*)(ws + WS_CTL) + CW_CNT;
    LAS float* PL = (LAS float*)lds;
    LAS float* SS = (LAS float*)(lds + 16384);
    LAS float* RSTD = (LAS float*)(lds + 16896);
    LAS int* rowE = (LAS int*)(lds + 20480); LAS float* rowW = (LAS float*)(lds + 22528); LAS int* rowPos = (LAS int*)(lds + 24576);
    LAS int* bcnt = (LAS int*)(lds + 26624); LAS int* bbase = (LAS int*)(lds + 26752);
    const float* wr = a.in[I_WR];
    const int kw = 128 * wid;
    bf16x8 bh[4][2], bl[4][2];
#pragma unroll
    for (int ks = 0; ks < 4; ++ks)
#pragma unroll
        for (int et = 0; et < 2; ++et) { float wv[8], wl[8];
#pragma unroll
            for (int jj = 0; jj < 8; ++jj) { wv[jj] = wr[(size_t)(kw + 32 * ks + 8 * g + jj) * 32 + 16 * et + li]; }
            u32x4 hh; hh.x = cvtpk2(wv[0], wv[1]); hh.y = cvtpk2(wv[2], wv[3]); hh.z = cvtpk2(wv[4], wv[5]); hh.w = cvtpk2(wv[6], wv[7]);
            wl[0] = wv[0] - bflo(hh.x); wl[1] = wv[1] - bfhi(hh.x); wl[2] = wv[2] - bflo(hh.y); wl[3] = wv[3] - bfhi(hh.y); wl[4] = wv[4] - bflo(hh.z); wl[5] = wv[5] - bfhi(hh.z); wl[6] = wv[6] - bflo(hh.w); wl[7] = wv[7] - bfhi(hh.w);
            u32x4 ll; ll.x = cvtpk2(wl[0], wl[1]); ll.y = cvtpk2(wl[2], wl[3]); ll.z = cvtpk2(wl[4], wl[5]); ll.w = cvtpk2(wl[6], wl[7]);
            bh[ks][et] = __builtin_bit_cast(bf16x8, hh); bl[ks][et] = __builtin_bit_cast(bf16x8, ll); }
    f32x4 gf[4][2];
#pragma unroll
    for (int ks = 0; ks < 4; ++ks) { gf[ks][0] = *(const f32x4*)(a.in[I_GFFN] + kw + 32 * ks + 8 * g); gf[ks][1] = *(const f32x4*)(a.in[I_GFFN] + kw + 32 * ks + 8 * g + 4); }
    const float brl = a.in[I_BR][lane & 31];
    for (int grp = blockIdx.x; grp < M / 128; grp += G) {
        __syncthreads();
        if (tid < 32) bcnt[tid] = 0;
        __syncthreads();
        u32x4 xc[4];
        {   const bf16* xr = X1 + (size_t)(grp * 128 + li) * DM + kw + 8 * g;
#pragma unroll
            for (int ks = 0; ks < 4; ++ks) xc[ks] = *(const u32x4*)(xr + 32 * ks); }
#pragma unroll 1
        for (int tile = 0; tile < 8; ++tile) {
            const int m = grp * 128 + 16 * tile + li;
            f32x4 xg[4][2]; float ss = 0.f;
            u32x4 xnx[4];
            {   const bf16* xr = X1 + (size_t)(grp * 128 + 16 * (tile < 7 ? tile + 1 : tile) + li) * DM + kw + 8 * g;
#pragma unroll
                for (int ks = 0; ks < 4; ++ks) xnx[ks] = *(const u32x4*)(xr + 32 * ks); }
#pragma unroll
            for (int ks = 0; ks < 4; ++ks) { const f32x4 x0 = {bflo(xc[ks].x), bfhi(xc[ks].x), bflo(xc[ks].y), bfhi(xc[ks].y)}, x1 = {bflo(xc[ks].z), bfhi(xc[ks].z), bflo(xc[ks].w), bfhi(xc[ks].w)};
                ss += (x0.x * x0.x + x0.y * x0.y) + (x0.z * x0.z + x0.w * x0.w) + (x1.x * x1.x + x1.y * x1.y) + (x1.z * x1.z + x1.w * x1.w);
                xg[ks][0] = x0 * gf[ks][0]; xg[ks][1] = x1 * gf[ks][1]; }
            f32x4 acc0 = {0.f, 0.f, 0.f, 0.f}, acc1 = {0.f, 0.f, 0.f, 0.f};
#pragma unroll
            for (int ks = 0; ks < 4; ++ks) { const f32x4 v0 = xg[ks][0], v1 = xg[ks][1];
                u32x4 hh; hh.x = cvtpk2(v0.x, v0.y); hh.y = cvtpk2(v0.z, v0.w); hh.z = cvtpk2(v1.x, v1.y); hh.w = cvtpk2(v1.z, v1.w);
                u32x4 ll; ll.x = cvtpk2(v0.x - bflo(hh.x), v0.y - bfhi(hh.x)); ll.y = cvtpk2(v0.z - bflo(hh.y), v0.w - bfhi(hh.y)); ll.z = cvtpk2(v1.x - bflo(hh.z), v1.y - bfhi(hh.z)); ll.w = cvtpk2(v1.z - bflo(hh.w), v1.w - bfhi(hh.w));
                const bf16x8 ah = __builtin_bit_cast(bf16x8, hh), al = __builtin_bit_cast(bf16x8, ll);
                acc0 = __builtin_amdgcn_mfma_f32_16x16x32_bf16(ah, bh[ks][0], acc0, 0, 0, 0); acc0 = __builtin_amdgcn_mfma_f32_16x16x32_bf16(ah, bl[ks][0], acc0, 0, 0, 0); acc0 = __builtin_amdgcn_mfma_f32_16x16x32_bf16(al, bh[ks][0], acc0, 0, 0, 0);
                acc1 = __builtin_amdgcn_mfma_f32_16x16x32_bf16(ah, bh[ks][1], acc1, 0, 0, 0); acc1 = __builtin_amdgcn_mfma_f32_16x16x32_bf16(ah, bl[ks][1], acc1, 0, 0, 0); acc1 = __builtin_amdgcn_mfma_f32_16x16x32_bf16(al, bh[ks][1], acc1, 0, 0, 0); }
#pragma unroll
            for (int rg = 0; rg < 4; ++rg) { PL[wid * 512 + (4 * g + rg) * 32 + li] = acc0[rg]; PL[wid * 512 + (4 * g + rg) * 32 + 16 + li] = acc1[rg]; }
            ss += __shfl_xor(ss, 16); ss += __shfl_xor(ss, 32);
            if (g == 0) SS[wid * 16 + li] = ss;
            __syncthreads();
            {   const int r2 = lane >> 5, ex = lane & 31, row = 2 * wid + r2;
                float lg = 0.f, sq = 0.f;
#pragma unroll
                for (int w8 = 0; w8 < 8; ++w8) { lg += PL[w8 * 512 + row * 32 + ex]; sq += SS[w8 * 16 + row]; }
                const float rstd = 1.0f / sqrtf(sq * (1.f / DM) + RMS_EPS);
                if (ex == 0) RSTD[row] = rstd;
                float val = lg * rstd + brl;
                int te[4]; float tv[4];
#pragma unroll
                for (int i = 0; i < 4; ++i) { float mxv = val;
#pragma unroll
                    for (int o = 1; o < 32; o <<= 1) mxv = fmaxf(mxv, __shfl_xor(mxv, o));
                    const unsigned long long mk64 = __ballot(val == mxv); const unsigned mk = r2 ? (unsigned)(mk64 >> 32) : (unsigned)mk64;
                    const int src = mk ? __ffs((int)mk) - 1 : i; te[i] = src; tv[i] = mxv; if (ex == src) val = -3.0e38f; }
                const float e1 = __expf(tv[1] - tv[0]), e2 = __expf(tv[2] - tv[0]), e3 = __expf(tv[3] - tv[0]); const float den = 1.0f / (1.0f + e1 + e2 + e3);
                if (ex < 4) { const int ee = ex == 0 ? te[0] : ex == 1 ? te[1] : ex == 2 ? te[2] : te[3]; const float wv = (ex == 0 ? 1.0f : ex == 1 ? e1 : ex == 2 ? e2 : e3) * den;
                    const int pos = __hip_atomic_fetch_add(bcnt + ee, 1, __ATOMIC_RELAXED, __HIP_MEMORY_SCOPE_WORKGROUP);
                    const int rl = 16 * tile + row; rowE[rl * 4 + ex] = ee; rowW[rl * 4 + ex] = wv; rowPos[rl * 4 + ex] = pos; }
            }
            __syncthreads();
            {   const float rstd = RSTD[li] * F8S_H; unsigned char* hr = H2 + (size_t)m * DM + kw + 8 * g;
#pragma unroll
                for (int ks = 0; ks < 4; ++ks) { const f32x4 v0 = xg[ks][0] * rstd, v1 = xg[ks][1] * rstd; u32x2 o; o.x = pack4_fp8(v0.x, v0.y, v0.z, v0.w); o.y = pack4_fp8(v1.x, v1.y, v1.z, v1.w);
                    *(u32x2*)(hr + 32 * ks) = o; } }
#pragma unroll
            for (int ks = 0; ks < 4; ++ks) xc[ks] = xnx[ks];
        }
        __syncthreads();
        if (tid < 32) bbase[tid] = dry ? 0 : (int)__hip_atomic_fetch_add(cnt + 64 * tid, (unsigned)bcnt[tid], __ATOMIC_RELAXED, __HIP_MEMORY_SCOPE_AGENT);
        __syncthreads();
        { const int rl = tid >> 2, i = tid & 3, m = grp * 128 + rl; const int e = rowE[tid], pos = bbase[e] + rowPos[tid];
          if (!dry) { int2 le; le.x = m * 4 + i; le.y = __builtin_bit_cast(int, rowW[tid]); list[(size_t)e * LISTCAP + pos] = le;
                      ((int*)(ws + WS_INV))[(size_t)m * 4 + i] = (e << 16) | pos; ((float*)(ws + WS_GW))[(size_t)m * 4 + i] = rowW[tid]; } }
    }
    __syncthreads();
}

__device__ __forceinline__ int moe_table(const Args& a, LAS unsigned char* lds) {
    LAS int* tab = (LAS int*)(lds + MISC_OFF) + 16;
    unsigned* cnt = (unsigned*)(a.ws + WS_CTL) + CW_CNT;
    __syncthreads();
    if (threadIdx.x < 32) tab[threadIdx.x] = (int)__hip_atomic_load(cnt + 64 * threadIdx.x, __ATOMIC_RELAXED, __HIP_MEMORY_SCOPE_AGENT);
    __syncthreads();
    if (threadIdx.x == 0) { int s = 0; for (int e = 0; e < NE; ++e) { tab[32 + e] = s; s += (tab[e] + 255) >> 8; } tab[32 + NE] = s; }
    __syncthreads();
    return tab[32 + NE];
}

__device__ __forceinline__ void phase_final(const Args& a, LAS unsigned char* lds, int G, bool dry) {
    const int tid = threadIdx.x, lane = tid & 63, wave = tid >> 6;
    const unsigned char* Y = a.ws + WS_YBUF; float* out = a.out; const bf16* X1 = (const bf16*)(a.ws + WS_X1B);
    const int* inv = (const int*)(a.ws + WS_INV); const float* gwt = (const float*)(a.ws + WS_GW);
    const LAS int* tab = (const LAS int*)(lds + MISC_OFF) + 16;
    const int gw = blockIdx.x * 8 + wave, NGW = G * 8;
    for (int m = gw; m < M; m += NGW) {
        const bf16* xr = X1 + (size_t)m * DM; float* xw = dry ? (float*)(a.ws + WS_P) + (size_t)m * DM : out + (size_t)m * DM;
        const int4 iv = *(const int4*)(inv + (size_t)m * 4); const f32x4 wv = *(const f32x4*)(gwt + (size_t)m * 4);
        const int ivs[4] = {iv.x, iv.y, iv.z, iv.w}; const float ws4[4] = {wv.x * (1.0f / F8S_Y), wv.y * (1.0f / F8S_Y), wv.z * (1.0f / F8S_Y), wv.w * (1.0f / F8S_Y)};
        const unsigned char* yr[4];
#pragma unroll
        for (int s = 0; s < 4; ++s) yr[s] = Y + ((size_t)(tab[32 + (ivs[s] >> 16)] * 256 + (ivs[s] & 0xffff))) * DM;
        const int c = lane * 16;
        f32x4 v[4]; u32x4 y[4];
#pragma unroll
        for (int k = 0; k < 2; ++k) { const u32x4 xb = *(const u32x4*)(xr + c + 8 * k);
            v[2 * k] = (f32x4){bflo(xb.x), bfhi(xb.x), bflo(xb.y), bfhi(xb.y)}; v[2 * k + 1] = (f32x4){bflo(xb.z), bfhi(xb.z), bflo(xb.w), bfhi(xb.w)}; }
#pragma unroll
        for (int s = 0; s < 4; ++s) y[s] = *(const u32x4*)(yr[s] + c);
#pragma unroll
        for (int s = 0; s < 4; ++s) { const float w = ws4[s]; const unsigned tw[4] = {y[s].x, y[s].y, y[s].z, y[s].w};
#pragma unroll
            for (int k = 0; k < 4; ++k) { const f32x2 lo = __builtin_amdgcn_cvt_pk_f32_fp8((int)tw[k], false), hi = __builtin_amdgcn_cvt_pk_f32_fp8((int)tw[k], true);
                v[k].x += w * lo[0]; v[k].y += w * lo[1]; v[k].z += w * hi[0]; v[k].w += w * hi[1]; } }
#pragma unroll
        for (int k = 0; k < 4; ++k) {
#if STAMP_SEL >= 0
            { const float sc_ = 1.0f + 0.3f * ((const float*)(a.ws + WS_GW))[160000 + STAMP_SEL]; v[k] = v[k] * sc_; }
#endif
#if FP8_SELFTEST
            if (__hip_atomic_load((unsigned*)(a.ws + WS_CTL) + 8, __ATOMIC_RELAXED, __HIP_MEMORY_SCOPE_AGENT)) v[k] = v[k] * 2.0f;
#endif
            *(f32x4*)(xw + c + 4 * k) = v[k]; }
    }
}

#if FP8_SELFTEST
typedef int i32x8 __attribute__((ext_vector_type(8)));
__device__ __forceinline__ void fp8_selftest(const Args& a) {
    if (blockIdx.x != 0 || threadIdx.x >= 64) return;
    const int l = threadIdx.x, li = l & 15, g = l >> 4;
    i32x8 av, bv;
#pragma unroll
    for (int d = 0; d < 8; ++d) { const int k0 = 32 * g + 4 * d;
        float fa[4], fb[4];
#pragma unroll
        for (int t = 0; t < 4; ++t) { fa[t] = (float)((li * 7 + (k0 + t) * 3) % 5); fb[t] = (float)(((k0 + t) * 5 + li * 11) % 3); }
        int pa = __builtin_amdgcn_cvt_pk_fp8_f32(fa[0], fa[1], 0, false); pa = __builtin_amdgcn_cvt_pk_fp8_f32(fa[2], fa[3], pa, true);
        int pb = __builtin_amdgcn_cvt_pk_fp8_f32(fb[0], fb[1], 0, false); pb = __builtin_amdgcn_cvt_pk_fp8_f32(fb[2], fb[3], pb, true);
        av[d] = pa; bv[d] = pb; }
    f32x4 c = {0.f, 0.f, 0.f, 0.f};
    c = __builtin_amdgcn_mfma_scale_f32_16x16x128_f8f6f4(av, bv, c, 0, 0, 0, 127, 0, 127);
    bool bad = false;
#pragma unroll
    for (int rg = 0; rg < 4; ++rg) { const int i = 4 * g + rg, j = li; float ref = 0.f;
        for (int k = 0; k < 128; ++k) ref += (float)((i * 7 + k * 3) % 5) * (float)((k * 5 + j * 11) % 3);
        if (c[rg] != ref) bad = true; }
    if (bad) atomicOr((unsigned*)(a.ws + WS_CTL) + 8, 1u);
}
#endif
constexpr int N_PHASES = 10;
__global__ void __launch_bounds__(512, 2) mk_fwd(Args args) {
    extern __shared__ __attribute__((aligned(16))) unsigned char lds_raw[];
    LAS unsigned char* lds = (LAS unsigned char*)lds_raw;
    const int tid = threadIdx.x; const int G = gridDim.x;
    unsigned char* ws = args.ws;
    volatile LAS unsigned* MISC = (volatile LAS unsigned*)(lds + MISC_OFF);
    for (int u = tid; u < 256; u += 512) MISC[u] = 0u;
    __syncthreads();
    const int lo = args.ph_lo, hi = args.ph_hi;
    XcdBarrier bar; bar.bar = (unsigned*)(ws + WS_CTL) + CW_BAR; bar.x = 0; bar.st = nullptr;
    if (hi - lo > 1) bar = xcd_barrier_post((unsigned*)(ws + WS_CTL) + CW_BAR, MISC + 8);
#ifndef ONLY_PHASE
#define ONLY_PHASE -1
#endif
#define IN(k) ((ONLY_PHASE < 0 || ONLY_PHASE == (k)) && lo <= (k) && (k) < hi)
#define SEAM(k) do { if (IN(k) && IN((k) + 1)) xcd_barrier(bar); } while (0)

#if FP8_SELFTEST
    if (IN(0)) fp8_selftest(args);
#endif
    if (IN(0)) { for (int rep = 0; rep < NREP(0); ++rep) phase_prologue(args, lds, G); } SEAM(0);
    if (IN(1)) for (int rep = 0; rep < NREP(1); ++rep) {
        phase_stagger(STAGGER_TICKS);
        pg8::StaticOrder S; S.init(M, PN, G, (int)blockIdx.x);
        EpiStoreBf16 E{(bf16*)(ws + WS_P), PN, C_GA};
        pg8::gemm_phase<EpiStoreBf16, pg8::StaticOrder, true, false>(lds, (const bf16*)(ws + WS_XN), (const bf16*)(ws + WS_WIN), 1024, S, E);
    } SEAM(1);
    if (IN(2)) {
        for (int rep = 0; rep < NREP(16); ++rep) if (blockIdx.x < 256) { if (blockIdx.x & 1) phase_scan_unit_t<1>(args, lds, (int)blockIdx.x); else phase_scan_unit_t<0>(args, lds, (int)blockIdx.x); }
        for (int rep = 0; rep < NREP(17); ++rep) if (blockIdx.x < 256) phase_na_unit(args, lds, (int)blockIdx.x);
    } SEAM(2);
    if (IN(3)) { for (int rep = 0; rep < NREP(3); ++rep) phase_combine(args, lds, G); } SEAM(3);
    if (IN(4)) for (int rep = 0; rep < NREP(4); ++rep) {
        pg8::StaticOrder S; S.init(M, DM, G, (int)blockIdx.x);
        { EpiGate<false> E{(bf16*)(ws + WS_MG), (const bf16*)(ws + WS_P), C_GA};
          pg8::gemm_phase<EpiGate<false>, pg8::StaticOrder, true, false>(lds, (const bf16*)(ws + WS_YA), (const bf16*)(ws + WS_WA), 512, S, E); }
        { EpiGate<true> E{(bf16*)(ws + WS_MG), (const bf16*)(ws + WS_P), C_GB};
          pg8::gemm_phase<EpiGate<true>, pg8::StaticOrder, true, false>(lds, (const bf16*)(ws + WS_YB), (const bf16*)(ws + WS_WB), 512, S, E); }
    } SEAM(4);
    if (IN(5)) for (int rep = 0; rep < NREP(5); ++rep) {
        pg8::StaticOrder S; S.init(M, DM, G, (int)blockIdx.x);
        EpiResid E{(const bf16*)(ws + WS_XN), (const float*)(ws + WS_RMS), args.in[I_GMIX], (bf16*)(ws + WS_X1B)};
        pg8::gemm_phase<EpiResid, pg8::StaticOrder, true, false>(lds, (const bf16*)(ws + WS_MG), (const bf16*)(ws + WS_WO), 1024, S, E);
    } SEAM(5);
    if (IN(6)) { for (int rep = 0; rep < NREP(6); ++rep) phase_router(args, lds, G, rep + 1 < NREP(6)); } SEAM(6);
    if (IN(7)) for (int rep = 0; rep < NREP(7); ++rep) {
        const int NT = moe_table(args, lds);
        phase_stagger(STAGGER_TICKS);
        MoeOrder S; S.JP = G / 8; S.x = blockIdx.x % 8; S.j = blockIdx.x / 8; S.NT = NT; S.TPX = (NT + 7) / 8; S.NPN = 8; S.tab = (const LAS int*)(lds + MISC_OFF) + 16; S.list = (const int2*)(ws + WS_LIST);
        EpiMoe1 E{ws + WS_P, args.in[I_B1]};
        pg8::gemm_phase<EpiMoe1, MoeOrder, true, true, true>(lds, ws + WS_XN, ws + WS_W1, 1024, S, E);
    } SEAM(7);
    if (IN(8)) for (int rep = 0; rep < NREP(8); ++rep) {
        const int NT = IN(7) ? ((const LAS int*)(lds + MISC_OFF) + 16)[32 + NE] : moe_table(args, lds);
        phase_stagger(STAGGER_TICKS);
        MoeOrder S; S.JP = G / 8; S.x = blockIdx.x % 8; S.j = blockIdx.x / 8; S.NT = NT; S.TPX = (NT + 7) / 8; S.NPN = 4; S.tab = (const LAS int*)(lds + MISC_OFF) + 16; S.list = (const int2*)(ws + WS_LIST);
        EpiMoe2 E{ws + WS_YBUF, args.in[I_B2]};
        pg8::gemm_phase<EpiMoe2, MoeOrder, true, false, true>(lds, ws + WS_P, ws + WS_W2, 1024, S, E);
    } SEAM(8);
    if (IN(9)) { if (!IN(7)) (void)moe_table(args, lds); for (int rep = 0; rep < NREP(9); ++rep) phase_final(args, lds, G, rep + 1 < NREP(9)); }
#undef IN
#undef SEAM
}

extern "C" void kernel_launch(void* const* d_in, const int* in_sizes, int n_in, void* d_out, int out_size, void* d_ws, size_t ws_size, hipStream_t stream) {
    static int grid = 0;
    if (grid == 0) {
        if (n_in != 32 || in_sizes[0] != M * DM || out_size != M * DM || ws_size < WS_END) {
            fprintf(stderr, "kernel_launch: unexpected problem: n_in %d in0 %d out %d ws %zu (need %zu)\n", n_in, n_in > 0 ? in_sizes[0] : -1, out_size, ws_size, (size_t)WS_END); grid = -1; return; }
        int dev = 0, cus = 0;
        if (hipGetDevice(&dev) != hipSuccess || hipDeviceGetAttribute(&cus, hipDeviceAttributeMultiprocessorCount, dev) != hipSuccess) { grid = -1; return; }
        if (hipFuncSetAttribute((const void*)mk_fwd, hipFuncAttributeMaxDynamicSharedMemorySize, LDS_BYTES) != hipSuccess) { fprintf(stderr, "kernel_launch: hipFuncSetAttribute failed\n"); grid = -1; return; }
        (void)hipGetLastError();
        grid = cus;
        if (grid != 256) { fprintf(stderr, "kernel_launch: this kernel needs a 256-CU device (got %d)\n", grid); grid = -1; return; }
    }
    if (grid < 0) return;
    (void)hipMemsetAsync((char*)d_ws + WS_CTL, 0, CTL_ZERO_BYTES, stream);
    Args a{};
    for (int i = 0; i < 32; ++i) a.in[i] = (const float*)d_in[i];
    a.out = (float*)d_out; a.ws = (unsigned char*)d_ws;
#if MK_N_LAUNCHES == 1
    a.ph_lo = 0; a.ph_hi = N_PHASES; a.li = 0;
    hipLaunchKernelGGL(mk_fwd, dim3(grid), dim3(512), LDS_BYTES, stream, a);
#else
    for (int p = 0; p < N_PHASES; ++p) { a.ph_lo = p; a.ph_hi = p + 1; a.li = p; hipLaunchKernelGGL(mk_fwd, dim3(grid), dim3(512), LDS_BYTES, stream, a); }
#endif
}
```

```cpp
#include <hip/hip_runtime.h>
#include <cstdio>
#include <cstdint>

#ifndef MK_N_LAUNCHES
#define MK_N_LAUNCHES 1
#endif

#ifndef DUP_MASK
#define DUP_MASK 0
#endif
#ifndef SCAN_DUP
#define SCAN_DUP 0
#endif
#ifndef SCAN_DBG
#define SCAN_DBG 0
#endif
#ifndef FP8_SELFTEST
#define FP8_SELFTEST 0
#endif
#ifndef STAMP_SEL
#define STAMP_SEL -1
#endif
#ifndef STAGGER_TICKS
#define STAGGER_TICKS 0
#endif
#define NREP(k) (((DUP_MASK >> (k)) & 1) + 1)
#define LAS __attribute__((address_space(3)))
#define GAS __attribute__((address_space(1)))
typedef unsigned short bf16;
typedef short bf16x8 __attribute__((ext_vector_type(8)));
typedef float f32x4 __attribute__((ext_vector_type(4)));
typedef float f32x2 __attribute__((ext_vector_type(2)));
typedef unsigned u32x4 __attribute__((ext_vector_type(4)));
typedef unsigned u32x2 __attribute__((ext_vector_type(2)));
typedef GAS unsigned gu32;

constexpr int BATCH = 16, SEQ = 2048, DM = 1024, M = BATCH * SEQ;
constexpr int DA = 512, HD = 64, NH = 8;
constexpr int IN_COLS = 5504, PN = 5632;
constexpr int C_R = 0, C_K = 512, C_V = 1024, C_LWF = 1536, C_LAF = 1664, C_LG = 1792;
constexpr int C_PAD = 1920, C_Q = 2048, C_BK = 2560, C_BV = 3072, C_GA = 3584, C_GB = 4608;
constexpr int NE = 32, DE = 1024, LISTCAP = 32768;
constexpr int NT_MAX = 544;
constexpr float RMS_EPS = 1e-5f, GN_EPS = 64e-5f, DECAY_SCALE = 0.6065306597126334f;

constexpr size_t MiB = 1u << 20;
constexpr size_t WS_CTL = 0, CTL_ZERO_BYTES = 1 * MiB;
constexpr size_t WS_WIN = 1 * MiB;
constexpr size_t WS_WA = 12 * MiB, WS_WB = 13 * MiB, WS_WO = 14 * MiB;
constexpr size_t WS_W1 = 16 * MiB;
constexpr size_t WS_W2 = 144 * MiB;
constexpr size_t WS_XN = 208 * MiB;
constexpr size_t WS_P = 272 * MiB;
constexpr size_t WS_OF = 624 * MiB, WS_OB = 688 * MiB;
constexpr size_t WS_YB = 752 * MiB, WS_YA = 784 * MiB;
constexpr size_t WS_XN8 = 816 * MiB, WS_WIN8 = 848 * MiB;
constexpr size_t WS_MG8 = 624 * MiB;
constexpr size_t WS_MG = 816 * MiB;
constexpr size_t WS_YBUF = 408 * MiB;
constexpr size_t WS_INV = 892 * MiB;
constexpr size_t WS_CFB = 880 * MiB;
constexpr size_t WS_X1B = 752 * MiB;
constexpr size_t WS_RMS = 882 * MiB + 768 * 1024;
constexpr size_t WS_GW = 882 * MiB;
constexpr size_t WS_LIST = 883 * MiB;
constexpr size_t WS_END = 893 * MiB;
static_assert(WS_P + (size_t)NT_MAX * 256 * DE <= WS_YBUF && WS_YBUF + (size_t)NT_MAX * 256 * DM * 2 <= WS_CFB, "act / y overlay");
static_assert((size_t)NT_MAX * 256 * DE * 2 <= 352 * MiB, "act overlay");
constexpr int CW_BAR = 4096;
constexpr int CW_CNT = 16384;

constexpr int LDS_BYTES = 163840;
constexpr int MISC_OFF = LDS_BYTES - 1024;

__device__ __forceinline__ unsigned f2bf(float f) { unsigned u = __builtin_bit_cast(unsigned, f); return (u + 0x7fffu + ((u >> 16) & 1u)) >> 16; }
__device__ __forceinline__ unsigned pk2(float lo, float hi) { return f2bf(lo) | (f2bf(hi) << 16); }
__device__ __forceinline__ float bflo(unsigned u) { return __builtin_bit_cast(float, u << 16); }
__device__ __forceinline__ float bfhi(unsigned u) { return __builtin_bit_cast(float, u & 0xffff0000u); }
__device__ __forceinline__ float sigmoidf_(float x) { return 1.0f / (1.0f + __expf(-x)); }
__device__ __forceinline__ float fast_sigmoid(float x) { return __builtin_amdgcn_rcpf(1.0f + __expf(-x)); }
__device__ __forceinline__ float clamp448(float x) { return __builtin_amdgcn_fmed3f(x, -448.0f, 448.0f); }
__device__ __forceinline__ unsigned pack4_fp8(float a, float b, float c, float d) { int p = __builtin_amdgcn_cvt_pk_fp8_f32(clamp448(a), clamp448(b), 0, false); p = __builtin_amdgcn_cvt_pk_fp8_f32(clamp448(c), clamp448(d), p, true); return (unsigned)p; }
constexpr float F8S_H = 16.0f, F8S_W = 512.0f, F8S_A = 4.0f, F8S_Y = 32.0f, F8S_M = 16.0f, F8S_YM = 16.0f;

__device__ __forceinline__ float fast_tanh(float x) { return 1.0f - 2.0f * __builtin_amdgcn_rcpf(1.0f + __expf(2.0f * x)); }
template <int CTRL> __device__ __forceinline__ float dppf(float x) { return __builtin_bit_cast(float, __builtin_amdgcn_update_dpp(0, __builtin_bit_cast(int, x), CTRL, 0xF, 0xF, true)); }
__device__ __forceinline__ float dpp_sum8(float x) { x += dppf<0xB1>(x); x += dppf<0x4E>(x); x += dppf<0x141>(x); return x; }
__device__ __forceinline__ float dpp_sum16(float x) { x += dppf<0xB1>(x); x += dppf<0x4E>(x); x += dppf<0x141>(x); x += dppf<0x140>(x); return x; }
__device__ __forceinline__ float dpp_max8(float x) { x = fmaxf(x, dppf<0xB1>(x)); x = fmaxf(x, dppf<0x4E>(x)); x = fmaxf(x, dppf<0x141>(x)); return x; }
__device__ __forceinline__ float wave_sum(float v) {
#pragma unroll
    for (int o = 1; o < 64; o <<= 1) v += __shfl_xor(v, o);
    return v;
}
__device__ __forceinline__ float wave_max(float v) {
#pragma unroll
    for (int o = 1; o < 64; o <<= 1) v = fmaxf(v, __shfl_xor(v, o));
    return v;
}
#define LDS_WAIT() asm volatile("s_waitcnt lgkmcnt(0)" ::: "memory")
#define VM_WAIT() asm volatile("s_waitcnt vmcnt(0)" ::: "memory")

namespace pg8 {
constexpr int BM = 256, BK = 64, HALF = 128, HTB = HALF * BK * 2, STAGE_BYTES = 8 * HTB, NXCD = 8, WGM = 8;
template <int SW = 5> __host__ __device__ __forceinline__ int lds_byte(int r, int c) { const int st = (r >> 4) * 2 + (c >> 5), rr = r & 15, cc = c & 31, ob = rr * 64 + cc * 2; return st * 1024 + (ob ^ (((ob >> 9) & 1) << SW)); }
template <int SW = 5> __host__ __device__ __forceinline__ void stage_rc(int b, int& R, int& C) { const int st = b / 1024, sb = b % 1024, swz = sb ^ (((sb >> 9) & 1) << SW); R = (st >> 1) * 16 + swz / 64; C = (st & 1) * 32 + (swz % 64) / 2; }
__host__ __device__ __forceinline__ int perm32(int rho) { const int n = rho >> 4, i = rho & 15; return 8 * (i >> 2) + 4 * n + (i & 3); }

struct Unit { int pm, pn, e, i0; };

struct StaticOrder {
    int nM, nN, nwg, G, c, cut = 1 << 30, skip = 0, off = 0;
    __device__ void init(int M_, int N_, int G_, int c_) { nM = M_ / BM; nN = N_ / BM; nwg = nM * nN; G = G_; c = c_; }
    __device__ bool next(int i, Unit& u) const {
        const long L = (long)i * G + c; if (L >= nwg) return false;
        int wgid = (int)L; { const int q = nwg / NXCD, r = nwg % NXCD, xcd = wgid % NXCD, off = wgid / NXCD; wgid = (xcd < r ? xcd * (q + 1) : r * (q + 1) + (xcd - r) * q) + off; }
        const int nig = WGM * nN, gid = wgid / nig, fm = gid * WGM, gsz = (nM - fm) < WGM ? (nM - fm) : WGM;
        u.pm = fm + ((wgid % nig) % gsz); u.pn = (wgid % nig) / gsz + off; if (u.pn >= cut) u.pn += skip; u.e = 0; u.i0 = 0; return true;
    }
    __device__ __forceinline__ unsigned goff(const Unit&, int) const { return 0u; }
};
struct PairOrder {
    StaticOrder S; int dpm0, dpn1;
    __device__ bool next(int i, Unit& u) const { if (!S.next(i >> 1, u)) return false; u.e = i & 1; if (u.e) u.pn += dpn1; else u.pm += dpm0; return true; }
    __device__ __forceinline__ unsigned goff(const Unit&, int) const { return 0u; }
};

__device__ __forceinline__ unsigned cvt_pk_bf16(float lo, float hi) { unsigned r; asm volatile("v_cvt_pk_bf16_f32 %0, %1, %2" : "=v"(r) : "v"(lo), "v"(hi)); return r; }

typedef int i32x8 __attribute__((ext_vector_type(8)));
template <bool FP8> struct Frag;
template <> struct Frag<false> { bf16x8 k0, k1; };
template <> struct Frag<true> { i32x8 v; };
template <bool FP8> __device__ __forceinline__ Frag<FP8> ldfrag(const LAS unsigned char* p, int o0, int o1) {
    Frag<FP8> f;
    if constexpr (FP8) { typedef int i32x4_t __attribute__((ext_vector_type(4))); f.v.lo = *(const LAS i32x4_t*)(p + o0); f.v.hi = *(const LAS i32x4_t*)(p + o1); }
    else { f.k0 = *(const LAS bf16x8*)(p + o0); f.k1 = *(const LAS bf16x8*)(p + o1); }
    return f;
}
template <bool FP8> __device__ __forceinline__ f32x4 mmafrag(const Frag<FP8>& b, const Frag<FP8>& a, f32x4 c) {
    if constexpr (FP8) {
        const int sc = 127;
#if defined(__HIP_DEVICE_COMPILE__)
        asm("v_mfma_scale_f32_16x16x128_f8f6f4 %0, %1, %2, %0, %3, %3 op_sel_hi:[0,0,0]" : "+v"(c) : "v"(b.v), "v"(a.v), "v"(sc));
#else
        (void)sc;
#endif
        return c; }
    else { c = __builtin_amdgcn_mfma_f32_16x16x32_bf16(b.k0, a.k0, c, 0, 0, 0); return __builtin_amdgcn_mfma_f32_16x16x32_bf16(b.k1, a.k1, c, 0, 0, 0); }
}
template <class Epi, class Sched, bool ALIGN_EPI, bool GATHER, bool FP8 = false>
__device__ __forceinline__ void gemm_phase(LAS unsigned char* lds, const void* Aall, const void* Ball, const int Kel, const Sched& S, const Epi& E) {
    const int K = FP8 ? (Kel >> 1) : Kel;
    int tid_ = threadIdx.x; asm volatile("" : "+v"(tid_));
    const int tid = tid_, wid = __builtin_amdgcn_readfirstlane(tid >> 6), lane = tid & 63, wr = wid >> 2, wc = wid & 3, fr = lane & 15, fq = lane >> 4;
    const int nt = K / BK;
    int Ri[2], Ci[2]; unsigned voffB[2];
    constexpr int SW = FP8 ? 4 : 5;
#pragma unroll
    for (int i = 0; i < 2; ++i) { stage_rc<SW>(tid * 16 + i * 8192, Ri[i], Ci[i]); const int Rb = Epi::PERM ? ((Ri[i] & ~31) + perm32(Ri[i] & 31)) : Ri[i]; voffB[i] = (unsigned)(Rb * K + Ci[i]) * 2u; }
    const size_t kstep = (size_t)(BK * 2);
    const size_t hstep = (size_t)HALF * K * 2;
    const size_t tstep = 2 * hstep;
    const unsigned ldsw = (unsigned)wid * 1024u;
    const int aoff = FP8 ? lds_byte<SW>(wr * 64 + fr, fq * 16) : lds_byte<SW>(wr * 64 + fr, fq * 8), boff = FP8 ? lds_byte<SW>(wc * 32 + fr, fq * 16) : lds_byte<SW>(wc * 32 + fr, fq * 8);
    const int aoff1 = FP8 ? lds_byte<SW>(wr * 64 + fr, fq * 16 + 8) : aoff + 1024, boff1 = FP8 ? lds_byte<SW>(wc * 32 + fr, fq * 16 + 8) : boff + 1024;
#define PG8_SA(b, h) (((b) * 2 + (h)) * HTB)
#define PG8_SB(b, h) ((4 + (b) * 2 + (h)) * HTB)
#define PG8_STAGE(bufoff, gbase, v0, v1) do { \
        __builtin_amdgcn_global_load_lds((const unsigned*)((const char*)(gbase) + (v0)), (LAS unsigned*)(lds + (bufoff) + ldsw), 16, 0, 0); \
        __builtin_amdgcn_global_load_lds((const unsigned*)((const char*)(gbase) + (v1)), (LAS unsigned*)(lds + (bufoff) + ldsw + 8192), 16, 0, 0); } while (0)
#define PG8_STAGE_B(bufoff, gbase) PG8_STAGE(bufoff, gbase, voffB[0], voffB[1])
#define PG8_LDA(dst, b, h) do { _Pragma("unroll") for (int m = 0; m < 4; ++m) dst[m] = ldfrag<FP8>(lds + PG8_SA(b, h) + m * 2048, aoff, aoff1); } while (0)
#define PG8_LDB(dst, b, h) do { _Pragma("unroll") for (int n = 0; n < 2; ++n) dst[n] = ldfrag<FP8>(lds + PG8_SB(b, h) + n * 2048, boff, boff1); } while (0)
#define PG8_MMA(ai, bj, At, Bt) do { __builtin_amdgcn_s_setprio(1); _Pragma("unroll") for (int m = 0; m < 4; ++m) _Pragma("unroll") for (int n = 0; n < 2; ++n) \
        acc[ai][bj][m][n] = mmafrag<FP8>(Bt[n], At[m], acc[ai][bj][m][n]); __builtin_amdgcn_s_setprio(0); } while (0)
#define PG8_WAIT_V(n) asm volatile("s_waitcnt vmcnt(" #n ")" ::: "memory")
#define PG8_WAIT_V_SEL_N(flag, nrel) asm volatile("s_cmp_eq_u32 %0, 0\n\ts_cbranch_scc1 1f\n\ts_waitcnt vmcnt(" #nrel ")\n\ts_branch 2f\n1:\n\ts_waitcnt vmcnt(8)\n2:" :: "s"(flag) : "memory", "scc")
#define PG8_WAIT_V_SEL(flag) do { if constexpr (Epi::NSTORE == 4) PG8_WAIT_V_SEL_N(flag, 12); else if constexpr (Epi::NSTORE == 8) PG8_WAIT_V_SEL_N(flag, 16); else if constexpr (Epi::NSTORE == 16) PG8_WAIT_V_SEL_N(flag, 24); else if constexpr (Epi::NSTORE == 32) PG8_WAIT_V_SEL_N(flag, 40); else PG8_WAIT_V(8); } while (0)
#define PG8_WAIT_L(n) asm volatile("s_waitcnt lgkmcnt(" #n ")" ::: "memory")
#define PG8_BAR __builtin_amdgcn_s_barrier()
#define PG8_SCHED __builtin_amdgcn_sched_barrier(0)
    Unit cur, nxt; int ui = 0;
    if (!S.next(0, cur)) return;
    f32x4 acc[2][2][4][2];
#pragma unroll
    for (int a = 0; a < 2; ++a)
#pragma unroll
        for (int b = 0; b < 2; ++b)
#pragma unroll
            for (int m = 0; m < 4; ++m)
#pragma unroll
                for (int n = 0; n < 2; ++n) acc[a][b][m][n] = (f32x4){0.f, 0.f, 0.f, 0.f};
    Frag<FP8> At[4], B0[2], B1[2];
    unsigned vc00, vc01, vc10, vc11, vn00, vn01, vn10, vn11;
    if constexpr (GATHER) {
        vc00 = S.goff(cur, Ri[0]) + (unsigned)Ci[0] * 2u; vc01 = S.goff(cur, Ri[1]) + (unsigned)Ci[1] * 2u;
        vc10 = S.goff(cur, 128 + Ri[0]) + (unsigned)Ci[0] * 2u; vc11 = S.goff(cur, 128 + Ri[1]) + (unsigned)Ci[1] * 2u;
    } else {
        vc00 = (unsigned)(Ri[0] * K + Ci[0]) * 2u; vc01 = (unsigned)(Ri[1] * K + Ci[1]) * 2u; vc10 = vc00 + (unsigned)hstep; vc11 = vc01 + (unsigned)hstep;
    }
    vn00 = vc00; vn01 = vc01; vn10 = vc10; vn11 = vc11;
    const char* cA = GATHER ? (const char*)Aall : (const char*)Aall + (size_t)cur.pm * tstep;
    const char* cB = (const char*)Ball + (size_t)cur.pn * tstep;
    PG8_STAGE_B(PG8_SB(0, 0), cB); PG8_STAGE_B(PG8_SB(0, 1), cB + hstep); PG8_STAGE(PG8_SA(0, 0), cA, vc00, vc01); PG8_STAGE(PG8_SA(0, 1), cA, vc10, vc11);
    if (wr == 1) PG8_BAR;
    PG8_WAIT_V(2); PG8_BAR;
    PG8_STAGE_B(PG8_SB(1, 0), cB + kstep); PG8_STAGE(PG8_SA(1, 0), cA + kstep, vc00, vc01); PG8_STAGE_B(PG8_SB(1, 1), cB + hstep + kstep);
    PG8_WAIT_V(6); PG8_BAR;
    for (;;) {
        const bool has_next = S.next(ui + 1, nxt);
        const char* nA = has_next ? (GATHER ? (const char*)Aall : (const char*)Aall + (size_t)nxt.pm * tstep) : cA;
        const char* nB = has_next ? (const char*)Ball + (size_t)nxt.pn * tstep : cB;
        if constexpr (GATHER) {
            if (has_next) {
                vn00 = S.goff(nxt, Ri[0]) + (unsigned)Ci[0] * 2u; vn01 = S.goff(nxt, Ri[1]) + (unsigned)Ci[1] * 2u;
                vn10 = S.goff(nxt, 128 + Ri[0]) + (unsigned)Ci[0] * 2u; vn11 = S.goff(nxt, 128 + Ri[1]) + (unsigned)Ci[1] * 2u;
            }
        }
#pragma unroll 1
        for (int t = 0; t < nt; t += 2) {
            const bool last = (t == nt - 2);
            const char* a1 = cA + (size_t)(t + 1) * kstep;
            const char* a2 = last ? nA : cA + (size_t)(t + 2) * kstep; const char* b2 = last ? nB : cB + (size_t)(t + 2) * kstep;
            const char* a3 = a2 + kstep; const char* b3 = b2 + kstep;
            const unsigned s00 = last ? vn00 : vc00, s01 = last ? vn01 : vc01, s10 = last ? vn10 : vc10, s11 = last ? vn11 : vc11;
            const int relax = __builtin_amdgcn_readfirstlane(((t == 0) && (ui > 0) && (!Epi::PAIR || cur.e == 0)) ? 1 : 0);
            PG8_LDB(B0, 0, 0); PG8_LDB(B1, 0, 1); PG8_SCHED; PG8_LDA(At, 0, 0); PG8_STAGE(PG8_SA(1, 1), a1, vc10, vc11);
            PG8_WAIT_V_SEL(relax); PG8_WAIT_L(0); PG8_BAR; PG8_MMA(0, 0, At, B0); PG8_MMA(0, 1, At, B1); PG8_BAR; PG8_SCHED;
            PG8_LDA(At, 0, 1); PG8_STAGE_B(PG8_SB(0, 0), b2); PG8_STAGE_B(PG8_SB(0, 1), b2 + hstep); PG8_STAGE(PG8_SA(0, 0), a2, s00, s01);
            PG8_WAIT_V_SEL(relax); PG8_WAIT_L(0); PG8_BAR; PG8_MMA(1, 0, At, B0); PG8_MMA(1, 1, At, B1); PG8_BAR; PG8_SCHED;
            PG8_LDB(B0, 1, 0); PG8_LDB(B1, 1, 1); PG8_SCHED; PG8_LDA(At, 1, 0); PG8_STAGE(PG8_SA(0, 1), a2, s10, s11);
            PG8_WAIT_V(8); PG8_WAIT_L(0); PG8_BAR; PG8_MMA(0, 0, At, B0); PG8_MMA(0, 1, At, B1); PG8_BAR; PG8_SCHED;
            PG8_LDA(At, 1, 1); PG8_STAGE_B(PG8_SB(1, 0), b3); PG8_STAGE_B(PG8_SB(1, 1), b3 + hstep); PG8_STAGE(PG8_SA(1, 0), a3, s00, s01);
            PG8_WAIT_V(8); PG8_WAIT_L(0); PG8_BAR; PG8_MMA(1, 0, At, B0); PG8_MMA(1, 1, At, B1); PG8_BAR; PG8_SCHED;
        }
        if constexpr (ALIGN_EPI) { if (wr == 0) PG8_BAR; }
        if constexpr (FP8) asm volatile("s_nop 7\n\ts_nop 7" ::: "memory");
        E(acc, cur, wr, wc, fr, fq);
#if (DUP_MASK >> 20) & 1
        if constexpr (Epi::IDEMP) { asm volatile("" ::: "memory"); E(acc, cur, wr, wc, fr, fq); }
#endif
#if (DUP_MASK >> 21) & 1
        if constexpr (Epi::ISP1) { asm volatile("" ::: "memory"); E(acc, cur, wr, wc, fr, fq); }
#endif
        if (!has_next) break;
        if (!(Epi::PAIR && cur.e == 0))
#pragma unroll
        for (int a = 0; a < 2; ++a)
#pragma unroll
            for (int b = 0; b < 2; ++b)
#pragma unroll
                for (int m = 0; m < 4; ++m)
#pragma unroll
                    for (int n = 0; n < 2; ++n) acc[a][b][m][n] = (f32x4){0.f, 0.f, 0.f, 0.f};
        cur = nxt; cA = nA; cB = nB; ++ui;
        vc00 = vn00; vc01 = vn01; vc10 = vn10; vc11 = vn11;
        if constexpr (ALIGN_EPI) { if (wr == 1) PG8_BAR; }
    }
    PG8_WAIT_V(0);
    if constexpr (!ALIGN_EPI) { if (wr == 0) PG8_BAR; }
    PG8_BAR;
#undef PG8_SA
#undef PG8_SB
#undef PG8_STAGE
#undef PG8_STAGE_B
#undef PG8_LDA
#undef PG8_LDB
#undef PG8_MMA
#undef PG8_WAIT_V
#undef PG8_WAIT_V_SEL
#undef PG8_WAIT_V_SEL_N
#undef PG8_WAIT_L
#undef PG8_BAR
#undef PG8_SCHED
}
}

__device__ __forceinline__ void phase_stagger(int dticks) {
    const int s = ((int)blockIdx.x >> 3) & 7;
    if (s && dticks > 0) { const unsigned long long t0 = __builtin_amdgcn_s_memrealtime(); const unsigned long long want = (unsigned long long)(s * dticks);
        while (__builtin_amdgcn_s_memrealtime() - t0 < want) __builtin_amdgcn_s_sleep(16); }
}
__device__ __forceinline__ u32x4 pair16(const u32x2 a, const u32x2 b) {
    const auto rx = __builtin_amdgcn_permlane16_swap(a.x, b.x, false, false);
    const auto ry = __builtin_amdgcn_permlane16_swap(a.y, b.y, false, false);
    return (u32x4){rx[0], ry[0], rx[1], ry[1]};
}
struct EpiStoreBf16S {
    static constexpr bool PERM = true, IDEMP = true, ISP1 = false, PAIR = false;
    static constexpr int NSTORE = 8;
    bf16* O; int ldc; float scale; int sig_from;
    __device__ __forceinline__ void operator()(const f32x4 (&acc)[2][2][4][2], const pg8::Unit& u, int wr, int wc, int fr, int fq) const {
        const int row0 = u.pm * 256 + wr * 64 + fr, col0 = u.pn * 256 + wc * 32 + 8 * fq;
#pragma unroll
        for (int ai = 0; ai < 2; ++ai)
#pragma unroll
            for (int mp = 0; mp < 2; ++mp)
#pragma unroll
                for (int bj = 0; bj < 2; ++bj) {
                    if (u.pn * 256 + bj * 128 >= sig_from) {
                        u32x2 wp[2];
#pragma unroll
                        for (int mh = 0; mh < 2; ++mh) { const int m = 2 * mp + mh; const f32x4 v0 = acc[ai][bj][m][0], v1 = acc[ai][bj][m][1];
                            unsigned q[8];
                            {   f32x4 kone = {1.0f, 1.0f, 1.0f, 1.0f}, k255 = {255.0f, 255.0f, 255.0f, 255.0f}, khalf = {0.5f, 0.5f, 0.5f, 0.5f}; asm volatile("" : "+v"(kone), "+v"(k255), "+v"(khalf));
                                const float ns = -1.4426950408889634f * scale;
                                const f32x4 t0 = v0 * ns, t1 = v1 * ns; f32x4 e0, e1;
#pragma unroll
                                for (int k = 0; k < 4; ++k) { e0[k] = __builtin_amdgcn_exp2f(t0[k]); e1[k] = __builtin_amdgcn_exp2f(t1[k]); }
                                const f32x4 d0 = e0 + kone, d1 = e1 + kone; f32x4 r0, r1;
#pragma unroll
                                for (int k = 0; k < 4; ++k) { r0[k] = __builtin_amdgcn_rcpf(d0[k]); r1[k] = __builtin_amdgcn_rcpf(d1[k]); }
                                const f32x4 s0 = __builtin_elementwise_fma(r0, k255, khalf), s1 = __builtin_elementwise_fma(r1, k255, khalf);
#pragma unroll
                                for (int k = 0; k < 4; ++k) { q[k] = (unsigned)s0[k]; q[4 + k] = (unsigned)s1[k]; } }
                            wp[mh].x = q[0] | (q[1] << 8) | (q[2] << 16) | (q[3] << 24); wp[mh].y = q[4] | (q[5] << 8) | (q[6] << 16) | (q[7] << 24); }
                        unsigned char* rowb = (unsigned char*)(O + (size_t)(row0 + ai * 128 + (2 * mp + (fq & 1)) * 16) * ldc);
                        *(u32x4*)(rowb + 2 * sig_from + (col0 - 8 * fq + 16 * (fq >> 1) + bj * 128 - sig_from)) = pair16(wp[0], wp[1]);
                    } else {
#pragma unroll
                        for (int mh = 0; mh < 2; ++mh) { const int m = 2 * mp + mh; bf16* rowp = O + (size_t)(row0 + ai * 128 + m * 16) * ldc + col0;
                            const f32x4 v0 = acc[ai][bj][m][0] * scale, v1 = acc[ai][bj][m][1] * scale; u32x4 w;
                            w.x = pg8::cvt_pk_bf16(v0[0], v0[1]); w.y = pg8::cvt_pk_bf16(v0[2], v0[3]); w.z = pg8::cvt_pk_bf16(v1[0], v1[1]); w.w = pg8::cvt_pk_bf16(v1[2], v1[3]);
                            *(u32x4*)(rowp + bj * 128) = w; } } }
    }
};
struct EpiStoreBf16 {
    static constexpr bool PERM = true, IDEMP = true, ISP1 = true, PAIR = false;
    static constexpr int NSTORE = 16;
    bf16* O; int ldc; int sig_from;
    __device__ __forceinline__ void operator()(const f32x4 (&acc)[2][2][4][2], const pg8::Unit& u, int wr, int wc, int fr, int fq) const {
        const int row0 = u.pm * 256 + wr * 64 + fr, col0 = u.pn * 256 + wc * 32 + 8 * fq;
#pragma unroll
        for (int ai = 0; ai < 2; ++ai)
#pragma unroll
            for (int m = 0; m < 4; ++m) { bf16* rowp = O + (size_t)(row0 + ai * 128 + m * 16) * ldc + col0;
#pragma unroll
                for (int bj = 0; bj < 2; ++bj) { const f32x4 v0 = acc[ai][bj][m][0], v1 = acc[ai][bj][m][1];
                    if (sig_from >= 0 && u.pn * 256 + bj * 128 >= sig_from) {
                        unsigned q[8];
                        {   f32x4 kone = {1.0f, 1.0f, 1.0f, 1.0f}, k255 = {255.0f, 255.0f, 255.0f, 255.0f}, khalf = {0.5f, 0.5f, 0.5f, 0.5f}; asm volatile("" : "+v"(kone), "+v"(k255), "+v"(khalf));
                            const f32x4 t0 = v0 * -1.4426950408889634f, t1 = v1 * -1.4426950408889634f; f32x4 e0, e1;
#pragma unroll
                            for (int k = 0; k < 4; ++k) { e0[k] = __builtin_amdgcn_exp2f(t0[k]); e1[k] = __builtin_amdgcn_exp2f(t1[k]); }
                            const f32x4 d0 = e0 + kone, d1 = e1 + kone; f32x4 r0, r1;
#pragma unroll
                            for (int k = 0; k < 4; ++k) { r0[k] = __builtin_amdgcn_rcpf(d0[k]); r1[k] = __builtin_amdgcn_rcpf(d1[k]); }
                            const f32x4 s0 = __builtin_elementwise_fma(r0, k255, khalf), s1 = __builtin_elementwise_fma(r1, k255, khalf);
#pragma unroll
                            for (int k = 0; k < 4; ++k) { q[k] = (unsigned)s0[k]; q[4 + k] = (unsigned)s1[k]; } }
                        u32x2 w; w.x = q[0] | (q[1] << 8) | (q[2] << 16) | (q[3] << 24); w.y = q[4] | (q[5] << 8) | (q[6] << 16) | (q[7] << 24);
                        *(u32x2*)((unsigned char*)(rowp - col0) + 2 * sig_from + (col0 + bj * 128 - sig_from)) = w;
                    } else { u32x4 w;
                        w.x = pg8::cvt_pk_bf16(v0[0], v0[1]); w.y = pg8::cvt_pk_bf16(v0[2], v0[3]); w.z = pg8::cvt_pk_bf16(v1[0], v1[1]); w.w = pg8::cvt_pk_bf16(v1[2], v1[3]);
                        *(u32x4*)(rowp + bj * 128) = w; } } }
    }
};
template <bool ADD> struct EpiGate {
    static constexpr bool PERM = true, IDEMP = true, ISP1 = false, PAIR = false;
    static constexpr int NSTORE = 16;
    bf16* MG; const bf16* P; int gcol0; unsigned char* MG8;
    __device__ __forceinline__ void operator()(const f32x4 (&acc)[2][2][4][2], const pg8::Unit& u, int wr, int wc, int fr, int fq) const {
        const int row0 = u.pm * 256 + wr * 64 + fr, col0 = u.pn * 256 + wc * 32 + 8 * fq;
#pragma unroll
        for (int ai = 0; ai < 2; ++ai)
#pragma unroll
            for (int m = 0; m < 4; ++m) { const size_t row = (size_t)(row0 + ai * 128 + m * 16);
#pragma unroll
                for (int bj = 0; bj < 2; ++bj) { const int col = col0 + bj * 128;
                    const u32x2 g = *(const u32x2*)((const unsigned char*)(P + row * PN) + 2 * C_GA + (gcol0 - C_GA) + col);
                    float o[8]; const f32x4 v0 = acc[ai][bj][m][0], v1 = acc[ai][bj][m][1];
                    constexpr float Q = 1.0f / (255.0f * F8S_YM * F8S_W);
                    {   const f32x4 b0 = {(float)(g.x & 0xffu), (float)((g.x >> 8) & 0xffu), (float)((g.x >> 16) & 0xffu), (float)(g.x >> 24)}, b1 = {(float)(g.y & 0xffu), (float)((g.y >> 8) & 0xffu), (float)((g.y >> 16) & 0xffu), (float)(g.y >> 24)};
                        const f32x4 p0 = (v0 * Q) * b0, p1 = (v1 * Q) * b1;
                        o[0] = p0[0]; o[1] = p0[1]; o[2] = p0[2]; o[3] = p0[3]; o[4] = p1[0]; o[5] = p1[1]; o[6] = p1[2]; o[7] = p1[3]; }
                    bf16* dst = MG + row * DM + col;
                    if (ADD) { const u32x4 p = *(const u32x4*)dst;
                        o[0] += bflo(p.x); o[1] += bfhi(p.x); o[2] += bflo(p.y); o[3] += bfhi(p.y); o[4] += bflo(p.z); o[5] += bfhi(p.z); o[6] += bflo(p.w); o[7] += bfhi(p.w); }
                    if (ADD) { u32x2 w8; w8.x = pack4_fp8(o[0] * F8S_M, o[1] * F8S_M, o[2] * F8S_M, o[3] * F8S_M); w8.y = pack4_fp8(o[4] * F8S_M, o[5] * F8S_M, o[6] * F8S_M, o[7] * F8S_M);
                        *(u32x2*)(MG8 + row * DM + col) = w8; }
                    else { u32x4 w; w.x = pg8::cvt_pk_bf16(o[0], o[1]); w.y = pg8::cvt_pk_bf16(o[2], o[3]); w.z = pg8::cvt_pk_bf16(o[4], o[5]); w.w = pg8::cvt_pk_bf16(o[6], o[7]);
                        *(u32x4*)dst = w; } }
                if (ai == 0 && m == 1) asm volatile("" ::: "memory"); }
    }
};
struct EpiGatePair {
    static constexpr bool PERM = true, IDEMP = false, ISP1 = false, PAIR = true;
    static constexpr int NSTORE = 8;
    const bf16* P; unsigned char* MG8;
    static __device__ __forceinline__ void dec8(const unsigned x, const unsigned y, f32x4& b0, f32x4& b1) {
        b0 = (f32x4){(float)(x & 0xffu), (float)((x >> 8) & 0xffu), (float)((x >> 16) & 0xffu), (float)(x >> 24)}; b1 = (f32x4){(float)(y & 0xffu), (float)((y >> 8) & 0xffu), (float)((y >> 16) & 0xffu), (float)(y >> 24)}; }
    __device__ __forceinline__ void operator()(f32x4 (&acc)[2][2][4][2], const pg8::Unit& u, int wr, int wc, int fr, int fq) const {
        const int row0 = (u.pm & 127) * 256 + wr * 64 + fr, col0 = (u.pn & 3) * 256 + wc * 32 + 8 * fq;
        const int colw = col0 - 8 * fq + 16 * (fq >> 1);
        if (u.e == 0) {
#pragma unroll
            for (int ai = 0; ai < 2; ++ai)
#pragma unroll
                for (int mp = 0; mp < 2; ++mp) { const size_t rowl = (size_t)(row0 + ai * 128 + (2 * mp + (fq & 1)) * 16);
#pragma unroll
                    for (int bj = 0; bj < 2; ++bj) {
                        const unsigned char* gp = (const unsigned char*)(P + rowl * PN) + 2 * C_GA + colw + bj * 128;
                        const u32x4 la = *(const u32x4*)gp, lb = *(const u32x4*)(gp + 1024);
                        const auto ax = __builtin_amdgcn_permlane16_swap(la.x, la.z, false, false), ay = __builtin_amdgcn_permlane16_swap(la.y, la.w, false, false);
                        const auto bx = __builtin_amdgcn_permlane16_swap(lb.x, lb.z, false, false), by = __builtin_amdgcn_permlane16_swap(lb.y, lb.w, false, false);
#pragma unroll
                        for (int mh = 0; mh < 2; ++mh) { const int m = 2 * mp + mh; f32x4 a0, a1, b0, b1; dec8(ax[mh], ay[mh], a0, a1); dec8(bx[mh], by[mh], b0, b1);
#pragma unroll
                            for (int j = 0; j < 4; ++j) { b0[j] = __builtin_amdgcn_rcpf(fmaxf(b0[j], 1.0f)); b1[j] = __builtin_amdgcn_rcpf(fmaxf(b1[j], 1.0f)); }
                            acc[ai][bj][m][0] = acc[ai][bj][m][0] * (a0 * b0); acc[ai][bj][m][1] = acc[ai][bj][m][1] * (a1 * b1); } } }
        } else {
#pragma unroll
            for (int ai = 0; ai < 2; ++ai)
#pragma unroll
                for (int mp = 0; mp < 2; ++mp) { const size_t rowl = (size_t)(row0 + ai * 128 + (2 * mp + (fq & 1)) * 16);
#pragma unroll
                    for (int bj = 0; bj < 2; ++bj) {
                        const u32x4 lb = *(const u32x4*)((const unsigned char*)(P + rowl * PN) + 2 * C_GA + 1024 + colw + bj * 128);
                        const auto bx = __builtin_amdgcn_permlane16_swap(lb.x, lb.z, false, false), by = __builtin_amdgcn_permlane16_swap(lb.y, lb.w, false, false);
                        u32x2 wp[2];
#pragma unroll
                        for (int mh = 0; mh < 2; ++mh) { const int m = 2 * mp + mh; f32x4 b0, b1; dec8(bx[mh], by[mh], b0, b1);
                            constexpr float Q = F8S_M / (255.0f * F8S_YM * F8S_W);
#pragma unroll
                            for (int j = 0; j < 4; ++j) { b0[j] = fmaxf(b0[j], 1.0f); b1[j] = fmaxf(b1[j], 1.0f); }
                            const f32x4 p0 = (acc[ai][bj][m][0] * Q) * b0, p1 = (acc[ai][bj][m][1] * Q) * b1;
                            wp[mh].x = pack4_fp8(p0[0], p0[1], p0[2], p0[3]); wp[mh].y = pack4_fp8(p1[0], p1[1], p1[2], p1[3]); }
                        *(u32x4*)(MG8 + rowl * DM + colw + bj * 128) = pair16(wp[0], wp[1]); } }
        }
    }
};
struct EpiResid {
    static constexpr bool PERM = true, IDEMP = true, ISP1 = false, PAIR = false;
    static constexpr int NSTORE = 16;
    const bf16* XN; const float* RMS; const float* GM; bf16* O; float dq;
    __device__ __forceinline__ void operator()(const f32x4 (&acc)[2][2][4][2], const pg8::Unit& u, int wr, int wc, int fr, int fq) const {
        const int row0 = u.pm * 256 + wr * 64 + fr, col0 = u.pn * 256 + wc * 32 + 8 * fq;
        const float rmsA = RMS[u.pm * 256 + wr * 64 + fr + 16 * fq], rmsB = RMS[u.pm * 256 + 128 + wr * 64 + fr + 16 * fq];
        f32x4 gi[2][2];
#pragma unroll
        for (int bj = 0; bj < 2; ++bj)
#pragma unroll
            for (int n = 0; n < 2; ++n) { const f32x4 gv = *(const f32x4*)(GM + col0 + bj * 128 + 4 * n); gi[bj][n] = (f32x4){1.0f / gv[0], 1.0f / gv[1], 1.0f / gv[2], 1.0f / gv[3]}; }
#pragma unroll
        for (int ai = 0; ai < 2; ++ai)
#pragma unroll
            for (int m = 0; m < 4; ++m) { const int row = row0 + ai * 128 + m * 16; const size_t off = (size_t)row * DM + col0; const float rms = __shfl(ai ? rmsB : rmsA, fr + 16 * m);
#pragma unroll
                for (int bj = 0; bj < 2; ++bj) { const u32x4 xb = *(const u32x4*)(XN + off + bj * 128);
                    const f32x4 x0 = {bflo(xb.x), bfhi(xb.x), bflo(xb.y), bfhi(xb.y)}, x1 = {bflo(xb.z), bfhi(xb.z), bflo(xb.w), bfhi(xb.w)};
                    const f32x4 v0 = x0 * rms * gi[bj][0] + acc[ai][bj][m][0] * dq, v1 = x1 * rms * gi[bj][1] + acc[ai][bj][m][1] * dq; u32x4 w;
                    w.x = pg8::cvt_pk_bf16(v0[0], v0[1]); w.y = pg8::cvt_pk_bf16(v0[2], v0[3]); w.z = pg8::cvt_pk_bf16(v1[0], v1[1]); w.w = pg8::cvt_pk_bf16(v1[2], v1[3]);
                    *(u32x4*)(O + off + bj * 128) = w; } }
    }
};
struct EpiMoe1 {
    static constexpr bool PERM = true, IDEMP = true, ISP1 = false, PAIR = false;
    static constexpr int NSTORE = 4;
    unsigned char* ACT; const float* b1;
    __device__ __forceinline__ void operator()(const f32x4 (&acc)[2][2][4][2], const pg8::Unit& u, int wr, int wc, int fr, int fq) const {
        const int pnl = u.pn & 7; const int row0 = u.pm * 256 + wr * 64 + fr, j0 = pnl * 128 + wc * 32 + 8 * fq;
        const float* bg = b1 + (size_t)u.e * 2048 + j0; const float* bl = bg + 1024;
        const f32x4 bg0 = *(const f32x4*)bg, bg1 = *(const f32x4*)(bg + 4), bl0 = *(const f32x4*)bl, bl1 = *(const f32x4*)(bl + 4);
        constexpr float dq = 1.0f / (F8S_H * F8S_W);
        f32x4 dqv = {dq, dq, dq, dq}, one4 = {1.0f, 1.0f, 1.0f, 1.0f}; asm volatile("" : "+v"(dqv), "+v"(one4));
#pragma unroll
        for (int ai = 0; ai < 2; ++ai)
#pragma unroll
            for (int mp = 0; mp < 2; ++mp) { u32x2 wp[2];
#pragma unroll
                for (int mh = 0; mh < 2; ++mh) { const int m = 2 * mp + mh; u32x2 w;
#pragma unroll
                for (int n = 0; n < 2; ++n) {
                    const f32x4 gv = __builtin_elementwise_fma(acc[ai][0][m][n], dqv, (n ? bg1 : bg0)), lv = __builtin_elementwise_fma(acc[ai][1][m][n], dqv, (n ? bl1 : bl0));
                    f32x4 g, l;
#pragma unroll
                    for (int k = 0; k < 4; ++k) { g[k] = fminf(gv[k], 7.0f); l[k] = __builtin_amdgcn_fmed3f(lv[k], -7.0f, 7.0f); }
                    const f32x4 t = g * (-1.702f * 1.4426950408889634f);
                    f32x4 e;
#pragma unroll
                    for (int k = 0; k < 4; ++k) e[k] = __builtin_amdgcn_exp2f(t[k]);
                    const f32x4 d = e + one4;
                    f32x4 r;
#pragma unroll
                    for (int k = 0; k < 4; ++k) r[k] = __builtin_amdgcn_rcpf(d[k]);
                    const f32x4 o = (g * r) * (l * F8S_A + F8S_A);
                    int p = __builtin_amdgcn_cvt_pk_fp8_f32(o[0], o[1], 0, false); p = __builtin_amdgcn_cvt_pk_fp8_f32(o[2], o[3], p, true);
                    if (n) w.y = (unsigned)p; else w.x = (unsigned)p; }
                    wp[mh] = w; }
                const u32x4 q = pair16(wp[0], wp[1]);
                *(u32x4*)(ACT + (size_t)(row0 + ai * 128 + (2 * mp + (fq & 1)) * 16) * DE + (j0 - 8 * fq) + 16 * (fq >> 1)) = q; }
    }
};
struct EpiMoe2 {
    static constexpr bool PERM = true, IDEMP = true, ISP1 = false, PAIR = false;
    static constexpr int NSTORE = 8;
    unsigned char* Y; const float* b2;
    __device__ __forceinline__ void operator()(const f32x4 (&acc)[2][2][4][2], const pg8::Unit& u, int wr, int wc, int fr, int fq) const {
        const int pnl = u.pn & 3; const int row0 = u.pm * 256 + wr * 64 + fr, col0 = pnl * 256 + wc * 32 + 8 * fq;
        f32x4 bv[2][2];
#pragma unroll
        for (int bj = 0; bj < 2; ++bj)
#pragma unroll
            for (int n = 0; n < 2; ++n) bv[bj][n] = *(const f32x4*)(b2 + (size_t)u.e * 1024 + col0 + bj * 128 + 4 * n) * F8S_Y;
        constexpr float dq = 1.0f / (F8S_A * F8S_W);
#pragma unroll
        for (int ai = 0; ai < 2; ++ai)
#pragma unroll
            for (int mp = 0; mp < 2; ++mp) { unsigned char* rowp = Y + (size_t)(row0 + ai * 128 + (2 * mp + (fq & 1)) * 16) * DM + (col0 - 8 * fq) + 16 * (fq >> 1);
#pragma unroll
                for (int bj = 0; bj < 2; ++bj) { u32x2 wp[2];
#pragma unroll
                    for (int mh = 0; mh < 2; ++mh) { const int m = 2 * mp + mh; const f32x4 v0 = acc[ai][bj][m][0] * (dq * F8S_Y) + bv[bj][0], v1 = acc[ai][bj][m][1] * (dq * F8S_Y) + bv[bj][1];
                        wp[mh].x = pack4_fp8(v0[0], v0[1], v0[2], v0[3]); wp[mh].y = pack4_fp8(v1[0], v1[1], v1[2], v1[3]); }
                    *(u32x4*)(rowp + bj * 128) = pair16(wp[0], wp[1]); } }
    }
};
struct MoeOrder {
    int JP, x, j, TPX, NT, NPN; const LAS int* tab; const int2* list;
    __device__ bool next(int i, pg8::Unit& u) const {
        const int q = i * JP + j; const int lt = q / NPN, pn = q % NPN; if (lt >= TPX) return false; const int gt = x * TPX + lt; if (gt >= NT) return false;
        int e = 0;
        for (int k = 1; k < NE; ++k) e += (tab[32 + k] <= gt) ? 1 : 0;
        e = __builtin_amdgcn_readfirstlane(e); const int ts = __builtin_amdgcn_readfirstlane(tab[32 + e]);
        u.pm = gt; u.pn = e * NPN + pn; u.e = e; u.i0 = (gt - ts) * 256; return true;
    }
    __device__ __forceinline__ unsigned goff(const pg8::Unit& u, int r) const {
        const int idx = u.i0 + r; int tok = 0; if (idx < tab[u.e]) tok = list[(size_t)u.e * LISTCAP + idx].x >> 2; return (unsigned)tok * (unsigned)DM;
    }
};

#define XB_TMO      128
#define XB_XCNT(j)  (256  + 64 * (j))
#define XB_XSUB(j)  (1280 + 64 * (j))
#define XB_XGEN(j)  (2304 + 64 * (j))
#define XB_TOP      3328
#define XB_TOPGEN   3392
#define XCD_BAR_WORDS 3456
#define XB_SPIN_CAP (1u << 20)
__device__ __forceinline__ unsigned xb_ld(unsigned* p)              { return __hip_atomic_load(p, __ATOMIC_RELAXED, __HIP_MEMORY_SCOPE_AGENT); }
__device__ __forceinline__ unsigned xb_add(unsigned* p, unsigned v) { return __hip_atomic_fetch_add(p, v, __ATOMIC_RELAXED, __HIP_MEMORY_SCOPE_AGENT); }
__device__ __forceinline__ unsigned xb_xcc_id() { return (unsigned)__builtin_amdgcn_s_getreg((3 << 11) | 20) & 0xFu; }
#define XB_SPIN(cond, bar) do { unsigned _sp = 0; while (cond) { __builtin_amdgcn_s_sleep(1); \
    if ((++_sp & 255u) == 0u) { if (xb_ld(&(bar)[XB_TMO])) break; if (_sp > XB_SPIN_CAP) { atomicAdd(&(bar)[XB_TMO], 1u); break; } } } } while (0)
struct XcdBarrier { unsigned* bar; unsigned x; volatile LAS unsigned* st; };
__device__ __forceinline__ XcdBarrier xcd_barrier_post(unsigned* bar, volatile LAS unsigned* st) {
    XcdBarrier b; b.bar = bar; b.x = xb_xcc_id(); b.st = st;
    if (threadIdx.x == 0) (void)xb_add(&bar[XB_XCNT(b.x)], 1u);
    return b;
}
__device__ __forceinline__ void xcd_barrier_complete(unsigned* bar, unsigned x, unsigned& nloc, unsigned& nx) {
    const unsigned G = gridDim.x * gridDim.y * gridDim.z;
    unsigned sum, cnt, mine, sp = 0u;
    for (;;) {
        sum = 0u; cnt = 0u; mine = 0u;
#pragma unroll
        for (unsigned j = 0; j < 16; ++j) { const unsigned c = xb_ld(&bar[XB_XCNT(j)]); sum += c; cnt += (c > 0u) ? 1u : 0u; mine = (j == x) ? c : mine; }
        if (sum == G) break;
        __builtin_amdgcn_s_sleep(1);
        if ((++sp & 255u) == 0u) { if (xb_ld(&bar[XB_TMO])) break; if (sp > XB_SPIN_CAP) { atomicAdd(&bar[XB_TMO], 1u); break; } }
    }
    nloc = mine > 0u ? mine : 1u; nx = cnt > 0u ? cnt : 1u;
}
__device__ __forceinline__ void xcd_barrier(const XcdBarrier& b) {
    asm volatile("s_waitcnt vmcnt(0)" ::: "memory");
    __syncthreads();
    if (threadIdx.x == 0) {
        unsigned* bar = b.bar;
        __builtin_amdgcn_s_waitcnt(0);
        unsigned nloc = b.st[0], nx = b.st[1];
        if (nloc == 0u) { xcd_barrier_complete(bar, b.x, nloc, nx); b.st[0] = nloc; b.st[1] = nx; }
        const unsigned old = xb_add(&bar[XB_XSUB(b.x)], 1u);
        const unsigned gen = old / nloc;
        if (old + 1u == (gen + 1u) * nloc) {
            __builtin_amdgcn_fence(__ATOMIC_RELEASE, "agent");
            asm volatile("s_waitcnt vmcnt(0)" ::: "memory");
            const unsigned og = xb_add(&bar[XB_TOP], 1u);
            const unsigned tg = og / nx;
            if (og + 1u != (tg + 1u) * nx) XB_SPIN(xb_ld(&bar[XB_TOP]) < (tg + 1u) * nx, bar);
            __builtin_amdgcn_fence(__ATOMIC_ACQUIRE, "agent");
            asm volatile("s_waitcnt vmcnt(0)" ::: "memory");
        } else {
            XB_SPIN(xb_ld(&bar[XB_TOP]) < (gen + 1u) * nx, bar);
            __builtin_amdgcn_fence(__ATOMIC_ACQUIRE, "agent");
            asm volatile("s_waitcnt vmcnt(0)" ::: "memory");
        }
    }
    __syncthreads();
}

struct Args { const float* in[32]; float* out; unsigned char* ws; int ph_lo, ph_hi, li, pad; };
enum { I_X = 0, I_GMIX, I_WIN, I_MUP, I_MUN, I_W0F, I_W2F, I_W0B, I_W2B, I_A0F, I_A2F, I_A0B, I_A2B, I_G2, I_KK, I_KA, I_RK, I_LNG, I_LNB, I_QG, I_KG, I_RPB,
       I_WA, I_WB, I_WO, I_GFFN, I_WR, I_BR, I_W1, I_B1, I_W2, I_B2 };

__device__ __forceinline__ void p0_transpose_item_f8(const float* W, int N, unsigned char* WT8, int k0, int n0, int drow0, LAS float* scr, int lane, int rowb = 1024) {
#pragma unroll 8
    for (int i = 0; i < 32; ++i) { const int kk = 2 * i + (lane >> 5); scr[kk * 33 + (lane & 31)] = W[(size_t)(k0 + kk) * N + n0 + (lane & 31)]; }
    LDS_WAIT(); asm volatile("" ::: "memory");
    const int c = lane & 7;
#pragma unroll
    for (int j = 0; j < 4; ++j) { const int n = (lane >> 3) + 8 * j; const LAS float* s = scr + (8 * c) * 33 + n;
        u32x2 o; o.x = pack4_fp8(s[0 * 33] * F8S_W, s[1 * 33] * F8S_W, s[2 * 33] * F8S_W, s[3 * 33] * F8S_W); o.y = pack4_fp8(s[4 * 33] * F8S_W, s[5 * 33] * F8S_W, s[6 * 33] * F8S_W, s[7 * 33] * F8S_W);
        *(GAS u32x2*)(WT8 + (size_t)(drow0 + n) * rowb + k0 + 8 * c) = o; }
    LDS_WAIT(); asm volatile("" ::: "memory");
}
__device__ __forceinline__ void p0_transpose_item(const float* W, int K, int N, bf16* WT, int k0, int n0, int drow0, LAS float* scr, int lane) {
#pragma unroll 8
    for (int i = 0; i < 32; ++i) { const int kk = 2 * i + (lane >> 5); scr[kk * 33 + (lane & 31)] = W[(size_t)(k0 + kk) * N + n0 + (lane & 31)]; }
    LDS_WAIT(); asm volatile("" ::: "memory");
    const int c = lane & 7;
#pragma unroll
    for (int j = 0; j < 4; ++j) { const int n = (lane >> 3) + 8 * j; const LAS float* s = scr + (8 * c) * 33 + n;
        u32x4 o; o.x = pk2(s[0 * 33], s[1 * 33]); o.y = pk2(s[2 * 33], s[3 * 33]); o.z = pk2(s[4 * 33], s[5 * 33]); o.w = pk2(s[6 * 33], s[7 * 33]);
        *(GAS u32x4*)(WT + (size_t)(drow0 + n) * K + k0 + 8 * c) = o; }
    LDS_WAIT(); asm volatile("" ::: "memory");
}
__device__ __forceinline__ void phase_prologue(const Args& a, LAS unsigned char* lds, int G) {
    const int tid = threadIdx.x, lane = tid & 63, wave = tid >> 6;
    unsigned char* ws = a.ws;
    LAS float* scr = (LAS float*)(lds + wave * 16384);
    const int gw = blockIdx.x * 8 + wave, NGW = G * 8;
    constexpr int I_IN = 16 * 172, I_AB = 8 * 32, I_O = 16 * 32, I_1 = 32 * 16 * 64, I_2 = 32 * 16 * 32;
    constexpr int NITEMS = I_IN + 2 * I_AB + I_O;
    const float* x = a.in[I_X]; const float* gmix = a.in[I_GMIX]; bf16* XN = (bf16*)(ws + WS_XN);
    f32x4 gm[4];
#pragma unroll
    for (int j = 0; j < 4; ++j) gm[j] = *(const f32x4*)(gmix + 256 * j + 4 * lane);
#define P0_LOAD(j_, v_) do { const GAS f32x4* xr_ = (const GAS f32x4*)(x + (size_t)(gw + (j_) * NGW) * DM) + lane; v_[0] = xr_[0]; v_[1] = xr_[64]; v_[2] = xr_[128]; v_[3] = xr_[192]; } while (0)
#define P0_DONE(j_, v_) do { const int m = gw + (j_) * NGW; float s = 0.f; \
        _Pragma("unroll") for (int j = 0; j < 4; ++j) s += (v_[j].x * v_[j].x + v_[j].y * v_[j].y) + (v_[j].z * v_[j].z + v_[j].w * v_[j].w); \
        const float rms = sqrtf(wave_sum(s) * (1.f / DM) + RMS_EPS); const float rstd = 1.0f / rms; \
        if (lane == 0) ((float*)(ws + WS_RMS))[m] = rms;        \
        GAS u32x2* o8 = (GAS u32x2*)(XN + (size_t)m * DM) + lane; GAS unsigned* o4 = (GAS unsigned*)(ws + WS_XN8 + (size_t)m * DM) + lane;        \
        _Pragma("unroll") for (int j = 0; j < 4; ++j) { const f32x4 y = {v_[j].x * rstd * gm[j].x, v_[j].y * rstd * gm[j].y, v_[j].z * rstd * gm[j].z, v_[j].w * rstd * gm[j].w}; \
            u32x2 o; o.x = pk2(y.x, y.y); o.y = pk2(y.z, y.w); o8[64 * j] = o; o4[64 * j] = pack4_fp8(y.x * F8S_H, y.y * F8S_H, y.z * F8S_H, y.w * F8S_H); } } while (0)
#define P0_BODY(j_) do { const int j1 = min((j_) + 1, cnt - 1), j2 = min((j_) + 2, cnt - 1); \
        P0_LOAD(j1, vB); __builtin_amdgcn_sched_barrier(0); asm volatile("" ::: "memory"); \
        P0_DONE((j_), vA); \
        P0_LOAD(j2, vA); __builtin_amdgcn_sched_barrier(0); asm volatile("" ::: "memory"); \
        P0_DONE(j1, vB); } while (0)
    if (gw < M) {
        const int cnt = (M - gw + NGW - 1) / NGW;
        f32x4 vA[4], vB[4];
        P0_LOAD(0, vA);
        P0_BODY(0);
#pragma unroll 1
        for (int j = 2; j < cnt; j += 2) P0_BODY(j);
    }
#undef P0_BODY
#undef P0_DONE
#undef P0_LOAD
    for (int it = gw; it < NITEMS; it += NGW) {
        int r = it;
        if (r < I_IN) { const int kb = r / 172, nb = r % 172; const int sc_ = 32 * nb;
            if (sc_ < C_LWF) p0_transpose_item(a.in[I_WIN], 1024, IN_COLS, (bf16*)(ws + WS_WIN), 64 * kb, sc_, sc_, scr, lane);
            else p0_transpose_item_f8(a.in[I_WIN], IN_COLS, ws + WS_WIN8, 64 * kb, sc_, sc_ < C_PAD ? sc_ : sc_ + 128, scr, lane);
            continue; } r -= I_IN;
        if (r < I_AB) { const int kb = r / 32, nb = r % 32; p0_transpose_item_f8(a.in[I_WA], 1024, ws + WS_WA, 64 * kb, 32 * nb, 32 * nb, scr, lane, 512); continue; } r -= I_AB;
        if (r < I_AB) { const int kb = r / 32, nb = r % 32; p0_transpose_item_f8(a.in[I_WB], 1024, ws + WS_WB, 64 * kb, 32 * nb, 32 * nb, scr, lane, 512); continue; } r -= I_AB;
        { const int kb = r / 32, nb = r % 32; p0_transpose_item_f8(a.in[I_WO], 1024, ws + WS_WO, 64 * kb, 32 * nb, 32 * nb, scr, lane); }
    }
    { GAS u32x4* z = (GAS u32x4*)(ws + WS_WIN8 + (size_t)C_PAD * 1024);
      for (int i = blockIdx.x * 512 + tid; i < 8192; i += G * 512) z[i] = (u32x4){0u, 0u, 0u, 0u}; }
}

__device__ __forceinline__ f32x4 shift4(u32x2 pc, u32x2 pp, u32x2 pn, f32x4 mup, f32x4 mun) {
    f32x4 c = {bflo(pc.x), bfhi(pc.x), bflo(pc.y), bfhi(pc.y)}, p = {bflo(pp.x), bfhi(pp.x), bflo(pp.y), bfhi(pp.y)}, n = {bflo(pn.x), bfhi(pn.x), bflo(pn.y), bfhi(pn.y)};
    return c + mup * (p - c) + mun * (n - c);
}
__device__ __forceinline__ float fma_s(float a, float b, float c) { float r; asm("v_fma_f32 %0, %1, %2, %3" : "=v"(r) : "v"(a), "v"(b), "v"(c)); return r; }
__device__ __forceinline__ float mul_s(float a, float b) { float r; asm("v_mul_f32_e32 %0, %1, %2" : "=v"(r) : "v"(a), "v"(b)); return r; }
__device__ __forceinline__ float add_s(float a, float b) { float r; asm("v_add_f32_e32 %0, %1, %2" : "=v"(r) : "v"(a), "v"(b)); return r; }
__device__ __forceinline__ float dot4_s(const float (&s)[4], const f32x4 v) { const float m0 = mul_s(s[0], v[0]), m2 = mul_s(s[2], v[2]); return add_s(fma_s(s[1], v[1], m0), fma_s(s[3], v[3], m2)); }
__device__ __forceinline__ void dpp_sum16_x4(float& a, float& b, float& c, float& d) {
    asm("s_nop 1\n\t"
        "v_add_f32_dpp %0, %0, %0 quad_perm:[1,0,3,2] row_mask:0xf bank_mask:0xf\n\t"
        "v_add_f32_dpp %1, %1, %1 quad_perm:[1,0,3,2] row_mask:0xf bank_mask:0xf\n\t"
        "v_add_f32_dpp %2, %2, %2 quad_perm:[1,0,3,2] row_mask:0xf bank_mask:0xf\n\t"
        "v_add_f32_dpp %3, %3, %3 quad_perm:[1,0,3,2] row_mask:0xf bank_mask:0xf\n\t"
        "v_add_f32_dpp %0, %0, %0 quad_perm:[2,3,0,1] row_mask:0xf bank_mask:0xf\n\t"
        "v_add_f32_dpp %1, %1, %1 quad_perm:[2,3,0,1] row_mask:0xf bank_mask:0xf\n\t"
        "v_add_f32_dpp %2, %2, %2 quad_perm:[2,3,0,1] row_mask:0xf bank_mask:0xf\n\t"
        "v_add_f32_dpp %3, %3, %3 quad_perm:[2,3,0,1] row_mask:0xf bank_mask:0xf\n\t"
        "v_add_f32_dpp %0, %0, %0 row_half_mirror row_mask:0xf bank_mask:0xf\n\t"
        "v_add_f32_dpp %1, %1, %1 row_half_mirror row_mask:0xf bank_mask:0xf\n\t"
        "v_add_f32_dpp %2, %2, %2 row_half_mirror row_mask:0xf bank_mask:0xf\n\t"
        "v_add_f32_dpp %3, %3, %3 row_half_mirror row_mask:0xf bank_mask:0xf\n\t"
        "v_add_f32_dpp %0, %0, %0 row_mirror row_mask:0xf bank_mask:0xf\n\t"
        "v_add_f32_dpp %1, %1, %1 row_mirror row_mask:0xf bank_mask:0xf\n\t"
        "v_add_f32_dpp %2, %2, %2 row_mirror row_mask:0xf bank_mask:0xf\n\t"
        "v_add_f32_dpp %3, %3, %3 row_mirror row_mask:0xf bank_mask:0xf\n\t"
        "s_nop 0"
        : "+v"(a), "+v"(b), "+v"(c), "+v"(d));
}
#define LDS_BARRIER() do { asm volatile("s_waitcnt lgkmcnt(0)" ::: "memory"); __builtin_amdgcn_s_barrier(); asm volatile("" ::: "memory"); } while (0)
#define WAVE_LDS_SYNC() do { asm volatile("s_waitcnt lgkmcnt(0)" ::: "memory"); __builtin_amdgcn_wave_barrier(); asm volatile("" ::: "memory"); } while (0)
typedef short s16x4 __attribute__((ext_vector_type(4)));
typedef __bf16 bf16x2_t __attribute__((ext_vector_type(2)));
__device__ __forceinline__ unsigned cvtpk2(float lo, float hi) { const f32x2 v = {lo, hi}; const bf16x2_t b = __builtin_convertvector(v, bf16x2_t); return __builtin_bit_cast(unsigned, b); }
__device__ __forceinline__ s16x4 f4_to_bf4(const f32x4 v) { u32x2 w; w.x = cvtpk2(v[0], v[1]); w.y = cvtpk2(v[2], v[3]); return __builtin_bit_cast(s16x4, w); }
__device__ __forceinline__ f32x4 mfma16(s16x4 a, s16x4 b, f32x4 c) { return __builtin_amdgcn_mfma_f32_16x16x16bf16_1k(a, b, c, 0, 0, 0); }
__device__ __forceinline__ s16x4 lds_tr4(const LAS unsigned char* p) { return __builtin_bit_cast(s16x4, __builtin_amdgcn_ds_read_tr16_b64_v4i16((LAS s16x4*)p)); }
template <int CTRL> __device__ __forceinline__ float dpp0f(float x) { return __builtin_bit_cast(float, __builtin_amdgcn_update_dpp(0, __builtin_bit_cast(int, x), CTRL, 0xF, 0xF, true)); }
template <int CTRL> __device__ __forceinline__ float dpp1f(float x) { return __builtin_bit_cast(float, __builtin_amdgcn_update_dpp(0x3f800000, __builtin_bit_cast(int, x), CTRL, 0xF, 0xF, false)); }
__device__ __forceinline__ void row_scanmul16_x4(float& a, float& b, float& c, float& d) {
    asm("s_nop 1\n\t"
        "v_mul_f32_dpp %0, %0, %0 row_shr:1 row_mask:0xf bank_mask:0xf\n\t" "v_mul_f32_dpp %1, %1, %1 row_shr:1 row_mask:0xf bank_mask:0xf\n\t"
        "v_mul_f32_dpp %2, %2, %2 row_shr:1 row_mask:0xf bank_mask:0xf\n\t" "v_mul_f32_dpp %3, %3, %3 row_shr:1 row_mask:0xf bank_mask:0xf\n\t"
        "v_mul_f32_dpp %0, %0, %0 row_shr:2 row_mask:0xf bank_mask:0xf\n\t" "v_mul_f32_dpp %1, %1, %1 row_shr:2 row_mask:0xf bank_mask:0xf\n\t"
        "v_mul_f32_dpp %2, %2, %2 row_shr:2 row_mask:0xf bank_mask:0xf\n\t" "v_mul_f32_dpp %3, %3, %3 row_shr:2 row_mask:0xf bank_mask:0xf\n\t"
        "v_mul_f32_dpp %0, %0, %0 row_shr:4 row_mask:0xf bank_mask:0xf\n\t" "v_mul_f32_dpp %1, %1, %1 row_shr:4 row_mask:0xf bank_mask:0xf\n\t"
        "v_mul_f32_dpp %2, %2, %2 row_shr:4 row_mask:0xf bank_mask:0xf\n\t" "v_mul_f32_dpp %3, %3, %3 row_shr:4 row_mask:0xf bank_mask:0xf\n\t"
        "v_mul_f32_dpp %0, %0, %0 row_shr:8 row_mask:0xf bank_mask:0xf\n\t" "v_mul_f32_dpp %1, %1, %1 row_shr:8 row_mask:0xf bank_mask:0xf\n\t"
        "v_mul_f32_dpp %2, %2, %2 row_shr:8 row_mask:0xf bank_mask:0xf\n\t" "v_mul_f32_dpp %3, %3, %3 row_shr:8 row_mask:0xf bank_mask:0xf\n\t"
        "s_nop 0"
        : "+v"(a), "+v"(b), "+v"(c), "+v"(d));
}
__device__ __forceinline__ float row_scanmul16(float x) { x *= dpp1f<0x111>(x); x *= dpp1f<0x112>(x); x *= dpp1f<0x114>(x); x *= dpp1f<0x118>(x); return x; }

struct ConvItem { const float* src; unsigned char* dst; int N; };
__device__ __forceinline__ ConvItem conv_decode(const Args& a, int id) {
    unsigned char* ws = a.ws; ConvItem c;
    if (id < 65536) { const int e = id >> 11, r = id & 2047, kb = r >> 7, nb = r & 127; const int c0 = 16 * nb;
        const int drow = 256 * ((c0 & 1023) >> 7) + 128 * (c0 >> 10) + (c0 & 127);
        c.src = a.in[I_W1] + (size_t)e * 1024 * 2048 + (size_t)(64 * kb) * 2048 + c0; c.dst = ws + WS_W1 + (size_t)e * 2048 * 1024 + (size_t)drow * 1024 + 64 * kb; c.N = 2048;
    } else { const int r2 = id - 65536; const int e = r2 >> 10, r = r2 & 1023, kb = r >> 6, nb = r & 63;
        c.src = a.in[I_W2] + (size_t)e * 1024 * 1024 + (size_t)(64 * kb) * 1024 + 16 * nb; c.dst = ws + WS_W2 + (size_t)e * 1024 * 1024 + (size_t)(16 * nb) * 1024 + 64 * kb; c.N = 1024; }
    return c;
}
__device__ __forceinline__ void conv_load(const ConvItem& c, float (&v)[16], int lane) {
    const float* p = c.src + (size_t)(lane >> 2) * c.N + 4 * (lane & 3);
#pragma unroll
    for (int j = 0; j < 4; ++j) { const f32x4 t = *(const f32x4*)(p + (size_t)(16 * j) * c.N); v[4 * j] = t[0]; v[4 * j + 1] = t[1]; v[4 * j + 2] = t[2]; v[4 * j + 3] = t[3]; }
}
__device__ __forceinline__ void conv_store(const ConvItem& c, const float (&v)[16], LAS float* scr, int lane) {
#pragma unroll
    for (int j = 0; j < 4; ++j) *(LAS f32x4*)(scr + (16 * j + (lane >> 2)) * 20 + 16 * j + 4 * (lane & 3)) = (f32x4){v[4 * j], v[4 * j + 1], v[4 * j + 2], v[4 * j + 3]};
    asm volatile("s_waitcnt lgkmcnt(0)" ::: "memory"); __builtin_amdgcn_wave_barrier();
    const int n = lane >> 2, q = lane & 3; const LAS float* s = scr + (16 * q) * 20 + 16 * q + n;
    u32x4 o0;
    o0.x = pack4_fp8(s[0 * 20] * F8S_W, s[1 * 20] * F8S_W, s[2 * 20] * F8S_W, s[3 * 20] * F8S_W); o0.y = pack4_fp8(s[4 * 20] * F8S_W, s[5 * 20] * F8S_W, s[6 * 20] * F8S_W, s[7 * 20] * F8S_W);
    o0.z = pack4_fp8(s[8 * 20] * F8S_W, s[9 * 20] * F8S_W, s[10 * 20] * F8S_W, s[11 * 20] * F8S_W); o0.w = pack4_fp8(s[12 * 20] * F8S_W, s[13 * 20] * F8S_W, s[14 * 20] * F8S_W, s[15 * 20] * F8S_W);
    *(u32x4*)(c.dst + (size_t)n * 1024 + 16 * q) = o0;
    asm volatile("s_waitcnt lgkmcnt(0)" ::: "memory"); __builtin_amdgcn_wave_barrier();
}
constexpr int SC_W2T = 0, SC_A2T = 9216, SC_PRM = 18432, SC_PRIV = 22528, SC_PP = 13312, SC_HAND = 75776, SC_HP = 13056;
constexpr int HO_KAP = 0, HO_RT = 2304, HO_KDG = 4608, HO_VV = 6912, HO_BMT = 9216, HO_MBT = 9728, HO_N1T = 10240, HO_TBT = 10752, HO_GC = 12800;
constexpr int PV_XA = 0, PV_LOUT = 0, PV_BT = 8704, PV_KD = 11008, LOP = 68;
struct Raw6 { u32x4 c0, c1, h0, h1; };
__device__ __forceinline__ void scan_load_seg(Raw6& R, const bf16* prow, int col, bool hp, bool hn, int li, int dir) {
    R.c0 = *(const u32x4*)(prow + col); R.c1 = *(const u32x4*)(prow + col + 8);
    R.h0 = (u32x4){0u, 0u, 0u, 0u}; R.h1 = R.h0;
    const bool wantprev = (li == 0) ? (dir == 0) : (dir != 0);
    if ((li == 0 || li == 15) && (wantprev ? hp : hn)) { const bf16* hr = wantprev ? prow - PN : prow + PN; R.h0 = *(const u32x4*)(hr + col); R.h1 = *(const u32x4*)(hr + col + 8); }
}
template <int CTRL> __device__ __forceinline__ unsigned dpp_nbr(unsigned cur, unsigned halo) { return (unsigned)__builtin_amdgcn_update_dpp((int)halo, (int)cur, CTRL, 0xF, 0xF, false); }
template <int DIR> __device__ __forceinline__ f32x4 scan_shift4_t(const Raw6& R, int q4, const LAS float* mup, const LAS float* mun) {
    const unsigned c0 = q4 == 0 ? R.c0.x : q4 == 1 ? R.c0.z : q4 == 2 ? R.c1.x : R.c1.z, c1 = q4 == 0 ? R.c0.y : q4 == 1 ? R.c0.w : q4 == 2 ? R.c1.y : R.c1.w;
    const unsigned h0 = q4 == 0 ? R.h0.x : q4 == 1 ? R.h0.z : q4 == 2 ? R.h1.x : R.h1.z, h1 = q4 == 0 ? R.h0.y : q4 == 1 ? R.h0.w : q4 == 2 ? R.h1.y : R.h1.w;
    constexpr int CP = DIR ? 0x101 : 0x111, CN = DIR ? 0x111 : 0x101;
    const unsigned p0 = dpp_nbr<CP>(c0, h0), p1 = dpp_nbr<CP>(c1, h1), n0 = dpp_nbr<CN>(c0, h0), n1 = dpp_nbr<CN>(c1, h1);
    const f32x4 mp = *(const LAS f32x4*)(mup + 4 * q4), mn = *(const LAS f32x4*)(mun + 4 * q4);
    const f32x4 cv = {bflo(c0), bfhi(c0), bflo(c1), bfhi(c1)}, pv = {bflo(p0), bfhi(p0), bflo(p1), bfhi(p1)}, nv = {bflo(n0), bfhi(n0), bflo(n1), bfhi(n1)};
    return cv + mp * (pv - cv) + mn * (nv - cv);
}
template <int DIR> __device__ __forceinline__ f32x4 scan_shift4_v(const Raw6& R, int q4, const f32x4 mp, const f32x4 mn) {
    const unsigned c0 = q4 == 0 ? R.c0.x : q4 == 1 ? R.c0.z : q4 == 2 ? R.c1.x : R.c1.z, c1 = q4 == 0 ? R.c0.y : q4 == 1 ? R.c0.w : q4 == 2 ? R.c1.y : R.c1.w;
    const unsigned h0 = q4 == 0 ? R.h0.x : q4 == 1 ? R.h0.z : q4 == 2 ? R.h1.x : R.h1.z, h1 = q4 == 0 ? R.h0.y : q4 == 1 ? R.h0.w : q4 == 2 ? R.h1.y : R.h1.w;
    constexpr int CP = DIR ? 0x101 : 0x111, CN = DIR ? 0x111 : 0x101;
    const unsigned p0 = dpp_nbr<CP>(c0, h0), p1 = dpp_nbr<CP>(c1, h1), n0 = dpp_nbr<CN>(c0, h0), n1 = dpp_nbr<CN>(c1, h1);
    const f32x4 cv = {bflo(c0), bfhi(c0), bflo(c1), bfhi(c1)}, pv = {bflo(p0), bfhi(p0), bflo(p1), bfhi(p1)}, nv = {bflo(n0), bfhi(n0), bflo(n1), bfhi(n1)};
    return cv + mp * (pv - cv) + mn * (nv - cv);
}
#define PRM_LOAD4(dst, off, row) do { _Pragma("unroll") for (int q_ = 0; q_ < 4; ++q_) dst[(off) + q_] = *(const LAS f32x4*)(prm + (row) * 64 + 4 * q_); } while (0)
__device__ __forceinline__ f32x4 scan_shift4(const Raw6& R, int q4, const LAS float* mup, const LAS float* mun, int dir) { return dir ? scan_shift4_t<1>(R, q4, mup, mun) : scan_shift4_t<0>(R, q4, mup, mun); }
__device__ __forceinline__ void scan_shift16(float (&x)[16], const Raw6& R, const LAS float* mup, const LAS float* mun, int dir) {
#pragma unroll
    for (int q4 = 0; q4 < 4; ++q4) { const f32x4 v = scan_shift4(R, q4, mup, mun, dir); x[4 * q4] = v[0]; x[4 * q4 + 1] = v[1]; x[4 * q4 + 2] = v[2]; x[4 * q4 + 3] = v[3]; }
}
__device__ __forceinline__ void scan_store4_bf(LAS unsigned char* dst, const f32x4 v) { u32x2 w; w.x = cvtpk2(v[0], v[1]); w.y = cvtpk2(v[2], v[3]); *(LAS u32x2*)dst = w; }
__device__ __forceinline__ void scan_store16_bf(LAS unsigned char* dst, const float (&x)[16]) {
    u32x4 w0, w1; w0.x = cvtpk2(x[0], x[1]); w0.y = cvtpk2(x[2], x[3]); w0.z = cvtpk2(x[4], x[5]); w0.w = cvtpk2(x[6], x[7]); w1.x = cvtpk2(x[8], x[9]); w1.y = cvtpk2(x[10], x[11]); w1.z = cvtpk2(x[12], x[13]); w1.w = cvtpk2(x[14], x[15]);
    *(LAS u32x4*)dst = w0; *(LAS u32x4*)(dst + 16) = w1;
}
__device__ __forceinline__ f32x4 scan_gram(const LAS unsigned char* X, const LAS unsigned char* Y, int li, int g) {
    f32x4 c = {0.f, 0.f, 0.f, 0.f};
    const bf16x8 a0 = *(const LAS bf16x8*)(X + li * 144 + 16 * g), a1 = *(const LAS bf16x8*)(X + li * 144 + 64 + 16 * g);
    const bf16x8 b0 = *(const LAS bf16x8*)(Y + li * 144 + 16 * g), b1 = *(const LAS bf16x8*)(Y + li * 144 + 64 + 16 * g);
    c = __builtin_amdgcn_mfma_f32_16x16x32_bf16(a0, b0, c, 0, 0, 0); c = __builtin_amdgcn_mfma_f32_16x16x32_bf16(a1, b1, c, 0, 0, 0);
    return c;
}

template <int DIR> __device__ __forceinline__ void phase_scan_unit_t(const Args& a, LAS unsigned char* lds, int unit) {
    const int tid = threadIdx.x, lane = tid & 63, wid = __builtin_amdgcn_readfirstlane(tid >> 6), li = lane & 15, g = lane >> 4;
    const int b = unit >> 4, h = (unit >> 1) & 7; constexpr int dir = DIR;
    unsigned char* ws = a.ws;
    const bf16* P = (const bf16*)(ws + WS_P);
    bf16* Odir = (bf16*)(ws + (dir ? WS_OB : WS_OF));
    float* CFB = (float*)(ws + WS_CFB);
    LAS unsigned char* W2T = lds + SC_W2T; LAS unsigned char* A2T = lds + SC_A2T; LAS float* PRM = (LAS float*)(lds + SC_PRM);
    Raw6 rw, ra, rk, rr;
    Raw6 rvv;
    ConvItem cv0, cv1, cv2; float v0[16], v1[16], v2[16];
    if (wid >= 4) { const int pw_ = wid - 4; const int t0_ = dir ? (SEQ - 1 - (16 * pw_ + li)) : (16 * pw_ + li); const bf16* pr0 = P + ((size_t)b * SEQ + t0_) * PN; const bool hp0 = t0_ > 0, hn0 = t0_ < SEQ - 1;
        scan_load_seg(rw, pr0, C_LWF + dir * 64 + 16 * g, hp0, hn0, li, dir); scan_load_seg(ra, pr0, C_LAF + dir * 64 + 16 * g, hp0, hn0, li, dir);
        scan_load_seg(rk, pr0, C_K + h * 64 + 16 * g, hp0, hn0, li, dir); scan_load_seg(rr, pr0, C_R + h * 64 + 16 * g, hp0, hn0, li, dir);
    } else { const int vt_ = wid; const int t0_ = dir ? (SEQ - 1 - (16 * vt_ + li)) : (16 * vt_ + li); scan_load_seg(rvv, P + ((size_t)b * SEQ + t0_) * PN, C_V + h * 64 + 16 * g, t0_ > 0, t0_ < SEQ - 1, li, dir);
        const int cb0 = (((int)blockIdx.x * 4 + vt_) * 32) * 3; cv0 = conv_decode(a, cb0); cv1 = conv_decode(a, cb0 + 1); cv2 = conv_decode(a, cb0 + 2);
        conv_load(cv0, v0, lane); conv_load(cv1, v1, lane); conv_load(cv2, v2, lane); }
    __syncthreads();
    {   const float* w2 = a.in[dir ? I_W2B : I_W2F]; const float* a2 = a.in[dir ? I_A2B : I_A2F];
#pragma unroll
        for (int i = 0; i < 8; ++i) { const int idx = tid + 512 * i, j = idx >> 6, n = idx & 63;
            const int pr_ = 16 * ((n >> 2) & 3) + 4 * (n >> 4) + (n & 3);
            *(LAS unsigned short*)(W2T + pr_ * 144 + j * 2) = (unsigned short)f2bf(w2[j * 512 + h * 64 + n]);
            *(LAS unsigned short*)(A2T + pr_ * 144 + j * 2) = (unsigned short)f2bf(a2[j * 512 + h * 64 + n]); }
        const int segb[5] = {C_R + h * 64, C_K + h * 64, C_V + h * 64, C_LWF + dir * 64, C_LAF + dir * 64};
        for (int i = tid; i < 15 * 64; i += 512) { const int row = i >> 6, col = i & 63; float v;
            if (row < 5) v = a.in[I_MUP][segb[row] + col]; else if (row < 10) v = a.in[I_MUN][segb[row - 5] + col];
            else if (row == 10) v = a.in[dir ? I_W0B : I_W0F][h * 64 + col]; else if (row == 11) v = a.in[dir ? I_A0B : I_A0F][h * 64 + col];
            else if (row == 12) v = a.in[I_KK][h * 64 + col]; else if (row == 13) v = a.in[I_KA][h * 64 + col]; else v = a.in[I_RK][h * 64 + col];
            PRM[i] = v; }
    }
    __syncthreads();
    if (wid >= 4) {
        const int pw = wid - 4;
        LAS unsigned char* PV = lds + SC_PRIV + pw * SC_PP;
        LAS unsigned char* HO = lds + SC_HAND + pw * SC_HP;
        LAS unsigned char* XA0 = PV + PV_XA; LAS unsigned char* XA1 = PV + PV_XA + 2304; LAS float* LOUT = (LAS float*)(PV + PV_LOUT);
        LAS unsigned char* BTm = PV + PV_BT; LAS unsigned char* KDm = PV + PV_KD;
        const LAS float* prm0 = PRM + 16 * g;
        const int cR = C_R + h * 64 + 16 * g, cK = C_K + h * 64 + 16 * g, cV = C_V + h * 64 + 16 * g, cLW = C_LWF + dir * 64 + 16 * g, cLA = C_LAF + dir * 64 + 16 * g;
#if STAMP_SEL >= 0
        unsigned stacc[8] = {0u, 0u, 0u, 0u, 0u, 0u, 0u, 0u}; unsigned long long stprev = __builtin_amdgcn_s_memrealtime();
#define STAMP(k) do { __builtin_amdgcn_sched_barrier(0); const unsigned long long tn_ = __builtin_amdgcn_s_memrealtime(); stacc[k] += (unsigned)(tn_ - stprev); stprev = tn_; __builtin_amdgcn_sched_barrier(0); } while (0)
#else
#define STAMP(k) do { } while (0)
#endif
#pragma unroll 1
        for (int bi = 0; bi < SEQ / 64; ++bi) {
#if SCAN_DBG == 1
            LDS_BARRIER(); LDS_BARRIER(); continue;
#endif
            int li_ = li, g_ = g; asm volatile("" : "+v"(li_), "+v"(g_));
            const int cidx = 4 * bi + pw;
            const int t = dir ? (SEQ - 1 - (16 * cidx + li_)) : (16 * cidx + li_);
            const size_t m = (size_t)b * SEQ + t;
            const bf16* prow = P + m * PN; const bool hp = t > 0, hn = t < SEQ - 1;
            const LAS float* prm = prm0; asm volatile("" : "+v"(prm));
            float av[16], eG[16];
            {
            f32x4 cw[4], ca[4];
            {
                bf16x8 bw0, bw1, ba0, ba1;
                {   float xl[16];
                    f32x4 pm[16]; PRM_LOAD4(pm, 0, 3); PRM_LOAD4(pm, 4, 8); PRM_LOAD4(pm, 8, 4); PRM_LOAD4(pm, 12, 9);
                    __builtin_amdgcn_sched_barrier(0);
#pragma unroll
                    for (int q4 = 0; q4 < 4; ++q4) { const f32x4 v = scan_shift4_v<DIR>(rw, q4, pm[q4], pm[4 + q4]); xl[4 * q4] = v[0]; xl[4 * q4 + 1] = v[1]; xl[4 * q4 + 2] = v[2]; xl[4 * q4 + 3] = v[3]; }
#pragma unroll
                    for (int j = 0; j < 16; ++j) xl[j] = fast_tanh(xl[j]);
                    u32x4 w; w.x = cvtpk2(xl[0], xl[1]); w.y = cvtpk2(xl[2], xl[3]); w.z = cvtpk2(xl[4], xl[5]); w.w = cvtpk2(xl[6], xl[7]); bw0 = __builtin_bit_cast(bf16x8, w);
                    w.x = cvtpk2(xl[8], xl[9]); w.y = cvtpk2(xl[10], xl[11]); w.z = cvtpk2(xl[12], xl[13]); w.w = cvtpk2(xl[14], xl[15]); bw1 = __builtin_bit_cast(bf16x8, w);
#pragma unroll
                    for (int q4 = 0; q4 < 4; ++q4) { const f32x4 v = scan_shift4_v<DIR>(ra, q4, pm[8 + q4], pm[12 + q4]); xl[4 * q4] = v[0]; xl[4 * q4 + 1] = v[1]; xl[4 * q4 + 2] = v[2]; xl[4 * q4 + 3] = v[3]; }
                    w.x = cvtpk2(xl[0], xl[1]); w.y = cvtpk2(xl[2], xl[3]); w.z = cvtpk2(xl[4], xl[5]); w.w = cvtpk2(xl[6], xl[7]); ba0 = __builtin_bit_cast(bf16x8, w);
                    w.x = cvtpk2(xl[8], xl[9]); w.y = cvtpk2(xl[10], xl[11]); w.z = cvtpk2(xl[12], xl[13]); w.w = cvtpk2(xl[14], xl[15]); ba1 = __builtin_bit_cast(bf16x8, w);
                }
                STAMP(0);
#pragma unroll
                for (int nt = 0; nt < 4; ++nt) {
                    const LAS unsigned char* aw = W2T + (16 * nt + li_) * 144 + 32 * g_; const LAS unsigned char* aa = A2T + (16 * nt + li_) * 144 + 32 * g_;
                    f32x4 c = {0.f, 0.f, 0.f, 0.f};
                    c = __builtin_amdgcn_mfma_f32_16x16x32_bf16(*(const LAS bf16x8*)aw, bw0, c, 0, 0, 0); c = __builtin_amdgcn_mfma_f32_16x16x32_bf16(*(const LAS bf16x8*)(aw + 16), bw1, c, 0, 0, 0); cw[nt] = c;
                    c = (f32x4){0.f, 0.f, 0.f, 0.f};
                    c = __builtin_amdgcn_mfma_f32_16x16x32_bf16(*(const LAS bf16x8*)aa, ba0, c, 0, 0, 0); c = __builtin_amdgcn_mfma_f32_16x16x32_bf16(*(const LAS bf16x8*)(aa + 16), ba1, c, 0, 0, 0); ca[nt] = c;
                }
            }
#if SCAN_DUP == 8
            for (int rp_ = 0; rp_ < 2; ++rp_) { asm volatile("" : "+v"(li_), "+v"(g_));
#else
            {
#endif
            STAMP(1);
            f32x4 pwa[8]; PRM_LOAD4(pwa, 0, 10); PRM_LOAD4(pwa, 4, 11);
            __builtin_amdgcn_sched_barrier(0);
#pragma unroll
            for (int q4 = 0; q4 < 4; ++q4) { const f32x4 dl = cw[q4], al = ca[q4];
                const f32x4 w0 = pwa[q4], a0 = pwa[4 + q4];
#pragma unroll
                for (int e = 0; e < 4; ++e) { const int j = 4 * q4 + e; eG[j] = __expf(-DECAY_SCALE * fast_sigmoid(w0[e] + dl[e])); av[j] = fast_sigmoid(a0[e] + al[e]); }
                row_scanmul16_x4(eG[4 * q4], eG[4 * q4 + 1], eG[4 * q4 + 2], eG[4 * q4 + 3]); }
            }
            }
            STAMP(2);
            LAS float* GC = (LAS float*)(HO + HO_GC);
            LAS unsigned char* HPa = HO + li_ * 144 + 32 * g_; LAS unsigned char* HPb = HO + li_ * 32 + g_ * 8;
            asm volatile("" : "+v"(HPa), "+v"(HPb));
            float kdv[16]; u32x2 prt[4]; f32x4 krr[4]; float inv;
#if SCAN_DUP == 5
            for (int rp_ = 0; rp_ < 2; ++rp_) { asm volatile("" : "+v"(li_), "+v"(g_));
#else
            {
#endif
            {   float ss = 0.f;
                f32x4 pk[16]; PRM_LOAD4(pk, 0, 1); PRM_LOAD4(pk, 4, 6); PRM_LOAD4(pk, 8, 12); PRM_LOAD4(pk, 12, 13);
                __builtin_amdgcn_sched_barrier(0);
#pragma unroll
                for (int q4 = 0; q4 < 4; ++q4) { const f32x4 xk = scan_shift4_v<DIR>(rk, q4, pk[q4], pk[4 + q4]); const f32x4 kr = xk * pk[8 + q4]; krr[q4] = kr; ss += (kr[0] * kr[0] + kr[1] * kr[1]) + (kr[2] * kr[2] + kr[3] * kr[3]);
#pragma unroll
                    for (int e = 0; e < 4; ++e) { const int j = 4 * q4 + e; kdv[j] = xk[e] * (1.0f + (av[j] - 1.0f) * pk[12 + q4][e]); } }
                ss += __shfl_xor(ss, 16); ss += __shfl_xor(ss, 32);
                inv = __builtin_amdgcn_rcpf(fmaxf(sqrtf(ss), 1e-12f));
            }
            {   float cb = 0.f;
                f32x4 pr[12]; PRM_LOAD4(pr, 0, 0); PRM_LOAD4(pr, 4, 5); PRM_LOAD4(pr, 8, 14);
                __builtin_amdgcn_sched_barrier(0);
#pragma unroll
                for (int q4 = 0; q4 < 4; ++q4) { f32x4 xr = scan_shift4_v<DIR>(rr, q4, pr[q4], pr[4 + q4]); const f32x4 rk4 = pr[8 + q4];
#pragma unroll
                    for (int e = 0; e < 4; ++e) { const int j = 4 * q4 + e; cb += xr[e] * kdv[j] * rk4[e]; xr[e] *= eG[j]; }
                    prt[q4].x = cvtpk2(xr[0], xr[1]); prt[q4].y = cvtpk2(xr[2], xr[3]); }
                cb += __shfl_xor(cb, 16); cb += __shfl_xor(cb, 32);
                if (g_ == 0) CFB[m * 16 + h * 2 + dir] = cb;
            }
            LDS_BARRIER();
            STAMP(3);
            if (li_ == 15) {
#pragma unroll
                for (int q4 = 0; q4 < 4; ++q4) *(LAS f32x4*)(GC + 16 * g_ + 4 * q4) = (f32x4){eG[4 * q4], eG[4 * q4 + 1], eG[4 * q4 + 2], eG[4 * q4 + 3]};
            }
#pragma unroll
            for (int q4 = 0; q4 < 4; ++q4) *(LAS u32x2*)(HPa + HO_RT + 8 * q4) = prt[q4];
#pragma unroll
            for (int q4 = 0; q4 < 4; ++q4) {
                f32x4 okap, obt, okd, okdg;
#pragma unroll
                for (int e = 0; e < 4; ++e) { const int j = 4 * q4 + e; const float kappa = krr[q4][e] * inv; const float eGm = dpp1f<0x111>(eG[j]), enG = __builtin_amdgcn_rcpf(eG[j]);
                    const float kd = kdv[j];
                    const float gcj = __int_as_float(__builtin_amdgcn_update_dpp(0, __float_as_int(eG[j]), 0x15F, 0xF, 0xF, false));
                    okap[e] = kappa * eGm; obt[e] = kappa * av[j] * enG; okd[e] = kd * enG; okdg[e] = kd * enG * gcj; }
                scan_store4_bf(HPa + HO_KAP + 8 * q4, okap); scan_store4_bf(BTm + li_ * 144 + 32 * g_ + 8 * q4, obt);
                scan_store4_bf(KDm + li_ * 144 + 32 * g_ + 8 * q4, okd); scan_store4_bf(HPa + HO_KDG + 8 * q4, okdg);
            }
            }
            STAMP(4);
            {
                const int cn = (bi + 1 < SEQ / 64) ? cidx + 4 : cidx;
                const int tn = dir ? (SEQ - 1 - (16 * cn + li_)) : (16 * cn + li_); const bf16* prn = P + ((size_t)b * SEQ + tn) * PN;
                const bool hpn = tn > 0, hnn = tn < SEQ - 1;
                scan_load_seg(rw, prn, cLW, hpn, hnn, li_, dir); scan_load_seg(ra, prn, cLA, hpn, hnn, li_, dir); scan_load_seg(rk, prn, cK, hpn, hnn, li_, dir); scan_load_seg(rr, prn, cR, hpn, hnn, li_, dir); }
            WAVE_LDS_SYNC();
#if SCAN_DUP == 3
            for (int rp_ = 0; rp_ < 2; ++rp_) { asm volatile("" : "+v"(li_), "+v"(g_));
#else
            {
#endif
            f32x4 Lc = scan_gram(BTm, HO + HO_KAP, li_, g_), Lr = scan_gram(HO + HO_KAP, BTm, li_, g_), Bmc = scan_gram(KDm, HO + HO_KAP, li_, g_), MAc = scan_gram(BTm, HO + HO_RT, li_, g_), MBc = scan_gram(KDm, HO + HO_RT, li_, g_);
            f32x4 Ic;
#pragma unroll
            for (int rg = 0; rg < 4; ++rg) { const int i = 4 * g_ + rg;
                if (!(i < li_)) { Lc[rg] = 0.f; Bmc[rg] = 0.f; }
                if (!(li_ < i)) Lr[rg] = 0.f;
                if (!(i <= li_)) { MAc[rg] = 0.f; MBc[rg] = 0.f; }
                Ic[rg] = (i == li_) ? 1.0f : 0.f; }
            const f32x4 z4 = {0.f, 0.f, 0.f, 0.f};
            const s16x4 L1c = f4_to_bf4(Lc), L1r = f4_to_bf4(Lr);
            const f32x4 L2cf = mfma16(L1r, L1c, z4), L2rf = mfma16(L1c, L1r, z4);
            const s16x4 L2c = f4_to_bf4(L2cf), L2r = f4_to_bf4(L2rf);
            const f32x4 L4cf = mfma16(L2r, L2c, z4), L4rf = mfma16(L2c, L2r, z4);
            const s16x4 L4c = f4_to_bf4(L4cf), L4r = f4_to_bf4(L4rf);
            const f32x4 L8cf = mfma16(L4r, L4c, z4), L8rf = mfma16(L4c, L4r, z4);
            const s16x4 P1c = f4_to_bf4(Ic - Lc), P2r = f4_to_bf4(Ic + L2rf), P4c = f4_to_bf4(Ic + L4cf), P4r = f4_to_bf4(Ic + L4rf), P8c = f4_to_bf4(Ic + L8cf), P8r = f4_to_bf4(Ic + L8rf);
            const s16x4 T12r = f4_to_bf4(mfma16(P1c, P2r, z4));
            const s16x4 T48c = f4_to_bf4(mfma16(P4r, P8c, z4));
            const s16x4 Tr = f4_to_bf4(mfma16(T48c, T12r, z4));
            const f32x4 N1c = mfma16(Tr, f4_to_bf4(MAc), z4);
            *(LAS s16x4*)(HPb + HO_BMT) = f4_to_bf4(Bmc);
            *(LAS s16x4*)(HPb + HO_MBT) = f4_to_bf4(MBc);
            *(LAS s16x4*)(HPb + HO_N1T) = f4_to_bf4(-N1c);
#pragma unroll
            for (int kt = 0; kt < 4; ++kt) {
                const s16x4 bb = lds_tr4(BTm + (4 * g_ + (li_ >> 2)) * 144 + (16 * kt + 4 * (li_ & 3)) * 2);
                f32x4 d = mfma16(Tr, bb, z4);
                const float gck = -GC[16 * kt + li_];
                d = d * gck;
                *(LAS s16x4*)(HPb + HO_TBT + 512 * kt) = f4_to_bf4(d);
            }
            }
            STAMP(5);
            LDS_BARRIER();
            STAMP(6);
        }
#if STAMP_SEL >= 0
        if (blockIdx.x == 0 && pw == 0 && lane == 0) { float tot = 0.f; for (int k = 0; k < 7; ++k) tot += (float)stacc[k]; float* stp = (float*)(ws + WS_GW); for (int k = 0; k < 7; ++k) stp[k] = floorf((float)stacc[k] / tot * 16.0f + 0.5f) * (1.0f / 16.0f); stp[7] = floorf(tot * 0.01f / 32.0f + 0.5f); }
#endif
    } else {
        const int vt = wid;
        f32x4 St[4];
#pragma unroll
        for (int kt = 0; kt < 4; ++kt) St[kt] = (f32x4){0.f, 0.f, 0.f, 0.f};
        const int cVc = C_V + h * 64 + 16 * g;
#pragma unroll 1
        for (int bi = 0; bi < SEQ / 64; ++bi) {
            LDS_BARRIER();
            {
                {   const int tv = dir ? (SEQ - 1 - (16 * (4 * bi + vt) + li)) : (16 * (4 * bi + vt) + li); const bool hpv = tv > 0, hnv = tv < SEQ - 1;
                    LAS unsigned char* HOv = lds + SC_HAND + vt * SC_HP; const LAS float* prmv = PRM + 16 * g;
#pragma unroll
                    for (int q4 = 0; q4 < 4; ++q4) scan_store4_bf(HOv + HO_VV + li * 144 + 32 * g + 8 * q4, scan_shift4(rvv, q4, prmv + 2 * 64, prmv + 7 * 64, dir));
                    const int cn = (bi + 1 < SEQ / 64) ? 4 * (bi + 1) + vt : 4 * bi + vt; const int tn = dir ? (SEQ - 1 - (16 * cn + li)) : (16 * cn + li);
                    scan_load_seg(rvv, P + ((size_t)b * SEQ + tn) * PN, cVc, tn > 0, tn < SEQ - 1, li, dir); }
                LAS float* cscr = (LAS float*)(lds + 128000 + vt * 5632);
                conv_store(cv0, v0, cscr, lane); conv_store(cv1, v1, cscr, lane); conv_store(cv2, v2, cscr, lane);
            }
            LDS_BARRIER();
            {   const int cbn = (((int)blockIdx.x * 4 + vt) * 32 + (bi + 1 < SEQ / 64 ? bi + 1 : bi)) * 3;
                cv0 = conv_decode(a, cbn); cv1 = conv_decode(a, cbn + 1); cv2 = conv_decode(a, cbn + 2);
                conv_load(cv0, v0, lane); conv_load(cv1, v1, lane); conv_load(cv2, v2, lane); }
#if SCAN_DBG == 2
            continue;
#endif
#pragma unroll 1
            for (int cc = 0; cc < 4; ++cc) {
                int li_ = li, g_ = g; asm volatile("" : "+v"(li_), "+v"(g_));
                const LAS unsigned char* HO = lds + SC_HAND + cc * SC_HP;
                const LAS float* GC = (const LAS float*)(HO + HO_GC);
#if SCAN_DUP == 4
                f32x4 Ssv[4] = {St[0], St[1], St[2], St[3]}; f32x4 O;
                for (int rp_ = 0; rp_ < 2; ++rp_) { asm volatile("" : "+v"(li_), "+v"(g_)); if (rp_ == 1) { St[0] = Ssv[0]; St[1] = Ssv[1]; St[2] = Ssv[2]; St[3] = Ssv[3]; }
#else
                f32x4 O;
                {
#endif
                s16x4 aK[4], aR[4], aTB[4], aKD[4]; f32x4 gcv[4];
                const LAS unsigned char* Ha = HO + li_ * 144 + g_ * 8; const LAS unsigned char* Hb = HO + li_ * 32 + g_ * 8;
                const LAS unsigned char* Hc = HO + (4 * g_ + (li_ >> 2)) * 144 + (4 * (li_ & 3)) * 2; const LAS unsigned char* Hg = HO + HO_GC + 16 * g_;
                asm volatile("" : "+v"(Ha), "+v"(Hb), "+v"(Hc), "+v"(Hg));
                const s16x4 Vt = lds_tr4(Hc + HO_VV + 32 * vt);
#pragma unroll
                for (int kt = 0; kt < 4; ++kt) { aK[kt] = *(const LAS s16x4*)(Ha + HO_KAP + 32 * kt); aR[kt] = *(const LAS s16x4*)(Ha + HO_RT + 32 * kt); }
                const s16x4 aBm = *(const LAS s16x4*)(Hb + HO_BMT), aMB = *(const LAS s16x4*)(Hb + HO_MBT), aN1 = *(const LAS s16x4*)(Hb + HO_N1T);
#pragma unroll
                for (int kt = 0; kt < 4; ++kt) { gcv[kt] = *(const LAS f32x4*)(Hg + 64 * kt); aTB[kt] = *(const LAS s16x4*)(Hb + HO_TBT + 512 * kt);
                    aKD[kt] = lds_tr4(Hc + HO_KDG + 32 * kt); }
                __builtin_amdgcn_sched_barrier(0);
                s16x4 Sb[4];
#pragma unroll
                for (int kt = 0; kt < 4; ++kt) Sb[kt] = f4_to_bf4(St[kt]);
                f32x4 X = {0.f, 0.f, 0.f, 0.f}; O = (f32x4){0.f, 0.f, 0.f, 0.f};
#pragma unroll
                for (int kt = 0; kt < 4; ++kt) { X = mfma16(aK[kt], Sb[kt], X); O = mfma16(aR[kt], Sb[kt], O); }
                X = mfma16(aBm, Vt, X);
                const s16x4 Xb = f4_to_bf4(X);
                O = mfma16(aMB, Vt, O); O = mfma16(aN1, Xb, O);
#pragma unroll
                for (int kt = 0; kt < 4; ++kt) {
                    f32x4 acc = St[kt] * gcv[kt];
                    acc = mfma16(aTB[kt], Xb, acc); acc = mfma16(aKD[kt], Vt, acc);
                    St[kt] = acc;
                }
                }
                const int cidx = 4 * bi + cc;
#pragma unroll
                for (int pr = 0; pr < 2; ++pr) {
                    const bool odd = li_ & 1; const float oa = O[2 * pr], ob_ = O[2 * pr + 1];
                    const float recv = __int_as_float(__builtin_amdgcn_update_dpp(0, __float_as_int(odd ? oa : ob_), 0xB1, 0xF, 0xF, false));
                    const unsigned w = odd ? cvtpk2(recv, ob_) : cvtpk2(oa, recv);
                    const int pidx = 16 * cidx + 4 * g_ + 2 * pr + (odd ? 1 : 0); const int t = dir ? (SEQ - 1 - pidx) : pidx;
                    *(unsigned*)(Odir + ((size_t)b * SEQ + t) * DA + h * 64 + 16 * vt + (li_ & ~1)) = w; }
            }
        }
    }
    __syncthreads();
}

typedef short v4i16_t __attribute__((ext_vector_type(4)));
__device__ __forceinline__ unsigned cvtpk(float lo, float hi) { return cvtpk2(lo, hi); }
__device__ __forceinline__ void na_load_row(const bf16* P, int b, int h, int row, int col, int ch, u32x4& kc, u32x4& vc) {
    const size_t tok = (size_t)b * SEQ + row * 64 + col;
    kc = *(const u32x4*)(P + tok * PN + C_BK + h * 64 + 8 * ch);
    vc = *(const u32x4*)(P + tok * PN + C_BV + h * 64 + 8 * ch);
}
__device__ __forceinline__ void na_write_row(LAS unsigned char* Ks, LAS unsigned char* Vs, int row, int col, int ch, f32x4 g0, f32x4 g1, u32x4 kc, u32x4 vc) {
    const float e0 = bflo(kc.x), e1 = bfhi(kc.x), e2 = bflo(kc.y), e3 = bfhi(kc.y), e4 = bflo(kc.z), e5 = bfhi(kc.z), e6 = bflo(kc.w), e7 = bfhi(kc.w);
    float ss = (e0 * e0 + e1 * e1) + (e2 * e2 + e3 * e3) + (e4 * e4 + e5 * e5) + (e6 * e6 + e7 * e7);
    ss = dpp_sum8(ss);
    const float rk = 1.0f / sqrtf(ss * (1.f / 64.f) + RMS_EPS);
    u32x4 o; o.x = cvtpk(e0 * rk * g0.x, e1 * rk * g0.y); o.y = cvtpk(e2 * rk * g0.z, e3 * rk * g0.w); o.z = cvtpk(e4 * rk * g1.x, e5 * rk * g1.y); o.w = cvtpk(e6 * rk * g1.z, e7 * rk * g1.w);
    const int off = (((row & 7) * 64 + col) << 7) + ((ch ^ (col & 7)) << 4);
    *(LAS u32x4*)(Ks + off) = o;
    *(LAS u32x4*)(Vs + off) = vc;
}
__device__ __forceinline__ void phase_na_unit(const Args& a, LAS unsigned char* lds, int unit) {
    const int tid = threadIdx.x, lane = tid & 63, wid = __builtin_amdgcn_readfirstlane(tid >> 6);
    const int b = unit >> 4, h = (unit >> 1) & 7, rh = unit & 1;
    const int c = wid & 3, dhalf = wid >> 2, g = lane >> 4, li = lane & 15;
    unsigned char* ws = a.ws;
    const bf16* P = (const bf16*)(ws + WS_P);
    bf16* YB = (bf16*)(ws + WS_YB);
    LAS unsigned char* Ks = lds; LAS unsigned char* Vs = lds + 65536; LAS float* RPB = (LAS float*)(lds + 131072);
    const int scol = tid >> 3, sch = tid & 7;
    const f32x4 kg0 = *(const f32x4*)(a.in[I_KG] + 8 * sch), kg1 = *(const f32x4*)(a.in[I_KG] + 8 * sch + 4);
    __syncthreads();
    for (int i = tid; i < 15 * 32; i += 512) { const int rr_ = i >> 5, cc_ = i & 31; RPB[i] = (cc_ < 31) ? a.in[I_RPB][h * 465 + rr_ * 31 + cc_] * 1.4426950408889634f : -1e30f; }
    const int r0 = rh * 16;
    u32x4 kraw, vraw;
    const int q = 16 * c + li;
    const int kc0 = (c == 0) ? 0 : (c == 1) ? 8 : (c == 2) ? 24 : 32;
    const int cs = min(max(q - 8, 0), 48);
    const bf16* qbase = P + ((size_t)b * SEQ + q) * PN + C_Q + h * 64 + 8 * g;
    float qg[16]; u32x4 q0, q1;
    { const int rs0 = min(max(r0 - 4, 0), 24);
      u32x4 kr8[8], vr8[8];
#pragma unroll
      for (int i = 0; i < 8; ++i) na_load_row(P, b, h, rs0 + i, scol, sch, kr8[i], vr8[i]);
      q0 = *(const u32x4*)(qbase + (size_t)r0 * 64 * PN); q1 = *(const u32x4*)(qbase + (size_t)r0 * 64 * PN + 32);
#pragma unroll
      for (int j = 0; j < 8; ++j) { qg[j] = a.in[I_QG][8 * g + j]; qg[8 + j] = a.in[I_QG][32 + 8 * g + j]; }
#pragma unroll
      for (int i = 0; i < 8; ++i) na_write_row(Ks, Vs, rs0 + i, scol, sch, kg0, kg1, kr8[i], vr8[i]); }
    int boff[8];
#pragma unroll
    for (int ch2 = 0; ch2 < 2; ++ch2)
#pragma unroll
        for (int k = 0; k < 4; ++k) { const int kcol = kc0 + 16 * ch2 + 4 * g + k; const bool valid = (kcol >= cs) && (kcol < cs + 16); boff[4 * ch2 + k] = valid ? (kcol - q + 15) : 31; }
    __syncthreads();
    float cshift;
    {   float mq = fabsf(a.in[I_QG][lane]), mk = fabsf(a.in[I_KG][lane]), bm = -1e30f;
        for (int i = lane; i < 15 * 32; i += 64) bm = fmaxf(bm, RPB[i]);
#pragma unroll
        for (int o = 1; o < 64; o <<= 1) { mq = fmaxf(mq, __shfl_xor(mq, o)); mk = fmaxf(mk, __shfl_xor(mk, o)); bm = fmaxf(bm, __shfl_xor(bm, o)); }
        cshift = fminf(8.0f * 1.4426950408889634f * mq * mk + fmaxf(bm, 0.f), 60.0f); }
    f32x4 barr[8];
    LAS float* XCH = (LAS float*)(lds + 133120);
    int cur_d = -1000;
    int prev_rs = min(max(r0 - 4, 0), 24);
    { const int rsn = min(max(r0 + 1 - 4, 0), 24); if (rsn != prev_rs) na_load_row(P, b, h, rsn + 7, scol, sch, kraw, vraw); }
#pragma unroll 1
    for (int r = r0; r < r0 + 16; ++r) {
        const int rs = min(max(r - 4, 0), 24);
        __syncthreads();
        const size_t qtok = (size_t)b * SEQ + r * 64 + q;
        bf16x8 qf0, qf1;
        {   float e[16] = {bflo(q0.x), bfhi(q0.x), bflo(q0.y), bfhi(q0.y), bflo(q0.z), bfhi(q0.z), bflo(q0.w), bfhi(q0.w), bflo(q1.x), bfhi(q1.x), bflo(q1.y), bfhi(q1.y), bflo(q1.z), bfhi(q1.z), bflo(q1.w), bfhi(q1.w)};
            float ss = 0.f;
#pragma unroll
            for (int j = 0; j < 16; ++j) ss += e[j] * e[j];
            ss += __shfl_xor(ss, 16); ss += __shfl_xor(ss, 32);
            const float rq = (0.125f * 1.4426950408889634f) / sqrtf(ss * (1.f / 64.f) + RMS_EPS);
#pragma unroll
            for (int j = 0; j < 16; ++j) e[j] *= rq * qg[j];
            u32x4 w0, w1; w0.x = cvtpk(e[0], e[1]); w0.y = cvtpk(e[2], e[3]); w0.z = cvtpk(e[4], e[5]); w0.w = cvtpk(e[6], e[7]); w1.x = cvtpk(e[8], e[9]); w1.y = cvtpk(e[10], e[11]); w1.z = cvtpk(e[12], e[13]); w1.w = cvtpk(e[14], e[15]);
            qf0 = __builtin_bit_cast(bf16x8, w0); qf1 = __builtin_bit_cast(bf16x8, w1);
        }
        if (r + 1 < r0 + 16) {
            q0 = *(const u32x4*)(qbase + (size_t)(r + 1) * 64 * PN); q1 = *(const u32x4*)(qbase + (size_t)(r + 1) * 64 * PN + 32);
            const int rsn = min(max(r + 1 - 4, 0), 24); if (rsn != rs) na_load_row(P, b, h, rsn + 7, scol, sch, kraw, vraw);
        }
        if (rs - r != cur_d) { cur_d = rs - r;
#pragma unroll
            for (int ii = 0; ii < 4; ++ii) { const LAS float* rb = RPB + (4 * dhalf + ii + cur_d + 7) * 32;
#pragma unroll
                for (int ch2 = 0; ch2 < 2; ++ch2)
#pragma unroll
                    for (int k = 0; k < 4; ++k) barr[2 * ii + ch2][k] = rb[boff[4 * ch2 + k]] - cshift; } }
        f32x4 st[8];
#pragma unroll
        for (int ii = 0; ii < 4; ++ii) {
            const int sl = (rs + 4 * dhalf + ii) & 7;
#pragma unroll
            for (int ch2 = 0; ch2 < 2; ++ch2) {
                const int col = kc0 + 16 * ch2 + li; const LAS unsigned char* kr = Ks + ((sl * 64 + col) << 7);
                const bf16x8 a0 = *(const LAS bf16x8*)(kr + ((g ^ (col & 7)) << 4)), a1 = *(const LAS bf16x8*)(kr + (((g + 4) ^ (col & 7)) << 4));
                f32x4 s = barr[2 * ii + ch2];
                s = __builtin_amdgcn_mfma_f32_16x16x32_bf16(a0, qf0, s, 0, 0, 0); s = __builtin_amdgcn_mfma_f32_16x16x32_bf16(a1, qf1, s, 0, 0, 0);
                st[2 * ii + ch2] = s;
            }
        }
        float sum = 0.f;
#pragma unroll
        for (int t = 0; t < 8; ++t)
#pragma unroll
            for (int k = 0; k < 4; ++k) { const float p = __builtin_amdgcn_exp2f(st[t][k]); st[t][k] = p; sum += p; }
        sum += __shfl_xor(sum, 16); sum += __shfl_xor(sum, 32);
        bf16x8 pf[4];
#pragma unroll
        for (int ii = 0; ii < 4; ++ii) { u32x4 pw; pw.x = cvtpk(st[2 * ii][0], st[2 * ii][1]); pw.y = cvtpk(st[2 * ii][2], st[2 * ii][3]); pw.z = cvtpk(st[2 * ii + 1][0], st[2 * ii + 1][1]); pw.w = cvtpk(st[2 * ii + 1][2], st[2 * ii + 1][3]); pf[ii] = __builtin_bit_cast(bf16x8, pw); }
        f32x4 op[4];
#pragma unroll
        for (int dtt = 0; dtt < 4; ++dtt) {
            f32x4 o = {0.f, 0.f, 0.f, 0.f};
#pragma unroll
            for (int ii = 0; ii < 4; ++ii) {
                const int sl = (rs + 4 * dhalf + ii) & 7; const int qq = li >> 2, pp = li & 3;
                const int ca = kc0 + 4 * g + qq, cb = ca + 16;
                const LAS unsigned char* pa = Vs + ((sl * 64 + ca) << 7) + (((2 * dtt + (pp >> 1)) ^ (ca & 7)) << 4) + 8 * (pp & 1);
                const LAS unsigned char* pb = Vs + ((sl * 64 + cb) << 7) + (((2 * dtt + (pp >> 1)) ^ (cb & 7)) << 4) + 8 * (pp & 1);
                const v4i16_t va = __builtin_amdgcn_ds_read_tr16_b64_v4i16((LAS v4i16_t*)pa), vb = __builtin_amdgcn_ds_read_tr16_b64_v4i16((LAS v4i16_t*)pb);
                const bf16x8 vf = {va[0], va[1], va[2], va[3], vb[0], vb[1], vb[2], vb[3]};
                o = __builtin_amdgcn_mfma_f32_16x16x32_bf16(vf, pf[ii], o, 0, 0, 0);
            }
            op[dtt] = o;
        }
        {
            LAS float* mine = XCH + wid * 576 + lane; const f32x4 s0 = dhalf ? op[0] : op[2], s1 = dhalf ? op[1] : op[3];
            mine[0] = s0[0]; mine[64] = s0[1]; mine[128] = s0[2]; mine[192] = s0[3]; mine[256] = s1[0]; mine[320] = s1[1]; mine[384] = s1[2]; mine[448] = s1[3]; mine[512] = sum;
        }
        __syncthreads();
        if (r + 1 < r0 + 16) { const int rsn = min(max(r + 1 - 4, 0), 24); if (rsn != rs) na_write_row(Ks, Vs, rsn + 7, scol, sch, kg0, kg1, kraw, vraw); }
        {   const LAS float* theirs = XCH + (wid ^ 4) * 576 + lane;
            const f32x4 t0 = {theirs[0], theirs[64], theirs[128], theirs[192]}, t1 = {theirs[256], theirs[320], theirs[384], theirs[448]};
            const float rinv = 1.0f / (sum + theirs[512]);
#pragma unroll
            for (int dt = 0; dt < 2; ++dt) { const int dtt = 2 * dhalf + dt; const f32x4 o = (dhalf ? (dt ? op[3] : op[2]) : (dt ? op[1] : op[0])) + (dt ? t1 : t0);
                const float rs_ = rinv * F8S_YM;
                int p8_ = __builtin_amdgcn_cvt_pk_fp8_f32(o[0] * rs_, o[1] * rs_, 0, false); p8_ = __builtin_amdgcn_cvt_pk_fp8_f32(o[2] * rs_, o[3] * rs_, p8_, true);
                *(unsigned*)((unsigned char*)YB + qtok * DA + h * 64 + 16 * dtt + 4 * g) = (unsigned)p8_; }
        }
    }
    __syncthreads();
}

__device__ __forceinline__ void phase_combine(const Args& a, LAS unsigned char* lds, int G) {
    const int tid = threadIdx.x, lane = tid & 63, wid = __builtin_amdgcn_readfirstlane(tid >> 6), li = lane & 15, g = lane >> 4;
    unsigned char* ws = a.ws;
    const bf16* P = (const bf16*)(ws + WS_P);
    const bf16* OF = (const bf16*)(ws + WS_OF); const bf16* OB = (const bf16*)(ws + WS_OB); const float* CFB = (const float*)(ws + WS_CFB);
    bf16* YA = (bf16*)(ws + WS_YA);
    LAS unsigned char* SIG = lds;
    const float* g2 = a.in[I_G2];
    bf16x8 afr[4][4];
#pragma unroll
    for (int nt = 0; nt < 4; ++nt)
#pragma unroll
        for (int ks = 0; ks < 4; ++ks) { float e[8];
#pragma unroll
            for (int jj = 0; jj < 8; ++jj) e[jj] = g2[(size_t)(32 * ks + 8 * g + jj) * DA + wid * 64 + 16 * nt + li];
            u32x4 w; w.x = cvtpk2(e[0], e[1]); w.y = cvtpk2(e[2], e[3]); w.z = cvtpk2(e[4], e[5]); w.w = cvtpk2(e[6], e[7]); afr[nt][ks] = __builtin_bit_cast(bf16x8, w); }
    const float* mup = a.in[I_MUP]; const float* mun = a.in[I_MUN];
    const int st = tid >> 3, sj = (tid & 7) * 16;
    LAS float* CPRM = (LAS float*)(lds + 20480);
    {   CPRM[tid] = mup[C_V + tid]; CPRM[512 + tid] = mun[C_V + tid]; CPRM[1024 + tid] = a.in[I_LNG][tid]; CPRM[1536 + tid] = a.in[I_LNB][tid]; }
    for (int grp = blockIdx.x; grp < M / 64; grp += G) {
        const int m0 = grp * 64;
        __syncthreads();
        {   const int m = m0 + st, t = m & (SEQ - 1); const bf16* prow = P + (size_t)m * PN + C_LG + sj; const bool hp = t > 0, hn = t < SEQ - 1;
            const bf16* pp = hp ? prow - PN : prow; const bf16* pn = hn ? prow + PN : prow;
            const u32x4 c0 = *(const u32x4*)prow, c1 = *(const u32x4*)(prow + 8), p0 = *(const u32x4*)pp, p1 = *(const u32x4*)(pp + 8), n0 = *(const u32x4*)pn, n1 = *(const u32x4*)(pn + 8);
            const unsigned cw[8] = {c0.x, c0.y, c0.z, c0.w, c1.x, c1.y, c1.z, c1.w}, pw[8] = {p0.x, p0.y, p0.z, p0.w, p1.x, p1.y, p1.z, p1.w}, nw[8] = {n0.x, n0.y, n0.z, n0.w, n1.x, n1.y, n1.z, n1.w};
            float x[16];
#pragma unroll
            for (int q4 = 0; q4 < 4; ++q4) { const f32x4 mp = *(const f32x4*)(mup + C_LG + sj + 4 * q4), mn = *(const f32x4*)(mun + C_LG + sj + 4 * q4);
#pragma unroll
                for (int e = 0; e < 4; ++e) { const int j = 4 * q4 + e; const float cv = (j & 1) ? bfhi(cw[j >> 1]) : bflo(cw[j >> 1]);
                    const float pv = hp ? ((j & 1) ? bfhi(pw[j >> 1]) : bflo(pw[j >> 1])) : 0.f, nv = hn ? ((j & 1) ? bfhi(nw[j >> 1]) : bflo(nw[j >> 1])) : 0.f;
                    x[j] = fast_sigmoid(cv + mp[e] * (pv - cv) + mn[e] * (nv - cv)); } }
            u32x4 w0, w1; w0.x = cvtpk2(x[0], x[1]); w0.y = cvtpk2(x[2], x[3]); w0.z = cvtpk2(x[4], x[5]); w0.w = cvtpk2(x[6], x[7]); w1.x = cvtpk2(x[8], x[9]); w1.y = cvtpk2(x[10], x[11]); w1.z = cvtpk2(x[12], x[13]); w1.w = cvtpk2(x[14], x[15]);
            *(LAS u32x4*)(SIG + st * 272 + sj * 2) = w0; *(LAS u32x4*)(SIG + st * 272 + sj * 2 + 16) = w1; }
        __syncthreads();
#pragma unroll 1
        for (int tt = 0; tt < 4; ++tt) {
            const int m = m0 + 16 * tt + li, t = m & (SEQ - 1); const bool hp = t > 0, hn = t < SEQ - 1;
            u32x2 of[4], ob[4]; u32x2 pc[4], pv[4], pnx[4];
            {   const bf16* prow = P + (size_t)m * PN + C_V + wid * 64 + 4 * g; const bf16* pp = hp ? prow - PN : prow; const bf16* pn = hn ? prow + PN : prow;
#pragma unroll
                for (int nt = 0; nt < 4; ++nt) { const int c0 = wid * 64 + 16 * nt + 4 * g;
                    of[nt] = *(const u32x2*)(OF + (size_t)m * DA + c0); ob[nt] = *(const u32x2*)(OB + (size_t)m * DA + c0);
                    pc[nt] = *(const u32x2*)(prow + 16 * nt); pv[nt] = *(const u32x2*)(pp + 16 * nt); pnx[nt] = *(const u32x2*)(pn + 16 * nt); } }
            const float cf0 = CFB[(size_t)m * 16 + wid * 2], cf1 = CFB[(size_t)m * 16 + wid * 2 + 1];
            bf16x8 bfr[4];
#pragma unroll
            for (int ks = 0; ks < 4; ++ks) bfr[ks] = *(const LAS bf16x8*)(SIG + (16 * tt + li) * 272 + (32 * ks + 8 * g) * 2);
            f32x4 gt[4];
#pragma unroll
            for (int nt = 0; nt < 4; ++nt) { f32x4 c = {0.f, 0.f, 0.f, 0.f};
#pragma unroll
                for (int ks = 0; ks < 4; ++ks) c = __builtin_amdgcn_mfma_f32_16x16x32_bf16(afr[nt][ks], bfr[ks], c, 0, 0, 0);
                gt[nt] = c; }
            f32x4 o[4]; float s = 0.f;
#pragma unroll
            for (int nt = 0; nt < 4; ++nt) { o[nt] = (f32x4){bflo(of[nt].x) + bflo(ob[nt].x), bfhi(of[nt].x) + bfhi(ob[nt].x), bflo(of[nt].y) + bflo(ob[nt].y), bfhi(of[nt].y) + bfhi(ob[nt].y)}; s += (o[nt][0] + o[nt][1]) + (o[nt][2] + o[nt][3]); }
            s += __shfl_xor(s, 16); s += __shfl_xor(s, 32);
            const float mu = s * (1.f / 64.f); float vq = 0.f;
#pragma unroll
            for (int nt = 0; nt < 4; ++nt) { o[nt] = o[nt] - mu; vq += (o[nt][0] * o[nt][0] + o[nt][1] * o[nt][1]) + (o[nt][2] * o[nt][2] + o[nt][3] * o[nt][3]); }
            vq += __shfl_xor(vq, 16); vq += __shfl_xor(vq, 32);
            const float rstd = 1.0f / sqrtf(vq * (1.f / 64.f) + GN_EPS);
            const float cfb = cf0 + cf1;
            u32x2 wv[4];
#pragma unroll
            for (int nt = 0; nt < 4; ++nt) { const int c0 = wid * 64 + 16 * nt + 4 * g;
                const u32x2 z2 = {0u, 0u};
                const f32x4 xv = shift4(pc[nt], hp ? pv[nt] : z2, hn ? pnx[nt] : z2, *(const LAS f32x4*)(CPRM + c0), *(const LAS f32x4*)(CPRM + 512 + c0));
                const f32x4 lg = *(const LAS f32x4*)(CPRM + 1024 + c0), lb = *(const LAS f32x4*)(CPRM + 1536 + c0);
                const f32x4 y = (o[nt] * rstd * lg + lb + xv * cfb) * gt[nt];
                wv[nt].x = pack4_fp8(y[0] * F8S_YM, y[1] * F8S_YM, y[2] * F8S_YM, y[3] * F8S_YM); }
#pragma unroll
            for (int nt = 0; nt < 4; ++nt) *(unsigned*)((unsigned char*)YA + (size_t)m * DA + wid * 64 + 16 * nt + 4 * g) = wv[nt].x;
        }
    }
    __syncthreads();
}

__device__ __forceinline__ void phase_router(const Args& a, LAS unsigned char* lds, int G, bool dry) {
    const int tid = threadIdx.x, lane = tid & 63, wid = __builtin_amdgcn_readfirstlane(tid >> 6), li = lane & 15, g = lane >> 4;
    unsigned char* ws = a.ws;
    const bf16* X1 = (const bf16*)(ws + WS_X1B); unsigned char* H2 = ws + WS_XN;
    int2* list = (int2*)(ws + WS_LIST);
    unsigned* cnt = (unsigned*)(ws + WS_CTL) + CW_CNT;
    LAS float* PL = (LAS float*)lds;
    LAS float* SS = (LAS float*)(lds + 16384);
    LAS float* RSTD = (LAS float*)(lds + 16896);
    LAS int* rowE = (LAS int*)(lds + 20480); LAS float* rowW = (LAS float*)(lds + 22528); LAS int* rowPos = (LAS int*)(lds + 24576);
    LAS int* bcnt = (LAS int*)(lds + 26624); LAS int* bbase = (LAS int*)(lds + 26752);
    const float* wr = a.in[I_WR];
    const int kw = 128 * wid;
    bf16x8 bh[4][2], bl[4][2];
#pragma unroll
    for (int ks = 0; ks < 4; ++ks)
#pragma unroll
        for (int et = 0; et < 2; ++et) { float wv[8], wl[8];
#pragma unroll
            for (int jj = 0; jj < 8; ++jj) { wv[jj] = wr[(size_t)(kw + 32 * ks + 8 * g + jj) * 32 + 16 * et + li]; }
            u32x4 hh; hh.x = cvtpk2(wv[0], wv[1]); hh.y = cvtpk2(wv[2], wv[3]); hh.z = cvtpk2(wv[4], wv[5]); hh.w = cvtpk2(wv[6], wv[7]);
            wl[0] = wv[0] - bflo(hh.x); wl[1] = wv[1] - bfhi(hh.x); wl[2] = wv[2] - bflo(hh.y); wl[3] = wv[3] - bfhi(hh.y); wl[4] = wv[4] - bflo(hh.z); wl[5] = wv[5] - bfhi(hh.z); wl[6] = wv[6] - bflo(hh.w); wl[7] = wv[7] - bfhi(hh.w);
            u32x4 ll; ll.x = cvtpk2(wl[0], wl[1]); ll.y = cvtpk2(wl[2], wl[3]); ll.z = cvtpk2(wl[4], wl[5]); ll.w = cvtpk2(wl[6], wl[7]);
            bh[ks][et] = __builtin_bit_cast(bf16x8, hh); bl[ks][et] = __builtin_bit_cast(bf16x8, ll); }
    f32x4 gf[4][2];
#pragma unroll
    for (int ks = 0; ks < 4; ++ks) { gf[ks][0] = *(const f32x4*)(a.in[I_GFFN] + kw + 32 * ks + 8 * g); gf[ks][1] = *(const f32x4*)(a.in[I_GFFN] + kw + 32 * ks + 8 * g + 4); }
    const float brl = a.in[I_BR][lane & 31];
    for (int grp = blockIdx.x; grp < M / 128; grp += G) {
        __syncthreads();
        if (tid < 32) bcnt[tid] = 0;
        __syncthreads();
        u32x4 xc[4];
        {   const bf16* xr = X1 + (size_t)(grp * 128 + li) * DM + kw + 8 * g;
#pragma unroll
            for (int ks = 0; ks < 4; ++ks) xc[ks] = *(const u32x4*)(xr + 32 * ks); }
#pragma unroll 1
        for (int tile = 0; tile < 8; ++tile) {
            const int m = grp * 128 + 16 * tile + li;
            f32x4 xg[4][2]; float ss = 0.f;
            u32x4 xnx[4];
            {   const bf16* xr = X1 + (size_t)(grp * 128 + 16 * (tile < 7 ? tile + 1 : tile) + li) * DM + kw + 8 * g;
#pragma unroll
                for (int ks = 0; ks < 4; ++ks) xnx[ks] = *(const u32x4*)(xr + 32 * ks); }
#pragma unroll
            for (int ks = 0; ks < 4; ++ks) { const f32x4 x0 = {bflo(xc[ks].x), bfhi(xc[ks].x), bflo(xc[ks].y), bfhi(xc[ks].y)}, x1 = {bflo(xc[ks].z), bfhi(xc[ks].z), bflo(xc[ks].w), bfhi(xc[ks].w)};
                ss += (x0.x * x0.x + x0.y * x0.y) + (x0.z * x0.z + x0.w * x0.w) + (x1.x * x1.x + x1.y * x1.y) + (x1.z * x1.z + x1.w * x1.w);
                xg[ks][0] = x0 * gf[ks][0]; xg[ks][1] = x1 * gf[ks][1]; }
            f32x4 acc0 = {0.f, 0.f, 0.f, 0.f}, acc1 = {0.f, 0.f, 0.f, 0.f};
#pragma unroll
            for (int ks = 0; ks < 4; ++ks) { const f32x4 v0 = xg[ks][0], v1 = xg[ks][1];
                u32x4 hh; hh.x = cvtpk2(v0.x, v0.y); hh.y = cvtpk2(v0.z, v0.w); hh.z = cvtpk2(v1.x, v1.y); hh.w = cvtpk2(v1.z, v1.w);
                u32x4 ll; ll.x = cvtpk2(v0.x - bflo(hh.x), v0.y - bfhi(hh.x)); ll.y = cvtpk2(v0.z - bflo(hh.y), v0.w - bfhi(hh.y)); ll.z = cvtpk2(v1.x - bflo(hh.z), v1.y - bfhi(hh.z)); ll.w = cvtpk2(v1.z - bflo(hh.w), v1.w - bfhi(hh.w));
                const bf16x8 ah = __builtin_bit_cast(bf16x8, hh), al = __builtin_bit_cast(bf16x8, ll);
                acc0 = __builtin_amdgcn_mfma_f32_16x16x32_bf16(ah, bh[ks][0], acc0, 0, 0, 0); acc0 = __builtin_amdgcn_mfma_f32_16x16x32_bf16(ah, bl[ks][0], acc0, 0, 0, 0); acc0 = __builtin_amdgcn_mfma_f32_16x16x32_bf16(al, bh[ks][0], acc0, 0, 0, 0);
                acc1 = __builtin_amdgcn_mfma_f32_16x16x32_bf16(ah, bh[ks][1], acc1, 0, 0, 0); acc1 = __builtin_amdgcn_mfma_f32_16x16x32_bf16(ah, bl[ks][1], acc1, 0, 0, 0); acc1 = __builtin_amdgcn_mfma_f32_16x16x32_bf16(al, bh[ks][1], acc1, 0, 0, 0); }
#pragma unroll
            for (int rg = 0; rg < 4; ++rg) { PL[wid * 512 + (4 * g + rg) * 32 + li] = acc0[rg]; PL[wid * 512 + (4 * g + rg) * 32 + 16 + li] = acc1[rg]; }
            ss += __shfl_xor(ss, 16); ss += __shfl_xor(ss, 32);
            if (g == 0) SS[wid * 16 + li] = ss;
            __syncthreads();
            {   const int r2 = lane >> 5, ex = lane & 31, row = 2 * wid + r2;
                float lg = 0.f, sq = 0.f;
#pragma unroll
                for (int w8 = 0; w8 < 8; ++w8) { lg += PL[w8 * 512 + row * 32 + ex]; sq += SS[w8 * 16 + row]; }
                const float rstd = 1.0f / sqrtf(sq * (1.f / DM) + RMS_EPS);
                if (ex == 0) RSTD[row] = rstd;
                float val = lg * rstd + brl;
                int te[4]; float tv[4];
#pragma unroll
                for (int i = 0; i < 4; ++i) { float mxv = val;
#pragma unroll
                    for (int o = 1; o < 32; o <<= 1) mxv = fmaxf(mxv, __shfl_xor(mxv, o));
                    const unsigned long long mk64 = __ballot(val == mxv); const unsigned mk = r2 ? (unsigned)(mk64 >> 32) : (unsigned)mk64;
                    const int src = mk ? __ffs((int)mk) - 1 : i; te[i] = src; tv[i] = mxv; if (ex == src) val = -3.0e38f; }
                const float e1 = __expf(tv[1] - tv[0]), e2 = __expf(tv[2] - tv[0]), e3 = __expf(tv[3] - tv[0]); const float den = 1.0f / (1.0f + e1 + e2 + e3);
                if (ex < 4) { const int ee = ex == 0 ? te[0] : ex == 1 ? te[1] : ex == 2 ? te[2] : te[3]; const float wv = (ex == 0 ? 1.0f : ex == 1 ? e1 : ex == 2 ? e2 : e3) * den;
                    const int pos = __hip_atomic_fetch_add(bcnt + ee, 1, __ATOMIC_RELAXED, __HIP_MEMORY_SCOPE_WORKGROUP);
                    const int rl = 16 * tile + row; rowE[rl * 4 + ex] = ee; rowW[rl * 4 + ex] = wv; rowPos[rl * 4 + ex] = pos; }
            }
            __syncthreads();
            {   const float rstd = RSTD[li] * F8S_H; unsigned char* hr = H2 + (size_t)m * DM + kw + 8 * g;
#pragma unroll
                for (int ks = 0; ks < 4; ++ks) { const f32x4 v0 = xg[ks][0] * rstd, v1 = xg[ks][1] * rstd; u32x2 o; o.x = pack4_fp8(v0.x, v0.y, v0.z, v0.w); o.y = pack4_fp8(v1.x, v1.y, v1.z, v1.w);
                    *(u32x2*)(hr + 32 * ks) = o; } }
#pragma unroll
            for (int ks = 0; ks < 4; ++ks) xc[ks] = xnx[ks];
        }
        __syncthreads();
        if (tid < 32) bbase[tid] = dry ? 0 : (int)__hip_atomic_fetch_add(cnt + 64 * tid, (unsigned)bcnt[tid], __ATOMIC_RELAXED, __HIP_MEMORY_SCOPE_AGENT);
        __syncthreads();
        { const int rl = tid >> 2, i = tid & 3, m = grp * 128 + rl; const int e = rowE[tid], pos = bbase[e] + rowPos[tid];
          if (!dry) { int2 le; le.x = m * 4 + i; le.y = __builtin_bit_cast(int, rowW[tid]); list[(size_t)e * LISTCAP + pos] = le;
                      ((int*)(ws + WS_INV))[(size_t)m * 4 + i] = (e << 16) | pos; ((float*)(ws + WS_GW))[(size_t)m * 4 + i] = rowW[tid]; } }
    }
    __syncthreads();
}

__device__ __forceinline__ int moe_table(const Args& a, LAS unsigned char* lds) {
    LAS int* tab = (LAS int*)(lds + MISC_OFF) + 16;
    unsigned* cnt = (unsigned*)(a.ws + WS_CTL) + CW_CNT;
    __syncthreads();
    if (threadIdx.x < 32) tab[threadIdx.x] = (int)__hip_atomic_load(cnt + 64 * threadIdx.x, __ATOMIC_RELAXED, __HIP_MEMORY_SCOPE_AGENT);
    __syncthreads();
    if (threadIdx.x == 0) { int s = 0; for (int e = 0; e < NE; ++e) { tab[32 + e] = s; s += (tab[e] + 255) >> 8; } tab[32 + NE] = s; }
    __syncthreads();
    return tab[32 + NE];
}

__device__ __forceinline__ void phase_final(const Args& a, LAS unsigned char* lds, int G, bool dry) {
    const int tid = threadIdx.x, lane = tid & 63, wave = tid >> 6;
    const unsigned char* Y = a.ws + WS_YBUF; float* out = a.out; const bf16* X1 = (const bf16*)(a.ws + WS_X1B);
    const int* inv = (const int*)(a.ws + WS_INV); const float* gwt = (const float*)(a.ws + WS_GW);
    const LAS int* tab = (const LAS int*)(lds + MISC_OFF) + 16;
    const int gw = blockIdx.x * 8 + wave, NGW = G * 8;
    const int c = lane * 16;
#define PF_LOAD(j_, x_, y_) do { const int mj_ = base + (j_) * NGW; const bf16* xr_ = X1 + (size_t)mj_ * DM + c; x_[0] = *(const u32x4*)xr_; x_[1] = *(const u32x4*)(xr_ + 8); \
        _Pragma("unroll") for (int s = 0; s < 4; ++s) { const int r_ = __builtin_amdgcn_readlane(ri[s], (j_)); y_[s] = *(const u32x4*)(Y + (size_t)r_ * DM + c); } } while (0)
#define PF_DONE(j_, x_, y_) do { const int mj_ = base + (j_) * NGW; float* xw = dry ? (float*)(a.ws + WS_P) + (size_t)mj_ * DM : out + (size_t)mj_ * DM; f32x4 v[4]; \
        _Pragma("unroll") for (int k = 0; k < 2; ++k) { const u32x4 xb = x_[k]; \
            v[2 * k] = (f32x4){bflo(xb.x), bfhi(xb.x), bflo(xb.y), bfhi(xb.y)}; v[2 * k + 1] = (f32x4){bflo(xb.z), bfhi(xb.z), bflo(xb.w), bfhi(xb.w)}; } \
        _Pragma("unroll") for (int s = 0; s < 4; ++s) { const float w = __builtin_bit_cast(float, __builtin_amdgcn_readlane(__builtin_bit_cast(int, wq[s]), (j_))); const unsigned tw[4] = {y_[s].x, y_[s].y, y_[s].z, y_[s].w}; \
            _Pragma("unroll") for (int k = 0; k < 4; ++k) { const f32x2 lo = __builtin_amdgcn_cvt_pk_f32_fp8((int)tw[k], false), hi = __builtin_amdgcn_cvt_pk_f32_fp8((int)tw[k], true); \
                v[k].x += w * lo[0]; v[k].y += w * lo[1]; v[k].z += w * hi[0]; v[k].w += w * hi[1]; } } \
        PF_POST; \
        _Pragma("unroll") for (int k = 0; k < 4; ++k) *(f32x4*)(xw + c + 4 * k) = v[k]; } while (0)
#if STAMP_SEL >= 0
#define PF_POST do { const float sc_ = 1.0f + 0.3f * ((const float*)(a.ws + WS_GW))[160000 + STAMP_SEL]; _Pragma("unroll") for (int k = 0; k < 4; ++k) v[k] = v[k] * sc_; } while (0)
#elif FP8_SELFTEST
#define PF_POST do { if (__hip_atomic_load((unsigned*)(a.ws + WS_CTL) + 8, __ATOMIC_RELAXED, __HIP_MEMORY_SCOPE_AGENT)) { _Pragma("unroll") for (int k = 0; k < 4; ++k) v[k] = v[k] * 2.0f; } } while (0)
#else
#define PF_POST do { } while (0)
#endif
    for (int base = gw; base < M; base += 64 * NGW) {
        const int cnt = min(64, (M - base + NGW - 1) / NGW);
        int ri[4]; float wq[4];
        {   const int mt = base + lane * NGW, q_ = mt < M ? mt : M - 1;
            const int4 iv = *(const int4*)(inv + (size_t)q_ * 4); const f32x4 wv = *(const f32x4*)(gwt + (size_t)q_ * 4);
            const int ivs[4] = {iv.x, iv.y, iv.z, iv.w};
#pragma unroll
            for (int s = 0; s < 4; ++s) { ri[s] = tab[32 + (ivs[s] >> 16)] * 256 + (ivs[s] & 0xffff); wq[s] = wv[s] * (1.0f / F8S_Y); } }
        u32x4 xA[2], yA[4], xB[2], yB[4];
        PF_LOAD(0, xA, yA);
#define PF_BODY(j_) do { const int j1 = min((j_) + 1, cnt - 1), j2 = min((j_) + 2, cnt - 1); \
            PF_LOAD(j1, xB, yB); __builtin_amdgcn_sched_barrier(0); asm volatile("" ::: "memory"); \
            PF_DONE((j_), xA, yA); \
            PF_LOAD(j2, xA, yA); __builtin_amdgcn_sched_barrier(0); asm volatile("" ::: "memory"); \
            PF_DONE(j1, xB, yB); } while (0)
        PF_BODY(0);
#pragma unroll 1
        for (int j = 2; j < cnt; j += 2) PF_BODY(j);
#undef PF_BODY
    }
#undef PF_LOAD
#undef PF_DONE
#undef PF_POST
}

#if FP8_SELFTEST
typedef int i32x8 __attribute__((ext_vector_type(8)));
__device__ __forceinline__ void fp8_selftest(const Args& a) {
    if (blockIdx.x != 0 || threadIdx.x >= 64) return;
    const int l = threadIdx.x, li = l & 15, g = l >> 4;
    i32x8 av, bv;
#pragma unroll
    for (int d = 0; d < 8; ++d) { const int k0 = 32 * g + 4 * d;
        float fa[4], fb[4];
#pragma unroll
        for (int t = 0; t < 4; ++t) { fa[t] = (float)((li * 7 + (k0 + t) * 3) % 5); fb[t] = (float)(((k0 + t) * 5 + li * 11) % 3); }
        int pa = __builtin_amdgcn_cvt_pk_fp8_f32(fa[0], fa[1], 0, false); pa = __builtin_amdgcn_cvt_pk_fp8_f32(fa[2], fa[3], pa, true);
        int pb = __builtin_amdgcn_cvt_pk_fp8_f32(fb[0], fb[1], 0, false); pb = __builtin_amdgcn_cvt_pk_fp8_f32(fb[2], fb[3], pb, true);
        av[d] = pa; bv[d] = pb; }
    f32x4 c = {0.f, 0.f, 0.f, 0.f};
    c = __builtin_amdgcn_mfma_scale_f32_16x16x128_f8f6f4(av, bv, c, 0, 0, 0, 127, 0, 127);
    bool bad = false;
#pragma unroll
    for (int rg = 0; rg < 4; ++rg) { const int i = 4 * g + rg, j = li; float ref = 0.f;
        for (int k = 0; k < 128; ++k) ref += (float)((i * 7 + k * 3) % 5) * (float)((k * 5 + j * 11) % 3);
        if (c[rg] != ref) bad = true; }
    if (bad) atomicOr((unsigned*)(a.ws + WS_CTL) + 8, 1u);
}
#endif
constexpr int N_PHASES = 10;
__global__ void __launch_bounds__(512, 2) mk_fwd(Args args) {
    extern __shared__ __attribute__((aligned(16))) unsigned char lds_raw[];
    LAS unsigned char* lds = (LAS unsigned char*)lds_raw;
    const int tid = threadIdx.x; const int G = gridDim.x;
    unsigned char* ws = args.ws;
    volatile LAS unsigned* MISC = (volatile LAS unsigned*)(lds + MISC_OFF);
    for (int u = tid; u < 256; u += 512) MISC[u] = 0u;
    __syncthreads();
    const int lo = args.ph_lo, hi = args.ph_hi;
    XcdBarrier bar; bar.bar = (unsigned*)(ws + WS_CTL) + CW_BAR; bar.x = 0; bar.st = nullptr;
    if (hi - lo > 1) bar = xcd_barrier_post((unsigned*)(ws + WS_CTL) + CW_BAR, MISC + 8);
#ifndef ONLY_PHASE
#define ONLY_PHASE -1
#endif
#define IN(k) ((ONLY_PHASE < 0 || ONLY_PHASE == (k)) && lo <= (k) && (k) < hi)
#define SEAM(k) do { if (IN(k) && IN((k) + 1)) xcd_barrier(bar); } while (0)

#if FP8_SELFTEST
    if (IN(0)) fp8_selftest(args);
#endif
    if (IN(0)) { for (int rep = 0; rep < NREP(0); ++rep) phase_prologue(args, lds, G); } SEAM(0);
    if (IN(1)) for (int rep = 0; rep < NREP(1); ++rep) {
        phase_stagger(STAGGER_TICKS);
        {
            pg8::StaticOrder S; S.init(M, 6 * 256, G, (int)blockIdx.x);
            EpiStoreBf16 E{(bf16*)(ws + WS_P), PN, -1};
            pg8::gemm_phase<EpiStoreBf16, pg8::StaticOrder, true, false>(lds, (const bf16*)(ws + WS_XN), (const bf16*)(ws + WS_WIN), 1024, S, E); }
        {
            pg8::StaticOrder S; S.init(M, 16 * 256, G, (int)blockIdx.x); S.off = 6;
            EpiStoreBf16S E{(bf16*)(ws + WS_P), PN, 1.0f / (F8S_H * F8S_W), C_GA};
            pg8::gemm_phase<EpiStoreBf16S, pg8::StaticOrder, true, false, true>(lds, ws + WS_XN8, ws + WS_WIN8, 1024, S, E); }
    } SEAM(1);
    if (IN(2)) {
        for (int rep = 0; rep < NREP(16); ++rep) if (blockIdx.x < 256) { if (blockIdx.x & 1) phase_scan_unit_t<1>(args, lds, (int)blockIdx.x); else phase_scan_unit_t<0>(args, lds, (int)blockIdx.x); }
        for (int rep = 0; rep < NREP(17); ++rep) if (blockIdx.x < 256) phase_na_unit(args, lds, (int)blockIdx.x);
    } SEAM(2);
    if (IN(3)) { for (int rep = 0; rep < NREP(3); ++rep) phase_combine(args, lds, G); } SEAM(3);
    if (IN(4)) for (int rep = 0; rep < NREP(4); ++rep) {
        pg8::StaticOrder S; S.init(M, DM, G, (int)blockIdx.x);
        int k512 = 512; asm volatile("" : "+s"(k512));
        { pg8::PairOrder S2; S2.S = S; S2.dpm0 = (int)((WS_YA - WS_YB) / (256 * 512)); S2.dpn1 = (int)((WS_WB - WS_WA) / (256 * 512));
          EpiGatePair E{(const bf16*)(ws + WS_P), ws + WS_MG8};
          pg8::gemm_phase<EpiGatePair, pg8::PairOrder, true, false, true>(lds, ws + WS_YB, ws + WS_WA, k512, S2, E); }
    } SEAM(4);
    if (IN(5)) for (int rep = 0; rep < NREP(5); ++rep) {
        pg8::StaticOrder S; S.init(M, DM, G, (int)blockIdx.x);
        EpiResid E{(const bf16*)(ws + WS_XN), (const float*)(ws + WS_RMS), args.in[I_GMIX], (bf16*)(ws + WS_X1B), 1.0f / (F8S_M * F8S_W)};
        pg8::gemm_phase<EpiResid, pg8::StaticOrder, true, false, true>(lds, ws + WS_MG8, ws + WS_WO, 1024, S, E);
    } SEAM(5);
    if (IN(6)) { for (int rep = 0; rep < NREP(6); ++rep) phase_router(args, lds, G, rep + 1 < NREP(6)); } SEAM(6);
    if (IN(7)) for (int rep = 0; rep < NREP(7); ++rep) {
        const int NT = moe_table(args, lds);
        phase_stagger(STAGGER_TICKS);
        MoeOrder S; S.JP = G / 8; S.x = blockIdx.x % 8; S.j = blockIdx.x / 8; S.NT = NT; S.TPX = (NT + 7) / 8; S.NPN = 8; S.tab = (const LAS int*)(lds + MISC_OFF) + 16; S.list = (const int2*)(ws + WS_LIST);
        EpiMoe1 E{ws + WS_P, args.in[I_B1]};
        pg8::gemm_phase<EpiMoe1, MoeOrder, true, true, true>(lds, ws + WS_XN, ws + WS_W1, 1024, S, E);
    } SEAM(7);
    if (IN(8)) for (int rep = 0; rep < NREP(8); ++rep) {
        const int NT = IN(7) ? ((const LAS int*)(lds + MISC_OFF) + 16)[32 + NE] : moe_table(args, lds);
        phase_stagger(STAGGER_TICKS);
        MoeOrder S; S.JP = G / 8; S.x = blockIdx.x % 8; S.j = blockIdx.x / 8; S.NT = NT; S.TPX = (NT + 7) / 8; S.NPN = 4; S.tab = (const LAS int*)(lds + MISC_OFF) + 16; S.list = (const int2*)(ws + WS_LIST);
        EpiMoe2 E{ws + WS_YBUF, args.in[I_B2]};
        pg8::gemm_phase<EpiMoe2, MoeOrder, true, false, true>(lds, ws + WS_P, ws + WS_W2, 1024, S, E);
    } SEAM(8);
    if (IN(9)) { if (!IN(7)) (void)moe_table(args, lds); for (int rep = 0; rep < NREP(9); ++rep) phase_final(args, lds, G, rep + 1 < NREP(9)); }
#undef IN
#undef SEAM
}

extern "C" void kernel_launch(void* const* d_in, const int* in_sizes, int n_in, void* d_out, int out_size, void* d_ws, size_t ws_size, hipStream_t stream) {
    static int grid = 0;
    if (grid == 0) {
        if (n_in != 32 || in_sizes[0] != M * DM || out_size != M * DM || ws_size < WS_END) {
            fprintf(stderr, "kernel_launch: unexpected problem: n_in %d in0 %d out %d ws %zu (need %zu)\n", n_in, n_in > 0 ? in_sizes[0] : -1, out_size, ws_size, (size_t)WS_END); grid = -1; return; }
        int dev = 0, cus = 0;
        if (hipGetDevice(&dev) != hipSuccess || hipDeviceGetAttribute(&cus, hipDeviceAttributeMultiprocessorCount, dev) != hipSuccess) { grid = -1; return; }
        if (hipFuncSetAttribute((const void*)mk_fwd, hipFuncAttributeMaxDynamicSharedMemorySize, LDS_BYTES) != hipSuccess) { fprintf(stderr, "kernel_launch: hipFuncSetAttribute failed\n"); grid = -1; return; }
        (void)hipGetLastError();
        grid = cus;
        if (grid != 256) { fprintf(stderr, "kernel_launch: this kernel needs a 256-CU device (got %d)\n", grid); grid = -1; return; }
    }
    if (grid < 0) return;
    (void)hipMemsetAsync((char*)d_ws + WS_CTL, 0, CTL_ZERO_BYTES, stream);
    Args a{};
    for (int i = 0; i < 32; ++i) a.in[i] = (const float*)d_in[i];
    a.out = (float*)d_out; a.ws = (unsigned char*)d_ws;
#if MK_N_LAUNCHES == 1
    a.ph_lo = 0; a.ph_hi = N_PHASES; a.li = 0;
    hipLaunchKernelGGL(mk_fwd, dim3(grid), dim3(512), LDS_BYTES, stream, a);
#else
    for (int p = 0; p < N_PHASES; ++p) { a.ph_lo = p; a.ph_hi = p + 1; a.li = p; hipLaunchKernelGGL(mk_fwd, dim3(grid), dim3(512), LDS_BYTES, stream, a); }
#endif
}
```
